# Optimizing an MI355X kernel written in HIP

```python
import math
import jax
import jax.numpy as jnp
from jax import lax
import numpy as np

D_MODEL = 2048
BATCH = 2
SEQ = 8192
DEPTH = 2
DEC_BATCH = 16
DEC_SEQ = 64
PAST_LEN = 4096

CHUNK = 64
Q_BLOCK = 128
N_MIXERS = 2
N_LAYERS_A = (DEPTH + N_MIXERS - 1) // N_MIXERS
N_LAYERS_B = DEPTH // N_MIXERS
HEAD_DIM = 128
N_HEADS_A = D_MODEL // HEAD_DIM
N_KV_A = 4
GROUP_A = N_HEADS_A // N_KV_A
N_IDX_HEADS = 16
IDX_DIM = 128
TOPK_MAX = 256
REL_BUCKETS = 32
REL_MAX_DIST = 128
N_HEADS_B = D_MODEL // HEAD_DIM
D_FF = 4 * D_MODEL
PLE_DIM = 256
LN_EPS = 1e-5
DEEPNORM_ALPHA = (2 * DEPTH) ** 0.25
DEEPNORM_BETA = (8 * DEPTH) ** -0.25
NEG_INF = -1e30
WIDTHS_A = (N_HEADS_A * HEAD_DIM, N_KV_A * HEAD_DIM, N_KV_A * HEAD_DIM,
            N_IDX_HEADS * IDX_DIM, IDX_DIM, N_IDX_HEADS)
SPLIT_A = [sum(WIDTHS_A[:i + 1]) for i in range(len(WIDTHS_A) - 1)]
D_IN_A = sum(WIDTHS_A)
D_IN_B = 3 * N_HEADS_B * HEAD_DIM

kernel_name = 'dsa_stickbreak_streaming_encoder'


def layer_norm(x, g, b):
    xf = x.astype(jnp.float32)
    mu = jnp.mean(xf, axis=-1, keepdims=True)
    var = jnp.mean(jnp.square(xf - mu), axis=-1, keepdims=True)
    y = (xf - mu) * lax.rsqrt(var + LN_EPS)
    return (y * g.astype(jnp.float32) + b.astype(jnp.float32)).astype(x.dtype)


def t5_bucket(rel):
    nb = REL_BUCKETS // 2
    n = -rel
    ret = jnp.where(n < 0, nb, 0)
    n = jnp.abs(n)
    max_exact = nb // 2
    nf = jnp.maximum(n, 1).astype(jnp.float32)
    large = max_exact + (jnp.log(nf / max_exact) / math.log(REL_MAX_DIST / max_exact)
                         * (nb - max_exact)).astype(jnp.int32)
    large = jnp.minimum(large, nb - 1)
    return ret + jnp.where(n < max_exact, n, large)


def dsa_project(x, w_in):
    B, T, _ = x.shape
    q, k, v, qi, ki, wi = jnp.split(x @ w_in, SPLIT_A, axis=-1)
    q = q.reshape(B, T, N_KV_A, GROUP_A, HEAD_DIM)
    k = k.reshape(B, T, N_KV_A, HEAD_DIM)
    v = v.reshape(B, T, N_KV_A, HEAD_DIM)
    qi = qi.reshape(B, T, N_IDX_HEADS, IDX_DIM)
    return q, k, v, qi, ki, wi


def dsa_attend(q, qi, wi, q_pos, k_all, v_all, ki_all, topk, rel_bias):
    B, Tq = q.shape[0], q.shape[1]
    S = k_all.shape[1]
    rel = jax.nn.relu(jnp.einsum('bthd,bsd->bths', qi, ki_all).astype(jnp.float32) * IDX_DIM ** -0.5)
    w = wi.astype(jnp.float32) * N_IDX_HEADS ** -0.5
    score = jnp.einsum('bth,bths->bts', w, rel)
    k_pos = jnp.arange(S, dtype=jnp.int32)
    admissible = (k_pos[None, :] // CHUNK) <= (q_pos[:, None] // CHUNK)
    score = jnp.where(admissible[None], score, NEG_INF)
    _, idx = lax.top_k(score, topk)
    valid = (idx // CHUNK) <= (q_pos[None, :, None] // CHUNK)
    bidx = jnp.arange(B)[:, None, None]
    k_sel = k_all[bidx, idx]
    v_sel = v_all[bidx, idx]
    logits = jnp.einsum('btkgd,btskd->btkgs', q, k_sel).astype(jnp.float32) * HEAD_DIM ** -0.5
    bias = rel_bias[t5_bucket(idx - q_pos[None, :, None])].astype(jnp.float32)
    bias = bias.reshape(B, Tq, topk, N_KV_A, GROUP_A).transpose(0, 1, 3, 4, 2)
    logits = jnp.where(valid[:, :, None, None, :], logits + bias, NEG_INF)
    p = jax.nn.softmax(logits, axis=-1).astype(v_all.dtype)
    o = jnp.einsum('btkgs,btskd->btkgd', p, v_sel)
    return o.reshape(B, Tq, N_HEADS_A * HEAD_DIM)


def to_blocks(a):
    B, T = a.shape[0], a.shape[1]
    return a.reshape((B, T // Q_BLOCK, Q_BLOCK) + a.shape[2:]).swapaxes(0, 1)


def from_blocks(o):
    nblk, B = o.shape[0], o.shape[1]
    return o.swapaxes(0, 1).reshape((B, nblk * Q_BLOCK) + o.shape[3:])


def mixer_a_prompt(x, w_in, w_out, rel_bias):
    B, T, _ = x.shape
    q, k, v, qi, ki, wi = dsa_project(x, w_in)
    topk = min(TOPK_MAX, T // 4)
    starts = jnp.arange(T // Q_BLOCK, dtype=jnp.int32) * Q_BLOCK

    def one_block(args):
        qb, qib, wib, start = args
        q_pos = start + jnp.arange(Q_BLOCK, dtype=jnp.int32)
        return dsa_attend(qb, qib, wib, q_pos, k, v, ki, topk, rel_bias)

    o = from_blocks(lax.map(one_block, (to_blocks(q), to_blocks(qi), to_blocks(wi), starts)))
    return o @ w_out, k, v, ki


def mixer_a_sample(x, cache_k, cache_v, cache_ki, w_in, w_out, rel_bias):
    B, n, _ = x.shape
    P = cache_k.shape[1]
    q, k, v, qi, ki, wi = dsa_project(x, w_in)
    k_all = jnp.concatenate([cache_k, k], axis=1)
    v_all = jnp.concatenate([cache_v, v], axis=1)
    ki_all = jnp.concatenate([cache_ki, ki], axis=1)
    topk = min(TOPK_MAX, (P + n) // 4)
    q_pos = P + jnp.arange(n, dtype=jnp.int32)
    o = dsa_attend(q, qi, wi, q_pos, k_all, v_all, ki_all, topk, rel_bias)
    return o @ w_out, k, v, ki


def sb_project(x, w_in):
    B, T, _ = x.shape
    q, k, v = jnp.split(x @ w_in, 3, axis=-1)
    shp = (B, T, N_HEADS_B, HEAD_DIM)
    return q.reshape(shp), k.reshape(shp), v.reshape(shp)


def sb_attend(q, k_all, v_all, q_pos):
    B, Tq = q.shape[0], q.shape[1]
    S = k_all.shape[1]
    z = jnp.einsum('bthd,bshd->bhts', q, k_all).astype(jnp.float32) * HEAD_DIM ** -0.5
    k_pos = jnp.arange(S, dtype=jnp.int32)
    m = k_pos[None, :] < q_pos[:, None]
    log_1m = jnp.where(m, jax.nn.log_sigmoid(-z), 0.0)
    later = lax.cumsum(log_1m, axis=3, reverse=True) - log_1m
    a = jnp.where(m, jnp.exp(jax.nn.log_sigmoid(z) + later), 0.0).astype(v_all.dtype)
    o = jnp.einsum('bhts,bshd->bthd', a, v_all)
    return o.reshape(B, Tq, N_HEADS_B * HEAD_DIM)


def mixer_b_prompt(x, w_in, w_out):
    B, T, _ = x.shape
    q, k, v = sb_project(x, w_in)
    starts = jnp.arange(T // Q_BLOCK, dtype=jnp.int32) * Q_BLOCK

    def one_block(args):
        qb, start = args
        q_pos = start + jnp.arange(Q_BLOCK, dtype=jnp.int32)
        return sb_attend(qb, k, v, q_pos)

    o = from_blocks(lax.map(one_block, (to_blocks(q), starts)))
    return o @ w_out, k, v


def mixer_b_sample(x, cache_k, cache_v, w_in, w_out):
    B, n, _ = x.shape
    P = cache_k.shape[1]
    q, k, v = sb_project(x, w_in)
    k_all = jnp.concatenate([cache_k, k], axis=1)
    v_all = jnp.concatenate([cache_v, v], axis=1)
    q_pos = P + jnp.arange(n, dtype=jnp.int32)
    o = sb_attend(q, k_all, v_all, q_pos)
    return o @ w_out, k, v


def finish_layer(x, mix, p_i, ln1g, ln1b, ln2g, ln2b, wu, wd, wp, wg):
    x = layer_norm(DEEPNORM_ALPHA * x + mix, ln1g, ln1b)
    h = jnp.square(jax.nn.relu(x @ wu)) @ wd
    x = layer_norm(DEEPNORM_ALPHA * x + h, ln2g, ln2b)
    return x + jax.nn.sigmoid(x @ wg) * (p_i @ wp)


def setup_inputs(seed: int = 0) -> dict:
    key = jax.random.key(seed)
    ks = jax.random.split(key, 22)

    def nrm(k, shape, scale=1.0):
        return jax.random.normal(k, shape, jnp.float32) * scale

    hd_a = N_HEADS_A * HEAD_DIM
    hd_b = N_HEADS_B * HEAD_DIM
    return {
        'x_prompt': nrm(ks[0], (BATCH, SEQ, D_MODEL)),
        'x_sample': nrm(ks[1], (DEC_BATCH, DEC_SEQ, D_MODEL)),
        'cache_k_a': nrm(ks[2], (N_LAYERS_A, DEC_BATCH, PAST_LEN, N_KV_A, HEAD_DIM)),
        'cache_v_a': nrm(ks[3], (N_LAYERS_A, DEC_BATCH, PAST_LEN, N_KV_A, HEAD_DIM)),
        'cache_kidx_a': nrm(ks[4], (N_LAYERS_A, DEC_BATCH, PAST_LEN, IDX_DIM)),
        'cache_k_b': nrm(ks[5], (N_LAYERS_B, DEC_BATCH, PAST_LEN, N_HEADS_B, HEAD_DIM)),
        'cache_v_b': nrm(ks[6], (N_LAYERS_B, DEC_BATCH, PAST_LEN, N_HEADS_B, HEAD_DIM)),
        'p_prompt': nrm(ks[7], (DEPTH, BATCH, SEQ, PLE_DIM)),
        'p_sample': nrm(ks[8], (DEPTH, DEC_BATCH, DEC_SEQ, PLE_DIM)),
        'rel_bias': nrm(ks[9], (REL_BUCKETS, N_HEADS_A), 0.5),
        'w_in_a': nrm(ks[10], (N_LAYERS_A, D_MODEL, D_IN_A), D_MODEL ** -0.5),
        'w_out_a': nrm(ks[11], (N_LAYERS_A, hd_a, D_MODEL), DEEPNORM_BETA * hd_a ** -0.5),
        'w_in_b': nrm(ks[12], (N_LAYERS_B, D_MODEL, D_IN_B), D_MODEL ** -0.5),
        'w_out_b': nrm(ks[13], (N_LAYERS_B, hd_b, D_MODEL), DEEPNORM_BETA * hd_b ** -0.5),
        'ln1_g': 1.0 + nrm(ks[14], (DEPTH, D_MODEL), 0.01),
        'ln1_b': nrm(ks[15], (DEPTH, D_MODEL), 0.01),
        'ln2_g': 1.0 + nrm(ks[16], (DEPTH, D_MODEL), 0.01),
        'ln2_b': nrm(ks[17], (DEPTH, D_MODEL), 0.01),
        'w_up': nrm(ks[18], (DEPTH, D_MODEL, D_FF), D_MODEL ** -0.5),
        'w_down': nrm(ks[19], (DEPTH, D_FF, D_MODEL), DEEPNORM_BETA * D_FF ** -0.5),
        'w_ple': nrm(ks[20], (DEPTH, PLE_DIM, D_MODEL), PLE_DIM ** -0.5),
        'w_ple_gate': nrm(ks[21], (DEPTH, D_MODEL, D_MODEL), D_MODEL ** -0.5),
    }


def reference(x_prompt, x_sample, cache_k_a, cache_v_a, cache_kidx_a, cache_k_b, cache_v_b,
              p_prompt, p_sample, rel_bias, w_in_a, w_out_a, w_in_b, w_out_b,
              ln1_g, ln1_b, ln2_g, ln2_b, w_up, w_down, w_ple, w_ple_gate):
    xp, xs = x_prompt, x_sample
    ka_p, va_p, kia_p, kb_p, vb_p = [], [], [], [], []
    ka_s, va_s, kia_s, kb_s, vb_s = [], [], [], [], []
    for i in range(DEPTH):
        j = i // N_MIXERS
        if i % N_MIXERS == 0:
            mix_p, k_new, v_new, ki_new = mixer_a_prompt(xp, w_in_a[j], w_out_a[j], rel_bias)
            ka_p.append(k_new)
            va_p.append(v_new)
            kia_p.append(ki_new)
            mix_s, k_new, v_new, ki_new = mixer_a_sample(xs, cache_k_a[j], cache_v_a[j], cache_kidx_a[j],
                                                         w_in_a[j], w_out_a[j], rel_bias)
            ka_s.append(k_new)
            va_s.append(v_new)
            kia_s.append(ki_new)
        else:
            mix_p, k_new, v_new = mixer_b_prompt(xp, w_in_b[j], w_out_b[j])
            kb_p.append(k_new)
            vb_p.append(v_new)
            mix_s, k_new, v_new = mixer_b_sample(xs, cache_k_b[j], cache_v_b[j], w_in_b[j], w_out_b[j])
            kb_s.append(k_new)
            vb_s.append(v_new)
        xp = finish_layer(xp, mix_p, p_prompt[i], ln1_g[i], ln1_b[i], ln2_g[i], ln2_b[i],
                          w_up[i], w_down[i], w_ple[i], w_ple_gate[i])
        xs = finish_layer(xs, mix_s, p_sample[i], ln1_g[i], ln1_b[i], ln2_g[i], ln2_b[i],
                          w_up[i], w_down[i], w_ple[i], w_ple_gate[i])
    return (xp, xs,
            jnp.stack(ka_p), jnp.stack(va_p), jnp.stack(kia_p), jnp.stack(kb_p), jnp.stack(vb_p),
            jnp.stack(ka_s), jnp.stack(va_s), jnp.stack(kia_s), jnp.stack(kb_s), jnp.stack(vb_s))
```

```cpp
#include <hip/hip_runtime.h>
#include <cstdio>
#include <cstdint>
#ifndef MK_PER_PHASE
#define MK_PER_PHASE 0
#endif
#ifndef MK_PH_MASK
#define MK_PH_MASK 0xffffffffu
#endif
constexpr int NWAVES = 8, NTHREADS = 512;
constexpr int DM = 2048, SEQ = 8192, MP = 16384, DECB = 16, DECS = 64, MS = 1024, MT = 17408, PAST = 4096, SALL = 4160;
constexpr int NINA = 5264, NINA_PAD = 5376, NINB = 6144, DFF = 8192, PLE = 256, HD = 128, KVW = 512, TOPK = 256;
constexpr float LN_EPS = 1e-5f, ALPHA = 1.41421356237309515f;
constexpr float QK_SCALE = 0.08838834764831845f;
constexpr float WI_SCALE = 0.25f * 0.08838834764831845f;
constexpr int NPH = 19;

constexpr size_t O_Y = 0;
constexpr size_t O_KAP = (size_t)MT * DM, O_VAP = O_KAP + (size_t)MP * KVW, O_KIP = O_VAP + (size_t)MP * KVW;
constexpr size_t O_KBP = O_KIP + (size_t)MP * HD, O_VBP = O_KBP + (size_t)MP * DM;
constexpr size_t O_KAS = O_VBP + (size_t)MP * DM, O_VAS = O_KAS + (size_t)MS * KVW, O_KIS = O_VAS + (size_t)MS * KVW;
constexpr size_t O_KBS = O_KIS + (size_t)MS * HD, O_VBS = O_KBS + (size_t)MS * DM, O_END = O_VBS + (size_t)MS * DM;
static_assert(O_END == 127008768, "d_out layout");

constexpr size_t MiB = 1u << 20;
constexpr size_t WS_CTL = 0, CTL_ZERO_BYTES = 1 * MiB;
constexpr size_t WS_WINA = 2 * MiB, WS_WOUTA = 23 * MiB, WS_WINB = 31 * MiB, WS_WOUTB = 55 * MiB, WS_WUP = 63 * MiB, WS_WDOWN = 127 * MiB, WS_WG = 191 * MiB, WS_WP = 207 * MiB;
constexpr size_t WS_PB = 210 * MiB, WS_XB = 228 * MiB, WS_X1B = 296 * MiB, WS_X2B = 364 * MiB, WS_QB = 432 * MiB, WS_OB = 500 * MiB, WS_QIB = 568 * MiB;
constexpr size_t WS_KAP = 636 * MiB, WS_VAP = 652 * MiB, WS_KAS = 668 * MiB, WS_VAS = 733 * MiB, WS_KIP = 798 * MiB, WS_KIS = 802 * MiB, WS_WI = 819 * MiB;
constexpr size_t WS_IDX = 821 * MiB, WS_CNT = 838 * MiB, WS_RES = 840 * MiB, WS_Y0 = 976 * MiB, WS_PW = 1112 * MiB, WS_H = 1248 * MiB;
constexpr size_t WS_SCP = 1248 * MiB  , WS_SCS = 1760 * MiB, WS_END = 1777 * MiB;
static_assert(WS_WINA + (size_t)NINA_PAD * DM * 2 <= WS_WOUTA && WS_PB + (size_t)2 * MT * PLE * 2 <= WS_XB && WS_XB + (size_t)MT * DM * 2 <= WS_X1B && WS_KAS + (size_t)DECB * SALL * KVW * 2 <= WS_VAS
              && WS_KIS + (size_t)DECB * SALL * HD * 2 <= WS_WI && WS_WI + (size_t)MT * 16 * 4 <= WS_IDX && WS_IDX + (size_t)MT * TOPK * 4 <= WS_CNT && WS_RES + (size_t)MT * DM * 4 <= WS_Y0
              && WS_H + (size_t)MT * DFF * 2 <= WS_SCS && WS_SCP + (size_t)MP * SEQ * 4 <= WS_SCS && WS_SCS + (size_t)MS * SALL * 4 <= WS_END, "d_ws map");
constexpr size_t D_VAP = (WS_VAP - WS_KAP) / 2, D_KAS = (WS_KAS - WS_KAP) / 2, D_VAS = (WS_VAS - WS_KAP) / 2, D_KIS = (WS_KIS - WS_KIP) / 2;
constexpr int CW_BAR = 4096;
constexpr int CW_QSC = 8192;

constexpr int RING_BYTES = 135168;
constexpr int LDSCTL_OFF = RING_BYTES, MISC_OFF = LDSCTL_OFF + 320;
constexpr int LDS_BYTES = 147456;
static_assert(MISC_OFF + 128 <= LDS_BYTES, "LDS map");

#define GAS __attribute__((address_space(1)))
#define LAS __attribute__((address_space(3)))
typedef unsigned short bf16;
typedef unsigned v4u __attribute__((ext_vector_type(4)));
typedef unsigned v2u __attribute__((ext_vector_type(2)));
typedef float f32x4 __attribute__((ext_vector_type(4)));
typedef float f32x2 __attribute__((ext_vector_type(2)));
typedef float f32x16 __attribute__((ext_vector_type(16)));
typedef short bf16x8 __attribute__((ext_vector_type(8)));
typedef __bf16 bf16x2_t __attribute__((ext_vector_type(2)));
#define LDS_WAIT() asm volatile("s_waitcnt lgkmcnt(0)" ::: "memory")
#define VM_WAIT() asm volatile("s_waitcnt vmcnt(0)" ::: "memory")
__device__ __forceinline__ unsigned pk2(float lo, float hi) { f32x2 v = {lo, hi}; bf16x2_t b = __builtin_convertvector(v, bf16x2_t); return __builtin_bit_cast(unsigned, b); }
__device__ __forceinline__ float bf_lo(unsigned w) { return __uint_as_float(w << 16); }
__device__ __forceinline__ float bf_hi(unsigned w) { return __uint_as_float(w & 0xffff0000u); }
__device__ __forceinline__ float dot2bf(unsigned a, unsigned b, float c) { return __builtin_amdgcn_fdot2_f32_bf16(__builtin_bit_cast(bf16x2_t, a), __builtin_bit_cast(bf16x2_t, b), c, false); }
namespace pg8 {
#define PG8_LAS __attribute__((address_space(3)))
typedef unsigned short bf16_t;
typedef short bf16x8 __attribute__((ext_vector_type(8)));
typedef float f32x4 __attribute__((ext_vector_type(4)));
typedef unsigned u32x4 __attribute__((ext_vector_type(4)));
constexpr int BM = 256, BK = 64, HALF = 128, HTB = HALF * BK * 2  , STAGE_BYTES = 8 * HTB, NXCD = 8, WGM = 8;

__host__ __device__ __forceinline__ int lds_byte(int r, int c) { const int st = (r >> 4) * 2 + (c >> 5), rr = r & 15, cc = c & 31, ob = rr * 64 + cc * 2; return st * 1024 + (ob ^ (((ob >> 9) & 1) << 5)); }
__host__ __device__ __forceinline__ void stage_rc(int b, int& R, int& C) { const int st = b / 1024, sb = b % 1024, swz = sb ^ (((sb >> 9) & 1) << 5); R = (st >> 1) * 16 + swz / 64; C = (st & 1) * 32 + (swz % 64) / 2; }
__host__ __device__ __forceinline__ int perm32(int rho) { const int n = rho >> 4, i = rho & 15; return 8 * (i >> 2) + 4 * n + (i & 3); }

struct Unit { int pm, pn; };
struct Gemm { const bf16_t* A; const bf16_t* Bt; int M, N, K; };

struct StaticOrder {
    int nM, nN, nwg, G, c;
    __host__ __device__ void init(int M, int N, int G_, int c_) { nM = M / BM; nN = N / BM; nwg = nM * nN; G = G_; c = c_; }
    __host__ __device__ bool next(int i, Unit& u) const {
        const long L = (long)i * G + c; if (L >= nwg) return false;
        int wgid = (int)L; { const int q = nwg / NXCD, r = nwg % NXCD, xcd = wgid % NXCD, off = wgid / NXCD; wgid = (xcd < r ? xcd * (q + 1) : r * (q + 1) + (xcd - r) * q) + off; }
        const int nig = WGM * nN, gid = wgid / nig, fm = gid * WGM, gsz = (nM - fm) < WGM ? (nM - fm) : WGM;
        u.pm = fm + ((wgid % nig) % gsz); u.pn = (wgid % nig) / gsz; return true;
    }
    __device__ __forceinline__ void a_ready(const Unit&) const {}
    __device__ __forceinline__ void done(const Unit&) const {}
};

__device__ __forceinline__ unsigned cvt_pk_bf16(float lo, float hi) { unsigned r; asm volatile("v_cvt_pk_bf16_f32 %0, %1, %2" : "=v"(r) : "v"(lo), "v"(hi)); return r; }
typedef float f32x2 __attribute__((ext_vector_type(2)));
__device__ __forceinline__ void st_bf16x8(bf16_t* p, const f32x4& a, const f32x4& b) { u32x4 w; w.x = ::pk2(a[0], a[1]); w.y = ::pk2(a[2], a[3]); w.z = ::pk2(b[0], b[1]); w.w = ::pk2(b[2], b[3]); *(u32x4*)p = w; }
__device__ __forceinline__ void st_f32x8(float* p, const f32x4& a, const f32x4& b) { *(f32x4*)p = a; *(f32x4*)(p + 4) = b; }
#define PG8_EPI_LOOP(...) \
    _Pragma("unroll") for (int ai = 0; ai < 2; ++ai) _Pragma("unroll") for (int m = 0; m < 4; ++m) { const int row = u.pm * BM + ai * HALF + wr * 64 + m * 16 + fr; \
        _Pragma("unroll") for (int bj = 0; bj < 2; ++bj) { const int cl = bj * HALF + wc * 32 + 8 * fq; const f32x4 v0 = acc[ai][bj][m][0], v1 = acc[ai][bj][m][1]; __VA_ARGS__ } }
#define PG8_EPI_LOOP_F(...) \
    _Pragma("unroll") for (int ai = 0; ai < 2; ++ai) _Pragma("unroll") for (int m = 0; m < 4; ++m) { const int row = u.pm * BM + ai * HALF + wr * 64 + m * 16 + fr; \
        _Pragma("unroll") for (int bj = 0; bj < 2; ++bj) { const int cl = bj * HALF + wc * 32 + 8 * fq; const f32x4 v0 = acc[ai][bj][m][0], v1 = acc[ai][bj][m][1]; __VA_ARGS__ } asm volatile("" ::: "memory"); }

struct EpiInA {
    static constexpr bool PERM = true, AFTER_DRAIN = false;
    bf16_t *Q, *QI, *KAP, *KIP; float* WI; float* out;
    __device__ __forceinline__ void operator()(const f32x4 (&acc)[2][2][4][2], const Unit& u, int wr, int wc, int fr, int fq) const {
        const int pn = u.pn; const bool samp = u.pm >= 64;
        float* fb = nullptr; bf16_t* bb; int ld; bool remap = false;
        if (pn < 8) { bb = Q + pn * BM; ld = ::DM; }
        else if (pn < 12) { const bool isv = pn >= 10; const int c0 = (pn & 1) * BM; ld = ::KVW; remap = samp;
            fb = out + (samp ? (isv ? ::O_VAS : ::O_KAS) - (size_t)::MP * ::KVW : (isv ? ::O_VAP : ::O_KAP)) + c0;
            bb = KAP + (samp ? (isv ? ::D_VAS : ::D_KAS) : (isv ? ::D_VAP : (size_t)0)) + c0; }
        else if (pn < 20) { bb = QI + (pn - 12) * BM; ld = ::DM; }
        else { ld = ::HD; remap = samp; fb = out + (samp ? ::O_KIS - (size_t)::MP * ::HD : ::O_KIP); bb = KIP + (samp ? ::D_KIS : (size_t)0); }
        PG8_EPI_LOOP(
            const int rs = row - ::MP; const size_t brow = remap ? ((size_t)(rs >> 6) * ::SALL + ::PAST + (rs & 63)) : (size_t)row;
            if (pn == 20 && cl >= 128) { if (cl < 144) st_f32x8(WI + (size_t)row * 16 + (cl - 128), v0 * ::WI_SCALE, v1 * ::WI_SCALE); }
            else { if (fb) st_f32x8(fb + (size_t)row * ld + cl, v0, v1); st_bf16x8(bb + brow * ld + cl, v0, v1); }
        )
    }
};
struct EpiInB {
    static constexpr bool PERM = true, AFTER_DRAIN = false;
    bf16_t* Q; float* out;
    __device__ __forceinline__ void operator()(const f32x4 (&acc)[2][2][4][2], const Unit& u, int wr, int wc, int fr, int fq) const {
        const int pn = u.pn; const bool samp = u.pm >= 64;
        PG8_EPI_LOOP(
            if (pn < 8) st_bf16x8(Q + (size_t)row * ::DM + pn * BM + cl, v0, v1);
            else { const bool isv = pn >= 16; const int c = (pn - (isv ? 16 : 8)) * BM + cl;
                float* of = out + (samp ? (isv ? ::O_VBS : ::O_KBS) + (size_t)(row - ::MP) * ::DM : (isv ? ::O_VBP : ::O_KBP) + (size_t)row * ::DM) + c; st_f32x8(of, v0, v1); }
        )
    }
};
struct EpiResid {
    static constexpr bool PERM = true, AFTER_DRAIN = false;
    const float* xa; const float* xb; float* RES;
    __device__ __forceinline__ void operator()(const f32x4 (&acc)[2][2][4][2], const Unit& u, int wr, int wc, int fr, int fq) const {
        const float* xin = (u.pm >= 64) ? xb : xa; const int pn = u.pn;
        PG8_EPI_LOOP_F(
            const size_t off = (size_t)row * ::DM + pn * BM + cl; const f32x4 x0 = *(const f32x4*)(xin + off), x1 = *(const f32x4*)(xin + off + 4);
            st_f32x8(RES + off, x0 * ::ALPHA + v0, x1 * ::ALPHA + v1);
        )
    }
};
struct EpiSqRelu {
    static constexpr bool PERM = true, AFTER_DRAIN = false;
    bf16_t* H;
    __device__ __forceinline__ void operator()(const f32x4 (&acc)[2][2][4][2], const Unit& u, int wr, int wc, int fr, int fq) const {
        const int pn = u.pn;
        PG8_EPI_LOOP(
            f32x4 a = __builtin_elementwise_max(v0, (f32x4){0.f, 0.f, 0.f, 0.f}), b = __builtin_elementwise_max(v1, (f32x4){0.f, 0.f, 0.f, 0.f});
            st_bf16x8(H + (size_t)row * ::DFF + pn * BM + cl, a * a, b * b);
        )
    }
};
struct EpiStoreF32 {
    static constexpr bool PERM = true, AFTER_DRAIN = false;
    float* C;
    __device__ __forceinline__ void operator()(const f32x4 (&acc)[2][2][4][2], const Unit& u, int wr, int wc, int fr, int fq) const {
        const int pn = u.pn;
        PG8_EPI_LOOP( st_f32x8(C + (size_t)row * ::DM + pn * BM + cl, v0, v1); )
    }
};
struct EpiGate {
    static constexpr bool PERM = true, AFTER_DRAIN = false;
    const float* X2; const float* PW; float* Y; bf16_t* YB;
    __device__ __forceinline__ f32x4 sig(const f32x4& v) const { f32x4 r;
#pragma unroll
        for (int i = 0; i < 4; ++i) r[i] = __builtin_amdgcn_rcpf(1.0f + __expf(-v[i])); return r; }
    __device__ __forceinline__ void operator()(const f32x4 (&acc)[2][2][4][2], const Unit& u, int wr, int wc, int fr, int fq) const {
        const int pn = u.pn;
        PG8_EPI_LOOP_F(
            const size_t off = (size_t)row * ::DM + pn * BM + cl;
            const f32x4 y0 = *(const f32x4*)(X2 + off) + sig(v0) * *(const f32x4*)(PW + off), y1 = *(const f32x4*)(X2 + off + 4) + sig(v1) * *(const f32x4*)(PW + off + 4);
            st_f32x8(Y + off, y0, y1); if (YB) st_bf16x8(YB + off, y0, y1);
        )
    }
};
template <class Epi, class Sched, bool ALIGN_EPI = false, bool SP2 = false>
__device__ __forceinline__ void gemm_phase(PG8_LAS unsigned char* lds, const Gemm g, const Sched& S, const Epi& E) {
    const int tid = threadIdx.x, wid = __builtin_amdgcn_readfirstlane(tid >> 6), lane = tid & 63, wr = wid >> 2, wc = wid & 3, fr = lane & 15, fq = lane >> 4;
    const int K = g.K, nt = K / BK;
    unsigned voffA[2], voffB[2];
#pragma unroll
    for (int i = 0; i < 2; ++i) { int R, C; stage_rc(tid * 16 + i * 8192, R, C); const int Rb = Epi::PERM ? ((R & ~31) + perm32(R & 31)) : R;
        voffA[i] = (unsigned)(R * K + C) * 2u; voffB[i] = (unsigned)(Rb * K + C) * 2u; }
    const size_t kstep = (size_t)(BK * 2);
    const size_t hstep = (size_t)HALF * K * 2;
    const size_t tstep = 2 * hstep;
    const unsigned ldsw = (unsigned)wid * 1024u;
    const int aoff = lds_byte(wr * 64 + fr, fq * 8), boff = lds_byte(wc * 32 + fr, fq * 8);
#define PG8_SA(b, h) (((b) * 2 + (h)) * HTB)
#define PG8_SB(b, h) ((4 + (b) * 2 + (h)) * HTB)
#define PG8_STAGE(bufoff, gbase, voff) do { _Pragma("unroll") for (int _i = 0; _i < 2; ++_i) \
        __builtin_amdgcn_global_load_lds((const unsigned*)((const char*)(gbase) + (voff)[_i]), (PG8_LAS unsigned*)(lds + (bufoff) + ldsw + _i * 8192), 16, 0, 0); } while (0)
#define PG8_LDA(dst, b, h) do { _Pragma("unroll") for (int m = 0; m < 4; ++m) _Pragma("unroll") for (int k = 0; k < 2; ++k) dst[m][k] = *(const PG8_LAS bf16x8*)(lds + PG8_SA(b, h) + aoff + m * 2048 + k * 1024); } while (0)
#define PG8_LDB(dst, b, h) do { _Pragma("unroll") for (int n = 0; n < 2; ++n) _Pragma("unroll") for (int k = 0; k < 2; ++k) dst[n][k] = *(const PG8_LAS bf16x8*)(lds + PG8_SB(b, h) + boff + n * 2048 + k * 1024); } while (0)
#define PG8_MMA(ai, bj, At, Bt) do { __builtin_amdgcn_s_setprio(1); _Pragma("unroll") for (int m = 0; m < 4; ++m) _Pragma("unroll") for (int n = 0; n < 2; ++n) _Pragma("unroll") for (int k = 0; k < 2; ++k) \
        acc[ai][bj][m][n] = __builtin_amdgcn_mfma_f32_16x16x32_bf16(Bt[n][k], At[m][k], acc[ai][bj][m][n], 0, 0, 0); __builtin_amdgcn_s_setprio(0); } while (0)
#define PG8_WAIT_V(n) asm volatile("s_waitcnt vmcnt(" #n ")" ::: "memory")
#define PG8_WAIT_L(n) asm volatile("s_waitcnt lgkmcnt(" #n ")" ::: "memory")
#define PG8_BAR __builtin_amdgcn_s_barrier()
#define PG8_SCHED __builtin_amdgcn_sched_barrier(0)
    Unit cur, nxt; int ui = 0;
    if (!S.next(0, cur)) return;
    f32x4 acc[2][2][4][2];
#pragma unroll
    for (int a = 0; a < 2; ++a)
#pragma unroll
        for (int b = 0; b < 2; ++b)
#pragma unroll
            for (int m = 0; m < 4; ++m)
#pragma unroll
                for (int n = 0; n < 2; ++n) acc[a][b][m][n] = (f32x4){0.f, 0.f, 0.f, 0.f};
    bf16x8 At[4][2], B0[2][2], B1[2][2];
    const char* cA = (const char*)g.A + (size_t)cur.pm * tstep; const char* cB = (const char*)g.Bt + (size_t)cur.pn * tstep;
    S.a_ready(cur);
    if constexpr (SP2) {
        PG8_STAGE(PG8_SB(0, 0), cB, voffB); PG8_STAGE(PG8_SB(0, 1), cB + hstep, voffB); PG8_STAGE(PG8_SA(0, 0), cA, voffA); PG8_STAGE(PG8_SA(0, 1), cA + hstep, voffA);
        if (wr == 1) PG8_BAR;
        PG8_WAIT_V(2); PG8_BAR;
        PG8_STAGE(PG8_SB(1, 0), cB + kstep, voffB); PG8_STAGE(PG8_SA(1, 0), cA + kstep, voffA); PG8_STAGE(PG8_SB(1, 1), cB + hstep + kstep, voffB);
        PG8_WAIT_V(6); PG8_BAR;
    } else {
        PG8_STAGE(PG8_SB(0, 0), cB, voffB); PG8_STAGE(PG8_SA(0, 0), cA, voffA); PG8_STAGE(PG8_SB(0, 1), cB + hstep, voffB); PG8_STAGE(PG8_SA(0, 1), cA + hstep, voffA);
        if (wr == 1) PG8_BAR;
        PG8_WAIT_V(4); PG8_BAR;
        PG8_STAGE(PG8_SB(1, 0), cB + kstep, voffB); PG8_STAGE(PG8_SA(1, 0), cA + kstep, voffA); PG8_STAGE(PG8_SB(1, 1), cB + hstep + kstep, voffB);
        PG8_WAIT_V(6); PG8_BAR;
    }
    for (;;) {
        const bool has_next = S.next(ui + 1, nxt);
        const char* nA = has_next ? (const char*)g.A + (size_t)nxt.pm * tstep : cA; const char* nB = has_next ? (const char*)g.Bt + (size_t)nxt.pn * tstep : cB;
        for (int t = 0; t < nt; t += 2) {
            const bool last = (t == nt - 2);
            const char* a1 = cA + (size_t)(t + 1) * kstep;
            const char* a2 = last ? nA : cA + (size_t)(t + 2) * kstep; const char* b2 = last ? nB : cB + (size_t)(t + 2) * kstep;
            const char* a3 = a2 + kstep; const char* b3 = b2 + kstep;
            if (last && has_next) S.a_ready(nxt);
            if constexpr (SP2) {
            PG8_LDB(B0, 0, 0); PG8_LDB(B1, 0, 1); PG8_SCHED; PG8_LDA(At, 0, 0); PG8_STAGE(PG8_SA(1, 1), a1 + hstep, voffA);
            PG8_WAIT_V(8); PG8_WAIT_L(0); PG8_BAR; PG8_MMA(0, 0, At, B0); PG8_MMA(0, 1, At, B1); PG8_BAR; PG8_SCHED;
            PG8_LDA(At, 0, 1); PG8_STAGE(PG8_SB(0, 0), b2, voffB); PG8_STAGE(PG8_SB(0, 1), b2 + hstep, voffB); PG8_STAGE(PG8_SA(0, 0), a2, voffA);
            PG8_WAIT_V(8); PG8_WAIT_L(0); PG8_BAR; PG8_MMA(1, 0, At, B0); PG8_MMA(1, 1, At, B1); PG8_BAR; PG8_SCHED;
            PG8_LDB(B0, 1, 0); PG8_LDB(B1, 1, 1); PG8_SCHED; PG8_LDA(At, 1, 0); PG8_STAGE(PG8_SA(0, 1), a2 + hstep, voffA);
            PG8_WAIT_V(8); PG8_WAIT_L(0); PG8_BAR; PG8_MMA(0, 0, At, B0); PG8_MMA(0, 1, At, B1); PG8_BAR; PG8_SCHED;
            PG8_LDA(At, 1, 1); PG8_STAGE(PG8_SB(1, 0), b3, voffB); PG8_STAGE(PG8_SB(1, 1), b3 + hstep, voffB); PG8_STAGE(PG8_SA(1, 0), a3, voffA);
            PG8_WAIT_V(8); PG8_WAIT_L(0); PG8_BAR; PG8_MMA(1, 0, At, B0); PG8_MMA(1, 1, At, B1); PG8_BAR; PG8_SCHED;
            } else {
            PG8_LDB(B0, 0, 0); PG8_SCHED; PG8_LDA(At, 0, 0); PG8_STAGE(PG8_SA(1, 1), a1 + hstep, voffA);
            PG8_WAIT_L(8); PG8_BAR; PG8_WAIT_L(0); PG8_MMA(0, 0, At, B0); PG8_BAR; PG8_SCHED;
            PG8_LDB(B1, 0, 1); PG8_STAGE(PG8_SB(0, 0), b2, voffB);
            PG8_BAR; PG8_WAIT_L(0); PG8_MMA(0, 1, At, B1); PG8_BAR;
            PG8_LDA(At, 0, 1); PG8_STAGE(PG8_SA(0, 0), a2, voffA);
            PG8_BAR; PG8_WAIT_L(0); PG8_MMA(1, 0, At, B0); PG8_BAR; PG8_SCHED;
            PG8_STAGE(PG8_SB(0, 1), b2 + hstep, voffB);
            PG8_WAIT_V(6); PG8_BAR; PG8_MMA(1, 1, At, B1); PG8_BAR;
            PG8_LDB(B0, 1, 0); PG8_SCHED; PG8_LDA(At, 1, 0); PG8_STAGE(PG8_SA(0, 1), a2 + hstep, voffA);
            PG8_WAIT_L(8); PG8_BAR; PG8_WAIT_L(0); PG8_MMA(0, 0, At, B0); PG8_BAR; PG8_SCHED;
            PG8_LDB(B1, 1, 1); PG8_STAGE(PG8_SB(1, 0), b3, voffB);
            PG8_BAR; PG8_WAIT_L(0); PG8_MMA(0, 1, At, B1); PG8_BAR;
            PG8_LDA(At, 1, 1); PG8_STAGE(PG8_SA(1, 0), a3, voffA);
            PG8_BAR; PG8_WAIT_L(0); PG8_MMA(1, 0, At, B0); PG8_BAR; PG8_SCHED;
            PG8_STAGE(PG8_SB(1, 1), b3 + hstep, voffB);
            PG8_WAIT_V(6); PG8_BAR; PG8_MMA(1, 1, At, B1); PG8_BAR;
            }
        }
        if constexpr (ALIGN_EPI) { if (wr == 0) PG8_BAR; }
        if constexpr (!Epi::AFTER_DRAIN) { E(acc, cur, wr, wc, fr, fq); S.done(cur); }
        if (!has_next) break;
#pragma unroll
        for (int a = 0; a < 2; ++a)
#pragma unroll
            for (int b = 0; b < 2; ++b)
#pragma unroll
                for (int m = 0; m < 4; ++m)
#pragma unroll
                    for (int n = 0; n < 2; ++n) acc[a][b][m][n] = (f32x4){0.f, 0.f, 0.f, 0.f};
        cur = nxt; cA = nA; cB = nB; ++ui;
        if constexpr (ALIGN_EPI) { if (wr == 1) PG8_BAR; }
    }
    PG8_WAIT_V(0);
    if constexpr (!ALIGN_EPI) { if (wr == 0) PG8_BAR; }
    PG8_BAR;
    if constexpr (Epi::AFTER_DRAIN) { E.fused(acc, cur, wr, wc, fr, fq, lds, wid, lane); S.done(cur); }
#undef PG8_SA
#undef PG8_SB
#undef PG8_STAGE
#undef PG8_LDA
#undef PG8_LDB
#undef PG8_MMA
#undef PG8_WAIT_V
#undef PG8_WAIT_L
#undef PG8_BAR
#undef PG8_SCHED
}
}
#define XB_TMO      128
#define XB_XCNT(j)  (256  + 64 * (j))
#define XB_XSUB(j)  (1280 + 64 * (j))
#define XB_XGEN(j)  (2304 + 64 * (j))
#define XB_TOP      3328
#define XB_TOPGEN   3392
#define XCD_BAR_WORDS 3456
#define XB_SPIN_CAP (1u << 18)

__device__ __forceinline__ unsigned xb_ld(unsigned* p)              { return __hip_atomic_load(p, __ATOMIC_RELAXED, __HIP_MEMORY_SCOPE_AGENT); }
__device__ __forceinline__ unsigned xb_add(unsigned* p, unsigned v) { return __hip_atomic_fetch_add(p, v, __ATOMIC_RELAXED, __HIP_MEMORY_SCOPE_AGENT); }
__device__ __forceinline__ unsigned xb_xcc_id() { return (unsigned)__builtin_amdgcn_s_getreg((3 << 11) | 20) & 0xFu; }
#define XB_SPIN(cond, bar) do { unsigned _sp = 0; while (cond) { __builtin_amdgcn_s_sleep(1); \
    if ((++_sp & 255u) == 0u) { if (xb_ld(&(bar)[XB_TMO])) break; if (_sp > XB_SPIN_CAP) { atomicAdd(&(bar)[XB_TMO], 1u); break; } } } } while (0)

struct XcdBarrier {
    unsigned* bar; unsigned x;
    volatile LAS unsigned* st;
};

__device__ __forceinline__ XcdBarrier xcd_barrier_post(unsigned* bar, volatile LAS unsigned* st) {
    XcdBarrier b; b.bar = bar; b.x = xb_xcc_id(); b.st = st;
    if (threadIdx.x == 0) (void)xb_add(&bar[XB_XCNT(b.x)], 1u);
    return b;
}
__device__ __forceinline__ void xcd_barrier_complete(unsigned* bar, unsigned x, unsigned& nloc, unsigned& nx) {
    const unsigned G = gridDim.x * gridDim.y * gridDim.z;
    unsigned sum, cnt, mine, sp = 0u;
    for (;;) {
        sum = 0u; cnt = 0u; mine = 0u;
#pragma unroll
        for (unsigned j = 0; j < 16; ++j) { const unsigned c = xb_ld(&bar[XB_XCNT(j)]); sum += c; cnt += (c > 0u) ? 1u : 0u; mine = (j == x) ? c : mine; }
        if (sum == G) break;
        __builtin_amdgcn_s_sleep(1);
        if ((++sp & 255u) == 0u) { if (xb_ld(&bar[XB_TMO])) break; if (sp > XB_SPIN_CAP) { atomicAdd(&bar[XB_TMO], 1u); break; } }
    }
    nloc = mine > 0u ? mine : 1u; nx = cnt > 0u ? cnt : 1u;
}

__device__ __forceinline__ void xcd_barrier(const XcdBarrier& b) {
    asm volatile("s_waitcnt vmcnt(0)" ::: "memory");
    __syncthreads();
    if (threadIdx.x == 0) {
        unsigned* bar = b.bar;
        __builtin_amdgcn_s_waitcnt(0);
        unsigned nloc = b.st[0], nx = b.st[1];
        if (nloc == 0u) { xcd_barrier_complete(bar, b.x, nloc, nx); b.st[0] = nloc; b.st[1] = nx; }
        const unsigned old = xb_add(&bar[XB_XSUB(b.x)], 1u);
        const unsigned gen = old / nloc;
        if (old + 1u == (gen + 1u) * nloc) {
            __builtin_amdgcn_fence(__ATOMIC_RELEASE, "agent");
            asm volatile("s_waitcnt vmcnt(0)" ::: "memory");
            const unsigned og = xb_add(&bar[XB_TOP], 1u);
            const unsigned tg = og / nx;
            if (og + 1u == (tg + 1u) * nx) xb_add(&bar[XB_TOPGEN], 1u);
            else XB_SPIN(xb_ld(&bar[XB_TOPGEN]) == tg, bar);
            __builtin_amdgcn_fence(__ATOMIC_ACQUIRE, "agent");
            xb_add(&bar[XB_XGEN(b.x)], 1u);
            asm volatile("s_waitcnt vmcnt(0)" ::: "memory");
        } else {
            XB_SPIN(xb_ld(&bar[XB_XGEN(b.x)]) == gen, bar);
            __builtin_amdgcn_fence(__ATOMIC_ACQUIRE, "agent");
            asm volatile("s_waitcnt vmcnt(0)" ::: "memory");
        }
    }
    __syncthreads();
}
#ifndef MK_GATE_PART
#define MK_GATE_PART 3
#endif
typedef GAS unsigned gu32;
#define RLX_AGENT __ATOMIC_RELAXED, __HIP_MEMORY_SCOPE_AGENT
#define MFMA32(a, b, c) __builtin_amdgcn_mfma_f32_32x32x16_bf16((a), (b), (c), 0, 0, 0)

struct Ctx { LAS unsigned char* lds; volatile LAS unsigned* MISC; int tid, lane, wave, G, bx, gw, NGW; };
__device__ __forceinline__ int crow(int r, int hi) { return (r & 3) + 8 * (r >> 2) + 4 * hi; }

__device__ __forceinline__ void p0_transpose_item(const float* W, int K, int N, int NP, bf16* WT, LAS float* scr, int item, int lane) {
    const int nblk = NP / 32, kb = item / nblk, nb = item % nblk, k0 = 64 * kb, n0 = 32 * nb;
    const int nn = n0 + (lane & 31);
#pragma unroll 8
    for (int i = 0; i < 32; ++i) { const int kk = 2 * i + (lane >> 5); scr[kk * 33 + (lane & 31)] = (nn < N) ? W[(size_t)(k0 + kk) * N + nn] : 0.f; }
    LDS_WAIT();
    const int c = lane & 7;
#pragma unroll
    for (int j = 0; j < 4; ++j) { const int n = (lane >> 3) + 8 * j; const LAS float* s = scr + (8 * c) * 33 + n;
        v4u o; o.x = pk2(s[0 * 33], s[1 * 33]); o.y = pk2(s[2 * 33], s[3 * 33]); o.z = pk2(s[4 * 33], s[5 * 33]); o.w = pk2(s[6 * 33], s[7 * 33]);
        *(v4u*)(WT + (size_t)(n0 + n) * K + k0 + 8 * c) = o; }
    LDS_WAIT();
}
__device__ __forceinline__ void transpose_job(const Ctx& C, const float* W, int K, int N, int NP, bf16* WT) {
    LAS float* scr = (LAS float*)(C.lds + C.wave * 16384);
    const int nitems = (K / 64) * (NP / 32);
    for (int it = C.gw; it < nitems; it += C.NGW) p0_transpose_item(W, K, N, NP, WT, scr, it, C.lane);
}
__device__ __forceinline__ void cvt_job(const Ctx& C, const float* src, bf16* dst, int nseg, int seglen, size_t sstride, size_t dstride) {
    const int vps = seglen / 8; const long total = (long)nseg * vps; const long NGT = (long)C.G * NTHREADS;
    for (long i = (long)C.bx * NTHREADS + C.tid; i < total; i += NGT) { const int seg = (int)(i / vps), off = (int)(i % vps) * 8;
        const f32x4 a = *(const f32x4*)(src + seg * sstride + off), b = *(const f32x4*)(src + seg * sstride + off + 4);
        v4u o; o.x = pk2(a.x, a.y); o.y = pk2(a.z, a.w); o.z = pk2(b.x, b.y); o.w = pk2(b.z, b.w); *(v4u*)(dst + seg * dstride + off) = o; }
}

__device__ __forceinline__ float wave_sum(float v) {
#pragma unroll
    for (int o = 1; o < 64; o <<= 1) v += __shfl_xor(v, o);
    return v;
}
__device__ __forceinline__ void ln_phase(const Ctx& C, float* RES, bf16* XO, const float* g, const float* b) {
    for (int row = C.gw; row < MT; row += C.NGW) {
        f32x4* xr = (f32x4*)(RES + (size_t)row * DM) + C.lane;
        f32x4 v[8]; float s = 0.f;
#pragma unroll
        for (int j = 0; j < 8; ++j) { v[j] = xr[64 * j]; s += (v[j].x + v[j].y) + (v[j].z + v[j].w); }
        const float mean = wave_sum(s) * (1.f / DM); float s2 = 0.f;
#pragma unroll
        for (int j = 0; j < 8; ++j) { v[j] = v[j] - mean; s2 += (v[j].x * v[j].x + v[j].y * v[j].y) + (v[j].z * v[j].z + v[j].w * v[j].w); }
        const float rstd = 1.f / sqrtf(wave_sum(s2) * (1.f / DM) + LN_EPS);
        v2u* o8 = (v2u*)(XO + (size_t)row * DM) + C.lane;
#pragma unroll
        for (int j = 0; j < 8; ++j) { const f32x4 gg = ((const f32x4*)g)[C.lane + 64 * j], bb = ((const f32x4*)b)[C.lane + 64 * j]; const f32x4 y = v[j] * rstd * gg + bb;
            xr[64 * j] = y; v2u w; w.x = pk2(y.x, y.y); w.y = pk2(y.z, y.w); o8[64 * j] = w; }
    }
}

constexpr int SC_QPITCH = 4112, SC_NITEMS = 160 + 2304;
__device__ __forceinline__ void scores_phase(const Ctx& C, unsigned* qhead, const bf16* QIB, const bf16* KIP, const bf16* KIS, const float* WI, float* SCP, float* SCS) {
    const int q = C.lane & 31, hh = C.lane >> 5;
    for (;;) {
        if (C.tid == 0) C.MISC[0] = __hip_atomic_fetch_add(qhead, 1u, RLX_AGENT);
        __syncthreads();
        int id = (int)C.MISC[0];
        __syncthreads();
        if (id >= SC_NITEMS) break;
        int row0, nk, ch, stride; const bf16* KI; float* SC;
        if (id < 160) { const int qt = id / 5; ch = id % 5; const int rs0 = qt * 32, b = rs0 >> 6; row0 = MP + rs0; KI = KIS + (size_t)b * SALL * HD; nk = SALL; SC = SCS + (size_t)rs0 * SALL; stride = SALL; }
        else { id -= 160; int k = 7; while (id >= 64 * (k + 1)) { id -= 64 * (k + 1); --k; }
            const int per = 4 * (k + 1), ci = id / per, rem = id % per, c = 16 * k + 15 - ci, tile4 = rem / (k + 1); ch = rem % (k + 1);
            const int b = tile4 >> 1, t0 = c * 64 + (tile4 & 1) * 32; row0 = b * SEQ + t0; KI = KIP + (size_t)b * SEQ * HD; nk = 64 * (c + 1); SC = SCP + (size_t)row0 * SEQ; stride = SEQ; }
        const int s_begin = ch * 1024, nkc = (nk - s_begin) < 1024 ? (nk - s_begin) : 1024, ntiles = nkc >> 5;
#pragma unroll 4
        for (int i = 0; i < 16; ++i) { const int p = C.tid + NTHREADS * i, qq = p >> 8, off = (p & 255) * 16;
            const v4u v = *(const v4u*)((const char*)QIB + (size_t)(row0 + qq) * (DM * 2) + off); *(LAS v4u*)(C.lds + qq * SC_QPITCH + off) = v; }
        LAS float* wl = (LAS float*)(C.lds + 32 * SC_QPITCH);
        { const int qq = C.tid >> 4, h2 = C.tid & 15; wl[qq * 17 + h2] = WI[(size_t)(row0 + qq) * 16 + h2]; }
        __syncthreads();
        const LAS unsigned char* qb = C.lds + q * SC_QPITCH + hh * 16;
        for (int ti = C.wave; ti < ntiles; ti += NWAVES) {
            const int s0 = s_begin + ti * 32;
            const bf16* kp = KI + (size_t)(s0 + q) * HD + 8 * hh;
            bf16x8 kf[8];
#pragma unroll
            for (int kk = 0; kk < 8; ++kk) kf[kk] = *(const bf16x8*)(kp + 16 * kk);
            f32x16 acc;
#pragma unroll
            for (int r = 0; r < 16; ++r) acc[r] = 0.f;
#pragma unroll 2
            for (int h = 0; h < 16; ++h) {
                f32x16 c; const float wh = wl[q * 17 + h];
#pragma unroll
                for (int r = 0; r < 16; ++r) c[r] = 0.f;
#pragma unroll
                for (int kk = 0; kk < 8; ++kk) { const bf16x8 bq = *(const LAS bf16x8*)(qb + h * 256 + kk * 32); c = MFMA32(kf[kk], bq, c); }
#pragma unroll
                for (int r = 0; r < 16; ++r) acc[r] += wh * __builtin_fmaxf(c[r], 0.f);
            }
            float* sp = SC + (size_t)q * stride + s0 + 4 * hh;
#pragma unroll
            for (int g = 0; g < 4; ++g) *(f32x4*)(sp + 8 * g) = (f32x4){acc[4 * g], acc[4 * g + 1], acc[4 * g + 2], acc[4 * g + 3]};
        }
        __syncthreads();
    }
}

__device__ __forceinline__ unsigned tokey(float f) { const unsigned u = __float_as_uint(f); return (u & 0x80000000u) ? ~u : (u | 0x80000000u); }
__device__ __forceinline__ void select_phase(const Ctx& C, const float* SCP, const float* SCS, int* IDX, int* CNT) {
    LAS unsigned* hist = (LAS unsigned*)(C.lds + C.wave * 1024);
    const int lane = C.lane; const unsigned long long ltm = (1ull << lane) - 1ull;
    for (int row = C.gw; row < MT; row += C.NGW) {
        int n; const float* sc;
        if (row < MP) { const int t = row & (SEQ - 1); n = 64 * ((t >> 6) + 1); sc = SCP + (size_t)row * SEQ; } else { n = SALL; sc = SCS + (size_t)(row - MP) * SALL; }
        int* ip = IDX + (size_t)row * TOPK;
        if (n <= TOPK) {
#pragma unroll
            for (int k = 0; k < 4; ++k) { const int i = lane + 64 * k; ip[i] = (i < n) ? i : 0; }
            if (lane == 0) CNT[row] = n;
            continue;
        }
        unsigned prefix = 0u, mask = 0u, krem = TOPK;
        for (int pass = 0; pass < 4; ++pass) {
            const int shift = 24 - 8 * pass;
            *(LAS v4u*)(hist + 4 * lane) = (v4u){0u, 0u, 0u, 0u};
            LDS_WAIT();
            for (int i = lane * 4; i < n; i += 256) { const f32x4 v = *(const f32x4*)(sc + i);
#pragma unroll
                for (int e = 0; e < 4; ++e) { const unsigned key = tokey(v[e]); if ((key & mask) == prefix) __hip_atomic_fetch_add(hist + ((key >> shift) & 255u), 1u, __ATOMIC_RELAXED, __HIP_MEMORY_SCOPE_WORKGROUP); } }
            LDS_WAIT();
            const v4u hc = *(const LAS v4u*)(hist + 4 * lane);
            const unsigned tot = hc.x + hc.y + hc.z + hc.w; unsigned x = tot;
#pragma unroll
            for (int o = 1; o < 64; o <<= 1) { const unsigned y = __shfl_down(x, o); if (lane + o < 64) x += y; }
            const unsigned a3 = x - tot, a2 = a3 + hc.w, a1 = a2 + hc.z, a0 = a1 + hc.y;
            int fe = -1; unsigned fa = 0u;
            if (a3 < krem && krem <= a3 + hc.w) { fe = 3; fa = a3; } else if (a2 < krem && krem <= a2 + hc.z) { fe = 2; fa = a2; }
            else if (a1 < krem && krem <= a1 + hc.y) { fe = 1; fa = a1; } else if (a0 < krem && krem <= a0 + hc.x) { fe = 0; fa = a0; }
            const unsigned long long bal = __ballot(fe >= 0); const int src = bal ? (__ffsll((long long)bal) - 1) : 0;
            const unsigned d = (unsigned)__shfl(4 * lane + fe, src), above = (unsigned)__shfl((int)fa, src);
            krem -= above; prefix |= d << shift; mask |= 0xffu << shift;
        }
        int outc = 0, eqs = 0;
        for (int i0 = 0; i0 < n; i0 += 64) { const unsigned key = tokey(sc[i0 + lane]); const bool gt = key > prefix, eq = key == prefix;
            const unsigned long long eqb = __ballot(eq); const int myr = eqs + __popcll(eqb & ltm); const bool sel = gt || (eq && (unsigned)myr < krem); eqs += __popcll(eqb);
            const unsigned long long sb = __ballot(sel); const int pos = outc + __popcll(sb & ltm); if (sel && pos < TOPK) ip[pos] = i0 + lane; outc += __popcll(sb); }
        if (lane == 0) CNT[row] = outc < TOPK ? outc : TOPK;
    }
}

__device__ __forceinline__ int t5_bucket(int n  ) {
    const int ret = (n < 0) ? 16 : 0; n = n < 0 ? -n : n;
    if (n < 8) return ret + n;
    const int lg = 31 - __builtin_clz((unsigned)(n * n));
    const int large = 2 + lg; return ret + (large < 15 ? large : 15);
}
__device__ __forceinline__ void sattn_task(int row, int g, int qpos, const bf16* Kb, const bf16* Vb, int cnt, const int* ip, const bf16* QB, bf16* OB,
                                           LAS int* idxl, LAS float* lg, const LAS float* biasl, int lane) {
#pragma unroll
    for (int k = 0; k < 4; ++k) { const int j = lane + 64 * k; const int v = ip[j]; idxl[j] = (j < cnt) ? v : 0; }
    const int ks = lane >> 3, dc = lane & 7;
    unsigned qreg[4][8];
    { const bf16* qp = QB + (size_t)row * DM + (4 * g) * HD + 16 * dc;
#pragma unroll
      for (int hq = 0; hq < 4; ++hq) { const v4u a = *(const v4u*)(qp + hq * HD), b = *(const v4u*)(qp + hq * HD + 8);
          qreg[hq][0] = a.x; qreg[hq][1] = a.y; qreg[hq][2] = a.z; qreg[hq][3] = a.w; qreg[hq][4] = b.x; qreg[hq][5] = b.y; qreg[hq][6] = b.z; qreg[hq][7] = b.w; } }
    LDS_WAIT();
#pragma unroll 4
    for (int r = 0; r < 32; ++r) { const int j = 8 * r + ks; const int key = idxl[j];
        const bf16* kp = Kb + (size_t)key * KVW + 16 * dc; const v4u a = *(const v4u*)kp, b = *(const v4u*)(kp + 8);
        float s[4];
#pragma unroll
        for (int hq = 0; hq < 4; ++hq) { float t = 0.f; t = dot2bf(a.x, qreg[hq][0], t); t = dot2bf(a.y, qreg[hq][1], t); t = dot2bf(a.z, qreg[hq][2], t); t = dot2bf(a.w, qreg[hq][3], t);
            t = dot2bf(b.x, qreg[hq][4], t); t = dot2bf(b.y, qreg[hq][5], t); t = dot2bf(b.z, qreg[hq][6], t); t = dot2bf(b.w, qreg[hq][7], t);
            t += __shfl_xor(t, 1); t += __shfl_xor(t, 2); t += __shfl_xor(t, 4); s[hq] = t; }
        const float sv = dc == 0 ? s[0] : dc == 1 ? s[1] : dc == 2 ? s[2] : s[3];
        if (dc < 4) lg[j * 4 + dc] = sv; }
    LDS_WAIT();
    float l[4][4];
#pragma unroll
    for (int k = 0; k < 4; ++k) { const int j = lane + 64 * k; const f32x4 l4 = *(const LAS f32x4*)(lg + 4 * j); const int key = idxl[j]; const int bk = t5_bucket(qpos - key);
        const f32x4 b4 = *(const LAS f32x4*)(biasl + bk * 16 + 4 * g); const bool valid = j < cnt;
#pragma unroll
        for (int hq = 0; hq < 4; ++hq) l[k][hq] = valid ? l4[hq] * QK_SCALE + b4[hq] : -INFINITY; }
    LDS_WAIT();
#pragma unroll
    for (int hq = 0; hq < 4; ++hq) { float m = __builtin_fmaxf(__builtin_fmaxf(l[0][hq], l[1][hq]), __builtin_fmaxf(l[2][hq], l[3][hq]));
#pragma unroll
        for (int o = 1; o < 64; o <<= 1) m = __builtin_fmaxf(m, __shfl_xor(m, o));
        float sum = 0.f;
#pragma unroll
        for (int k = 0; k < 4; ++k) { l[k][hq] = __expf(l[k][hq] - m); sum += l[k][hq]; }
        sum = wave_sum(sum); const float inv = 1.0f / sum;
#pragma unroll
        for (int k = 0; k < 4; ++k) l[k][hq] *= inv; }
#pragma unroll
    for (int k = 0; k < 4; ++k) { const int j = lane + 64 * k; *(LAS f32x4*)(lg + 4 * j) = (f32x4){l[k][0], l[k][1], l[k][2], l[k][3]}; }
    LDS_WAIT();
    f32x2 o[4];
#pragma unroll
    for (int hq = 0; hq < 4; ++hq) o[hq] = (f32x2){0.f, 0.f};
    const bf16* vp = Vb + 2 * lane; const int cnt4 = (cnt + 3) & ~3;
    for (int j = 0; j < cnt4; j += 4) {
        unsigned w[4]; f32x4 p4[4];
#pragma unroll
        for (int u = 0; u < 4; ++u) { const int key = __builtin_amdgcn_readfirstlane(idxl[j + u]); w[u] = *(const unsigned*)(vp + (size_t)key * KVW); p4[u] = *(const LAS f32x4*)(lg + 4 * (j + u)); }
#pragma unroll
        for (int u = 0; u < 4; ++u) { const f32x2 vv = (f32x2){bf_lo(w[u]), bf_hi(w[u])};
#pragma unroll
            for (int hq = 0; hq < 4; ++hq) o[hq] += p4[u][hq] * vv; }
    }
#pragma unroll
    for (int hq = 0; hq < 4; ++hq) *(unsigned*)(OB + (size_t)row * DM + (4 * g + hq) * HD + 2 * lane) = pk2(o[hq].x, o[hq].y);
    LDS_WAIT();
}
__device__ __forceinline__ void sattn_phase(const Ctx& C, const float* rel_bias, const bf16* QB, const bf16* KAP, const bf16* VAP, const bf16* KAS, const bf16* VAS, const int* IDX, const int* CNT, bf16* OB) {
    LAS float* biasl = (LAS float*)C.lds;
    LAS int* idxl = (LAS int*)(C.lds + 2048 + C.wave * 5120); LAS float* lg = (LAS float*)(C.lds + 2048 + C.wave * 5120 + 1024);
    if (C.tid < 512) biasl[C.tid] = rel_bias[C.tid];
    __syncthreads();
    const int x8 = C.bx & 7, g = x8 & 3, par = x8 >> 2, wi = (C.bx >> 3) * NWAVES + C.wave, nw = (C.G >> 3) * NWAVES;
    for (int k = wi; k < SEQ + 512; k += nw) {
        if (k < SEQ) { const int row = par * SEQ + k;
            sattn_task(row, g, k, KAP + (size_t)par * SEQ * KVW + g * HD, VAP + (size_t)par * SEQ * KVW + g * HD, CNT[row], IDX + (size_t)row * TOPK, QB, OB, idxl, lg, biasl, C.lane); }
        else { const int j = k - SEQ, b = 2 * (j >> 6) + par, i = j & 63, row = MP + b * DECS + i;
            sattn_task(row, g, PAST + i, KAS + (size_t)b * SALL * KVW + g * HD, VAS + (size_t)b * SALL * KVW + g * HD, CNT[row], IDX + (size_t)row * TOPK, QB, OB, idxl, lg, biasl, C.lane); }
    }
}

constexpr int VT_PITCH = 72;
__device__ __forceinline__ bf16x8 pack8(const f32x4& a, const f32x4& b) { v4u w; w.x = pk2(a.x, a.y); w.y = pk2(a.z, a.w); w.z = pk2(b.x, b.y); w.w = pk2(b.z, b.w); return __builtin_bit_cast(bf16x8, w); }
__device__ __forceinline__ const float* sb_rowp(bool samp, int b, int s, int h, const float* newp, const float* cache) {
    if (!samp) return newp + (size_t)(b * SEQ + s) * DM + h * HD;
    if (s < PAST) return cache + ((size_t)(b * PAST + s) * 16 + h) * HD;
    return newp + (size_t)(b * DECS + (s - PAST)) * DM + h * HD;
}
__device__ __forceinline__ void sb_task(bool samp, int b, int h, int qpos0, int r0, const bf16* QB, const float* knew, const float* vnew, const float* kcache, const float* vcache, bf16* OB, LAS unsigned char* vt, int lane) {
    const int q = lane & 31, hh = lane >> 5;
    bf16x8 qf[8];
    { const bf16* qp = QB + (size_t)(r0 + q) * DM + h * HD + 8 * hh;
#pragma unroll
      for (int kk = 0; kk < 8; ++kk) qf[kk] = *(const bf16x8*)(qp + 16 * kk); }
    f32x16 O[4];
#pragma unroll
    for (int db = 0; db < 4; ++db)
#pragma unroll
        for (int r = 0; r < 16; ++r) O[db][r] = 0.f;
    float R = 1.f; const int t = qpos0 + q;
    for (int kt = qpos0 >> 5; kt >= 0; --kt) {
        const float* kb = sb_rowp(samp, b, 32 * kt, h, knew, kcache); const float* vb = sb_rowp(samp, b, 32 * kt, h, vnew, vcache);
        f32x16 c;
#pragma unroll
        for (int r = 0; r < 16; ++r) c[r] = 0.f;
        { const float* kl = kb + (size_t)q * DM + 8 * hh;
#pragma unroll
          for (int kk = 0; kk < 8; ++kk) { const f32x4 a = *(const f32x4*)(kl + 16 * kk), bq = *(const f32x4*)(kl + 16 * kk + 4); c = MFMA32(pack8(a, bq), qf[kk], c); } }
        { const int d4 = lane & 31, kq = lane >> 5;
#pragma unroll
          for (int i = 0; i < 8; ++i) { const int kp = kq + 2 * i; const float* v0p = vb + (size_t)(2 * kp) * DM + 4 * d4; const f32x4 va = *(const f32x4*)v0p, vb2 = *(const f32x4*)(v0p + DM);
#pragma unroll
              for (int e = 0; e < 4; ++e) *(LAS unsigned*)(vt + (4 * d4 + e) * VT_PITCH + 4 * kp) = pk2(va[e], vb2[e]); } }
        float om[16], be[16];
#pragma unroll
        for (int r = 0; r < 16; ++r) { const int s = 32 * kt + crow(r, hh); const float z = c[r] * QK_SCALE; const float a = __expf(-__builtin_fabsf(z)); const float rr = __builtin_amdgcn_rcpf(1.0f + a), ar = a * rr;
            const bool m = s < t; const float beta = z > 0.f ? rr : ar, omb = z > 0.f ? ar : rr; om[r] = m ? omb : 1.f; be[r] = m ? beta : 0.f; }
        float pg[4], pp[4], tt[4];
#pragma unroll
        for (int gi = 0; gi < 4; ++gi) { pg[gi] = (om[4 * gi] * om[4 * gi + 1]) * (om[4 * gi + 2] * om[4 * gi + 3]); pp[gi] = __shfl_xor(pg[gi], 32); tt[gi] = pg[gi] * pp[gi]; }
        float SB[4]; SB[3] = 1.f; SB[2] = tt[3]; SB[1] = tt[3] * tt[2]; SB[0] = SB[1] * tt[1];
        float A[16];
#pragma unroll
        for (int gi = 0; gi < 4; ++gi) { const float s3 = R * SB[gi] * (hh == 0 ? pp[gi] : 1.f), s2 = s3 * om[4 * gi + 3], s1 = s2 * om[4 * gi + 2], s0 = s1 * om[4 * gi + 1];
            A[4 * gi + 3] = be[4 * gi + 3] * s3; A[4 * gi + 2] = be[4 * gi + 2] * s2; A[4 * gi + 1] = be[4 * gi + 1] * s1; A[4 * gi] = be[4 * gi] * s0; }
        R = R * (SB[0] * tt[0]);
        bf16x8 pf[2];
#pragma unroll
        for (int s = 0; s < 2; ++s) { v4u w; w.x = pk2(A[8 * s], A[8 * s + 1]); w.y = pk2(A[8 * s + 2], A[8 * s + 3]); w.z = pk2(A[8 * s + 4], A[8 * s + 5]); w.w = pk2(A[8 * s + 6], A[8 * s + 7]); pf[s] = __builtin_bit_cast(bf16x8, w); }
        LDS_WAIT();
#pragma unroll
        for (int db = 0; db < 4; ++db)
#pragma unroll
            for (int s = 0; s < 2; ++s) { const LAS unsigned char* ap = vt + (32 * db + q) * VT_PITCH + (16 * s + 4 * hh) * 2; const v2u lo = *(const LAS v2u*)ap, hi2 = *(const LAS v2u*)(ap + 16);
                v4u w; w.x = lo.x; w.y = lo.y; w.z = hi2.x; w.w = hi2.y; O[db] = MFMA32(__builtin_bit_cast(bf16x8, w), pf[s], O[db]); }
        LDS_WAIT();
        if (__all(R == 0.f)) break;
    }
#pragma unroll
    for (int db = 0; db < 4; ++db)
#pragma unroll
        for (int rg = 0; rg < 4; ++rg) { v2u w; w.x = pk2(O[db][4 * rg], O[db][4 * rg + 1]); w.y = pk2(O[db][4 * rg + 2], O[db][4 * rg + 3]);
            *(v2u*)(OB + (size_t)(r0 + q) * DM + h * HD + 32 * db + 8 * rg + 4 * hh) = w; }
}
__device__ __forceinline__ void sbattn_phase(const Ctx& C, const bf16* QB, float* out, const float* kcache, const float* vcache, bf16* OB) {
    LAS unsigned char* vt = C.lds + C.wave * 9216;
    for (int id = C.gw; id < 8192 + 512; id += C.NGW) {
        if (id < 8192) { const int b = id >> 12, h = (id >> 8) & 15, qt = id & 255; sb_task(false, b, h, qt * 32, b * SEQ + qt * 32, QB, out + O_KBP, out + O_VBP, kcache, vcache, OB, vt, C.lane); }
        else { const int j = id - 8192, b = j >> 5, h = (j >> 1) & 15, hf = j & 1; sb_task(true, b, h, PAST + 32 * hf, MP + b * DECS + 32 * hf, QB, out + O_KBS, out + O_VBS, kcache, vcache, OB, vt, C.lane); }
    }
}

struct Args { const float* in[22]; float* out; unsigned char* ws; int ph_lo, ph_hi; };
__global__ void __launch_bounds__(NTHREADS, 2) mk_fwd(Args args) {
    extern __shared__ __attribute__((aligned(16))) unsigned char lds_raw[];
    Ctx C;
    C.lds = (LAS unsigned char*)lds_raw; C.MISC = (volatile LAS unsigned*)(C.lds + MISC_OFF);
    C.tid = threadIdx.x; C.lane = C.tid & 63; C.wave = __builtin_amdgcn_readfirstlane(C.tid >> 6);
    C.G = gridDim.x; C.bx = blockIdx.x; C.gw = C.bx * NWAVES + C.wave; C.NGW = C.G * NWAVES;
    unsigned char* ws = args.ws; unsigned* ctl = (unsigned*)(ws + WS_CTL); float* out = args.out;
    for (int u = C.tid; u < (LDS_BYTES - LDSCTL_OFF) / 4; u += NTHREADS) ((LAS unsigned*)(C.lds + LDSCTL_OFF))[u] = 0u;
    __syncthreads();
    XcdBarrier bar; bar.bar = ctl + CW_BAR; bar.x = 0; bar.st = nullptr;
    if (!MK_PER_PHASE) bar = xcd_barrier_post(ctl + CW_BAR, C.MISC + 8);
    const int lo = args.ph_lo, hi = args.ph_hi;
#define IN(k) (lo <= (k) && (k) < hi)
#define PH_ON(k) ((MK_PH_MASK >> (k)) & 1u)
#define SEAM(k) do { if (!MK_PER_PHASE && IN(k) && IN((k) + 1)) xcd_barrier(bar); } while (0)
    const float *x_prompt = args.in[0], *x_sample = args.in[1], *cache_k_a = args.in[2], *cache_v_a = args.in[3], *cache_kidx_a = args.in[4], *cache_k_b = args.in[5], *cache_v_b = args.in[6];
    const float *p_prompt = args.in[7], *p_sample = args.in[8], *rel_bias = args.in[9], *w_in_a = args.in[10], *w_out_a = args.in[11], *w_in_b = args.in[12], *w_out_b = args.in[13];
    const float *ln1_g = args.in[14], *ln1_b = args.in[15], *ln2_g = args.in[16], *ln2_b = args.in[17], *w_up = args.in[18], *w_down = args.in[19], *w_ple = args.in[20], *w_ple_gate = args.in[21];
    bf16 *WINA = (bf16*)(ws + WS_WINA), *WOUTA = (bf16*)(ws + WS_WOUTA), *WINB = (bf16*)(ws + WS_WINB), *WOUTB = (bf16*)(ws + WS_WOUTB), *WUP = (bf16*)(ws + WS_WUP), *WDOWN = (bf16*)(ws + WS_WDOWN), *WG = (bf16*)(ws + WS_WG), *WP = (bf16*)(ws + WS_WP);
    bf16 *PB = (bf16*)(ws + WS_PB), *XB = (bf16*)(ws + WS_XB), *X1B = (bf16*)(ws + WS_X1B), *X2B = (bf16*)(ws + WS_X2B), *QB = (bf16*)(ws + WS_QB), *OB = (bf16*)(ws + WS_OB), *QIB = (bf16*)(ws + WS_QIB);
    bf16 *KAP = (bf16*)(ws + WS_KAP), *VAP = (bf16*)(ws + WS_VAP), *KAS = (bf16*)(ws + WS_KAS), *VAS = (bf16*)(ws + WS_VAS), *KIP = (bf16*)(ws + WS_KIP), *KIS = (bf16*)(ws + WS_KIS), *HB = (bf16*)(ws + WS_H);
    float *WI = (float*)(ws + WS_WI), *RES = (float*)(ws + WS_RES), *Y0 = (float*)(ws + WS_Y0), *PW = (float*)(ws + WS_PW), *SCP = (float*)(ws + WS_SCP), *SCS = (float*)(ws + WS_SCS);
    int *IDX = (int*)(ws + WS_IDX), *CNT = (int*)(ws + WS_CNT);

    if (IN(0)) {
        transpose_job(C, w_in_a, DM, NINA, NINA_PAD, WINA); transpose_job(C, w_out_a, DM, DM, DM, WOUTA); transpose_job(C, w_in_b, DM, NINB, NINB, WINB); transpose_job(C, w_out_b, DM, DM, DM, WOUTB);
        for (int l = 0; l < 2; ++l) { transpose_job(C, w_up + (size_t)l * DM * DFF, DM, DFF, DFF, WUP + (size_t)l * DFF * DM); transpose_job(C, w_down + (size_t)l * DFF * DM, DFF, DM, DM, WDOWN + (size_t)l * DM * DFF);
            transpose_job(C, w_ple_gate + (size_t)l * DM * DM, DM, DM, DM, WG + (size_t)l * DM * DM); transpose_job(C, w_ple + (size_t)l * PLE * DM, PLE, DM, DM, WP + (size_t)l * DM * PLE); }
        cvt_job(C, x_prompt, XB, 1, MP * DM, 0, 0); cvt_job(C, x_sample, XB + (size_t)MP * DM, 1, MS * DM, 0, 0);
        for (int l = 0; l < 2; ++l) { cvt_job(C, p_prompt + (size_t)l * MP * PLE, PB + (size_t)l * MT * PLE, 1, MP * PLE, 0, 0); cvt_job(C, p_sample + (size_t)l * MS * PLE, PB + (size_t)l * MT * PLE + (size_t)MP * PLE, 1, MS * PLE, 0, 0); }
        cvt_job(C, cache_k_a, KAS, DECB, PAST * KVW, (size_t)PAST * KVW, (size_t)SALL * KVW); cvt_job(C, cache_v_a, VAS, DECB, PAST * KVW, (size_t)PAST * KVW, (size_t)SALL * KVW);
        cvt_job(C, cache_kidx_a, KIS, DECB, PAST * HD, (size_t)PAST * HD, (size_t)SALL * HD);
    }
    SEAM(0);
#define LAYER_BODY(l) do { \
        const int pb = (l == 0) ? 5 : 13; \
        if (l == 0) { \
            if (IN(1) && PH_ON(1)) { pg8::Gemm g{XB, WINA, MT, NINA_PAD, DM}; pg8::StaticOrder S; S.init(MT, NINA_PAD, C.G, C.bx); \
                pg8::EpiInA E{QB, QIB, KAP, KIP, WI, out}; \
                pg8::gemm_phase<pg8::EpiInA, pg8::StaticOrder, true, true>(C.lds, g, S, E); } \
            SEAM(1); \
            if (IN(2) && PH_ON(2)) scores_phase(C, ctl + CW_QSC, QIB, KIP, KIS, WI, SCP, SCS); \
            SEAM(2); \
            if (IN(3) && PH_ON(3)) select_phase(C, SCP, SCS, IDX, CNT); \
            SEAM(3); \
            if (IN(4) && PH_ON(4)) sattn_phase(C, rel_bias, QB, KAP, VAP, KAS, VAS, IDX, CNT, OB); \
            SEAM(4); \
        } else { \
            if (IN(11) && PH_ON(11)) { pg8::Gemm g{XB, WINB, MT, NINB, DM}; pg8::StaticOrder S; S.init(MT, NINB, C.G, C.bx); \
                pg8::EpiInB E{QB, out}; \
                pg8::gemm_phase<pg8::EpiInB, pg8::StaticOrder, true, true>(C.lds, g, S, E); } \
            SEAM(11); \
            if (IN(12) && PH_ON(12)) sbattn_phase(C, QB, out, cache_k_b, cache_v_b, OB); \
            SEAM(12); \
        } \
        if (IN(pb) && PH_ON(pb)) { pg8::Gemm g{OB, l == 0 ? WOUTA : WOUTB, MT, DM, DM}; pg8::StaticOrder S; S.init(MT, DM, C.G, C.bx); \
            pg8::EpiResid E{l == 0 ? x_prompt : Y0, l == 0 ? x_sample - (size_t)MP * DM : Y0, RES}; \
            pg8::gemm_phase<pg8::EpiResid, pg8::StaticOrder, true, true>(C.lds, g, S, E); } \
        SEAM(pb); \
        if (IN(pb + 1) && PH_ON(pb + 1)) ln_phase(C, RES, X1B, ln1_g + l * DM, ln1_b + l * DM); \
        SEAM(pb + 1); \
        if (IN(pb + 2) && PH_ON(pb + 2)) { pg8::Gemm g{X1B, WUP + (size_t)l * DFF * DM, MT, DFF, DM}; pg8::StaticOrder S; S.init(MT, DFF, C.G, C.bx); \
            pg8::EpiSqRelu E{HB}; \
            pg8::gemm_phase<pg8::EpiSqRelu, pg8::StaticOrder, true, true>(C.lds, g, S, E); } \
        SEAM(pb + 2); \
        if (IN(pb + 3) && PH_ON(pb + 3)) { pg8::Gemm g{HB, WDOWN + (size_t)l * DM * DFF, MT, DM, DFF}; pg8::StaticOrder S; S.init(MT, DM, C.G, C.bx); \
            pg8::EpiResid E{RES, RES, RES}; \
            pg8::gemm_phase<pg8::EpiResid, pg8::StaticOrder, true, true>(C.lds, g, S, E); } \
        SEAM(pb + 3); \
        if (IN(pb + 4) && PH_ON(pb + 4)) ln_phase(C, RES, X2B, ln2_g + l * DM, ln2_b + l * DM); \
        SEAM(pb + 4); \
        if (IN(pb + 5) && PH_ON(pb + 5)) { \
            if (MK_GATE_PART & 1) { int kple = PLE; asm volatile("" : "+s"(kple)); pg8::Gemm g{PB + (size_t)l * MT * PLE, WP + (size_t)l * DM * PLE, MT, DM, kple}; pg8::StaticOrder S; S.init(MT, DM, C.G, C.bx); \
              pg8::EpiStoreF32 E{PW}; \
              pg8::gemm_phase<pg8::EpiStoreF32, pg8::StaticOrder, true, true>(C.lds, g, S, E); } \
            VM_WAIT(); __syncthreads(); \
            if (MK_GATE_PART & 2) { pg8::Gemm g{X2B, WG + (size_t)l * DM * DM, MT, DM, DM}; pg8::StaticOrder S; S.init(MT, DM, C.G, C.bx); \
              pg8::EpiGate E{RES, PW, l == 0 ? Y0 : out + O_Y, l == 0 ? XB : (bf16*)nullptr}; \
              pg8::gemm_phase<pg8::EpiGate, pg8::StaticOrder, true, true>(C.lds, g, S, E); } \
        } \
        SEAM(pb + 5); \
    } while (0)
    LAYER_BODY(0);
    LAYER_BODY(1);
#undef LAYER_BODY
#undef IN
#undef SEAM
}

extern "C" void kernel_launch(void* const* d_in, const int* in_sizes, int n_in, void* d_out, int out_size, void* d_ws, size_t ws_size, hipStream_t stream) {
    static int grid = 0;
    if (grid == 0) {
        if (n_in != 22 || out_size != (int)O_END || ws_size < WS_END) { fprintf(stderr, "kernel_launch: unexpected shapes (n_in %d, out %d, ws %zu)\n", n_in, out_size, ws_size); grid = -1; return; }
        int dev = 0, cus = 0;
        if (hipGetDevice(&dev) != hipSuccess || hipDeviceGetAttribute(&cus, hipDeviceAttributeMultiprocessorCount, dev) != hipSuccess) { grid = -1; return; }
        if (hipFuncSetAttribute((const void*)mk_fwd, hipFuncAttributeMaxDynamicSharedMemorySize, LDS_BYTES) != hipSuccess) { fprintf(stderr, "kernel_launch: hipFuncSetAttribute failed\n"); grid = -1; return; }
        int per_cu = 0;
        if (hipOccupancyMaxActiveBlocksPerMultiprocessor(&per_cu, (const void*)mk_fwd, NTHREADS, LDS_BYTES) != hipSuccess || per_cu < 1) fprintf(stderr, "kernel_launch: occupancy query reports %d\n", per_cu);
        (void)hipGetLastError();
        grid = cus - (cus % 8);
        if (grid < 8) grid = 8;
    }
    if (grid < 0) return;
    if (hipMemsetAsync((char*)d_ws + WS_CTL, 0, CTL_ZERO_BYTES, stream) != hipSuccess) return;
    Args a{};
    for (int i = 0; i < 22; ++i) a.in[i] = (const float*)d_in[i];
    a.out = (float*)d_out; a.ws = (unsigned char*)d_ws;
#if MK_PER_PHASE
    for (int p = 0; p < NPH; ++p) { a.ph_lo = p; a.ph_hi = p + 1; hipLaunchKernelGGL(mk_fwd, dim3(grid), dim3(NTHREADS), LDS_BYTES, stream, a); }
#else
    a.ph_lo = 0; a.ph_hi = NPH;
    hipLaunchKernelGGL(mk_fwd, dim3(grid), dim3(NTHREADS), LDS_BYTES, stream, a);
#endif
}
```

```cpp
#include <hip/hip_runtime.h>
#include <cstdio>
#include <cstdint>
#ifndef MK_PER_PHASE
#define MK_PER_PHASE 0
#endif
#ifndef MK_PH_MASK
#define MK_PH_MASK 0xffffffffu
#endif
constexpr int NWAVES = 8, NTHREADS = 512;
constexpr int DM = 2048, SEQ = 8192, MP = 16384, DECB = 16, DECS = 64, MS = 1024, MT = 17408, PAST = 4096, SALL = 4160;
constexpr int NINA = 5264, NINA_PAD = 5376, NINB = 6144, DFF = 8192, PLE = 256, HD = 128, KVW = 512, TOPK = 256;
constexpr float LN_EPS = 1e-5f, ALPHA = 1.41421356237309515f;
constexpr float QK_SCALE = 0.08838834764831845f;
constexpr float WI_SCALE = 0.25f * 0.08838834764831845f;
constexpr int NPH = 19;

constexpr size_t O_Y = 0;
constexpr size_t O_KAP = (size_t)MT * DM, O_VAP = O_KAP + (size_t)MP * KVW, O_KIP = O_VAP + (size_t)MP * KVW;
constexpr size_t O_KBP = O_KIP + (size_t)MP * HD, O_VBP = O_KBP + (size_t)MP * DM;
constexpr size_t O_KAS = O_VBP + (size_t)MP * DM, O_VAS = O_KAS + (size_t)MS * KVW, O_KIS = O_VAS + (size_t)MS * KVW;
constexpr size_t O_KBS = O_KIS + (size_t)MS * HD, O_VBS = O_KBS + (size_t)MS * DM, O_END = O_VBS + (size_t)MS * DM;
static_assert(O_END == 127008768, "d_out layout");

constexpr size_t MiB = 1u << 20;
constexpr size_t WS_CTL = 0, CTL_ZERO_BYTES = 1 * MiB;
constexpr size_t WS_WINA = 2 * MiB, WS_WOUTA = 23 * MiB, WS_WINB = 31 * MiB, WS_WOUTB = 55 * MiB, WS_WUP = 63 * MiB, WS_WDOWN = 127 * MiB, WS_WG = 191 * MiB, WS_WP = 207 * MiB;
constexpr size_t WS_PB = 210 * MiB, WS_XB = 228 * MiB, WS_X1B = 296 * MiB, WS_X2B = 364 * MiB, WS_QB = 432 * MiB, WS_OB = 500 * MiB, WS_QIB = 568 * MiB;
constexpr size_t WS_KAP = 636 * MiB, WS_VAP = 652 * MiB, WS_KAS = 668 * MiB, WS_VAS = 733 * MiB, WS_KIP = 798 * MiB, WS_KIS = 802 * MiB, WS_WI = 819 * MiB;
constexpr size_t WS_IDX = 821 * MiB, WS_CNT = 838 * MiB, WS_RES = 840 * MiB, WS_Y0 = 976 * MiB, WS_PW = 1112 * MiB, WS_H = 1248 * MiB;
constexpr size_t WS_SCP = 1248 * MiB  , WS_SCS = 1760 * MiB, WS_END = 1777 * MiB;
static_assert(WS_WINA + (size_t)NINA_PAD * DM * 2 <= WS_WOUTA && WS_PB + (size_t)2 * MT * PLE * 2 <= WS_XB && WS_XB + (size_t)MT * DM * 2 <= WS_X1B && WS_KAS + (size_t)DECB * SALL * KVW * 2 <= WS_VAS
              && WS_KIS + (size_t)DECB * SALL * HD * 2 <= WS_WI && WS_WI + (size_t)MT * 16 * 4 <= WS_IDX && WS_IDX + (size_t)MT * TOPK * 4 <= WS_CNT && WS_RES + (size_t)MT * DM * 4 <= WS_Y0
              && WS_H + (size_t)MT * DFF * 2 <= WS_SCS && WS_SCP + (size_t)MP * SEQ * 4 <= WS_SCS && WS_SCS + (size_t)MS * SALL * 4 <= WS_END, "d_ws map");
constexpr size_t D_VAP = (WS_VAP - WS_KAP) / 2, D_KAS = (WS_KAS - WS_KAP) / 2, D_VAS = (WS_VAS - WS_KAP) / 2, D_KIS = (WS_KIS - WS_KIP) / 2;
constexpr int CW_BAR = 4096;
constexpr int CW_QSC = 8192;

constexpr int RING_BYTES = 135168;
constexpr int LDSCTL_OFF = RING_BYTES, MISC_OFF = LDSCTL_OFF + 320;
constexpr int LDS_BYTES = 147456;
static_assert(MISC_OFF + 128 <= LDS_BYTES, "LDS map");

#define GAS __attribute__((address_space(1)))
#define LAS __attribute__((address_space(3)))
typedef unsigned short bf16;
typedef unsigned v4u __attribute__((ext_vector_type(4)));
typedef unsigned v2u __attribute__((ext_vector_type(2)));
typedef float f32x4 __attribute__((ext_vector_type(4)));
typedef float f32x2 __attribute__((ext_vector_type(2)));
typedef float f32x16 __attribute__((ext_vector_type(16)));
typedef short bf16x8 __attribute__((ext_vector_type(8)));
typedef __bf16 bf16x2_t __attribute__((ext_vector_type(2)));
#define LDS_WAIT() asm volatile("s_waitcnt lgkmcnt(0)" ::: "memory")
#define VM_WAIT() asm volatile("s_waitcnt vmcnt(0)" ::: "memory")
__device__ __forceinline__ unsigned pk2(float lo, float hi) { f32x2 v = {lo, hi}; bf16x2_t b = __builtin_convertvector(v, bf16x2_t); return __builtin_bit_cast(unsigned, b); }
__device__ __forceinline__ float bf_lo(unsigned w) { return __uint_as_float(w << 16); }
__device__ __forceinline__ float bf_hi(unsigned w) { return __uint_as_float(w & 0xffff0000u); }
__device__ __forceinline__ float dot2bf(unsigned a, unsigned b, float c) { return __builtin_amdgcn_fdot2_f32_bf16(__builtin_bit_cast(bf16x2_t, a), __builtin_bit_cast(bf16x2_t, b), c, false); }
namespace pg8 {
#define PG8_LAS __attribute__((address_space(3)))
typedef unsigned short bf16_t;
typedef short bf16x8 __attribute__((ext_vector_type(8)));
typedef float f32x4 __attribute__((ext_vector_type(4)));
typedef unsigned u32x4 __attribute__((ext_vector_type(4)));
constexpr int BM = 256, BK = 64, HALF = 128, HTB = HALF * BK * 2  , STAGE_BYTES = 8 * HTB, NXCD = 8, WGM = 8;

__host__ __device__ __forceinline__ int lds_byte(int r, int c) { const int st = (r >> 4) * 2 + (c >> 5), rr = r & 15, cc = c & 31, ob = rr * 64 + cc * 2; return st * 1024 + (ob ^ (((ob >> 9) & 1) << 5)); }
__host__ __device__ __forceinline__ void stage_rc(int b, int& R, int& C) { const int st = b / 1024, sb = b % 1024, swz = sb ^ (((sb >> 9) & 1) << 5); R = (st >> 1) * 16 + swz / 64; C = (st & 1) * 32 + (swz % 64) / 2; }
__host__ __device__ __forceinline__ int perm32(int rho) { const int n = rho >> 4, i = rho & 15; return 8 * (i >> 2) + 4 * n + (i & 3); }

struct Unit { int pm, pn; };
struct Gemm { const bf16_t* A; const bf16_t* Bt; int M, N, K; };

struct StaticOrder {
    int nM, nN, nwg, G, c;
    __host__ __device__ void init(int M, int N, int G_, int c_) { nM = M / BM; nN = N / BM; nwg = nM * nN; G = G_; c = c_; }
    __host__ __device__ bool next(int i, Unit& u) const {
        const long L = (long)i * G + c; if (L >= nwg) return false;
        int wgid = (int)L; { const int q = nwg / NXCD, r = nwg % NXCD, xcd = wgid % NXCD, off = wgid / NXCD; wgid = (xcd < r ? xcd * (q + 1) : r * (q + 1) + (xcd - r) * q) + off; }
        const int nig = WGM * nN, gid = wgid / nig, fm = gid * WGM, gsz = (nM - fm) < WGM ? (nM - fm) : WGM;
        u.pm = fm + ((wgid % nig) % gsz); u.pn = (wgid % nig) / gsz; return true;
    }
    __device__ __forceinline__ void a_ready(const Unit&) const {}
    __device__ __forceinline__ void done(const Unit&) const {}
};

__device__ __forceinline__ unsigned cvt_pk_bf16(float lo, float hi) { unsigned r; asm volatile("v_cvt_pk_bf16_f32 %0, %1, %2" : "=v"(r) : "v"(lo), "v"(hi)); return r; }
typedef float f32x2 __attribute__((ext_vector_type(2)));
__device__ __forceinline__ void st_bf16x8(bf16_t* p, const f32x4& a, const f32x4& b) { u32x4 w; w.x = ::pk2(a[0], a[1]); w.y = ::pk2(a[2], a[3]); w.z = ::pk2(b[0], b[1]); w.w = ::pk2(b[2], b[3]); *(u32x4*)p = w; }
__device__ __forceinline__ void st_f32x8(float* p, const f32x4& a, const f32x4& b) { *(f32x4*)p = a; *(f32x4*)(p + 4) = b; }
#define PG8_EPI_LOOP(...) \
    _Pragma("unroll") for (int ai = 0; ai < 2; ++ai) _Pragma("unroll") for (int m = 0; m < 4; ++m) { const int row = u.pm * BM + ai * HALF + wr * 64 + m * 16 + fr; \
        _Pragma("unroll") for (int bj = 0; bj < 2; ++bj) { const int cl = bj * HALF + wc * 32 + 8 * fq; const f32x4 v0 = acc[ai][bj][m][0], v1 = acc[ai][bj][m][1]; __VA_ARGS__ } }
#define PG8_EPI_LOOP_F(...) \
    _Pragma("unroll") for (int ai = 0; ai < 2; ++ai) _Pragma("unroll") for (int m = 0; m < 4; ++m) { const int row = u.pm * BM + ai * HALF + wr * 64 + m * 16 + fr; \
        _Pragma("unroll") for (int bj = 0; bj < 2; ++bj) { const int cl = bj * HALF + wc * 32 + 8 * fq; const f32x4 v0 = acc[ai][bj][m][0], v1 = acc[ai][bj][m][1]; __VA_ARGS__ } asm volatile("" ::: "memory"); }

struct EpiInA {
    static constexpr bool PERM = true, AFTER_DRAIN = false;
    bf16_t *Q, *QI, *KAP, *KIP; float* WI; float* out;
    __device__ __forceinline__ void operator()(const f32x4 (&acc)[2][2][4][2], const Unit& u, int wr, int wc, int fr, int fq) const {
        const int pn = u.pn; const bool samp = u.pm >= 64;
        float* fb = nullptr; bf16_t* bb; int ld; bool remap = false;
        if (pn < 8) { bb = Q + pn * BM; ld = ::DM; }
        else if (pn < 12) { const bool isv = pn >= 10; const int c0 = (pn & 1) * BM; ld = ::KVW; remap = samp;
            fb = out + (samp ? (isv ? ::O_VAS : ::O_KAS) - (size_t)::MP * ::KVW : (isv ? ::O_VAP : ::O_KAP)) + c0;
            bb = KAP + (samp ? (isv ? ::D_VAS : ::D_KAS) : (isv ? ::D_VAP : (size_t)0)) + c0; }
        else if (pn < 20) { bb = QI + (pn - 12) * BM; ld = ::DM; }
        else { ld = ::HD; remap = samp; fb = out + (samp ? ::O_KIS - (size_t)::MP * ::HD : ::O_KIP); bb = KIP + (samp ? ::D_KIS : (size_t)0); }
        PG8_EPI_LOOP(
            const int rs = row - ::MP; const size_t brow = remap ? ((size_t)(rs >> 6) * ::SALL + ::PAST + (rs & 63)) : (size_t)row;
            if (pn == 20 && cl >= 128) { if (cl < 144) st_f32x8(WI + (size_t)row * 16 + (cl - 128), v0 * ::WI_SCALE, v1 * ::WI_SCALE); }
            else { if (fb) st_f32x8(fb + (size_t)row * ld + cl, v0, v1); st_bf16x8(bb + brow * ld + cl, v0, v1); }
        )
    }
};
struct EpiInB {
    static constexpr bool PERM = true, AFTER_DRAIN = false;
    bf16_t* Q; float* out;
    __device__ __forceinline__ void operator()(const f32x4 (&acc)[2][2][4][2], const Unit& u, int wr, int wc, int fr, int fq) const {
        const int pn = u.pn; const bool samp = u.pm >= 64;
        PG8_EPI_LOOP(
            if (pn < 8) st_bf16x8(Q + (size_t)row * ::DM + pn * BM + cl, v0, v1);
            else { const bool isv = pn >= 16; const int c = (pn - (isv ? 16 : 8)) * BM + cl;
                float* of = out + (samp ? (isv ? ::O_VBS : ::O_KBS) + (size_t)(row - ::MP) * ::DM : (isv ? ::O_VBP : ::O_KBP) + (size_t)row * ::DM) + c; st_f32x8(of, v0, v1); }
        )
    }
};
struct EpiResid {
    static constexpr bool PERM = true, AFTER_DRAIN = false;
    const float* xa; const float* xb; float* RES;
    __device__ __forceinline__ void operator()(const f32x4 (&acc)[2][2][4][2], const Unit& u, int wr, int wc, int fr, int fq) const {
        const float* xin = (u.pm >= 64) ? xb : xa; const int pn = u.pn;
        PG8_EPI_LOOP_F(
            const size_t off = (size_t)row * ::DM + pn * BM + cl; const f32x4 x0 = *(const f32x4*)(xin + off), x1 = *(const f32x4*)(xin + off + 4);
            st_f32x8(RES + off, x0 * ::ALPHA + v0, x1 * ::ALPHA + v1);
        )
    }
};
struct EpiSqRelu {
    static constexpr bool PERM = true, AFTER_DRAIN = false;
    bf16_t* H;
    __device__ __forceinline__ void operator()(const f32x4 (&acc)[2][2][4][2], const Unit& u, int wr, int wc, int fr, int fq) const {
        const int pn = u.pn;
        PG8_EPI_LOOP(
            f32x4 a = __builtin_elementwise_max(v0, (f32x4){0.f, 0.f, 0.f, 0.f}), b = __builtin_elementwise_max(v1, (f32x4){0.f, 0.f, 0.f, 0.f});
            st_bf16x8(H + (size_t)row * ::DFF + pn * BM + cl, a * a, b * b);
        )
    }
};
struct EpiStoreF32 {
    static constexpr bool PERM = true, AFTER_DRAIN = false;
    float* C;
    __device__ __forceinline__ void operator()(const f32x4 (&acc)[2][2][4][2], const Unit& u, int wr, int wc, int fr, int fq) const {
        const int pn = u.pn;
        PG8_EPI_LOOP( st_f32x8(C + (size_t)row * ::DM + pn * BM + cl, v0, v1); )
    }
};
struct EpiGate {
    static constexpr bool PERM = true, AFTER_DRAIN = false;
    const float* X2; const float* PW; float* Y; bf16_t* YB;
    __device__ __forceinline__ f32x4 sig(const f32x4& v) const { f32x4 r;
#pragma unroll
        for (int i = 0; i < 4; ++i) r[i] = __builtin_amdgcn_rcpf(1.0f + __expf(-v[i])); return r; }
    __device__ __forceinline__ void operator()(const f32x4 (&acc)[2][2][4][2], const Unit& u, int wr, int wc, int fr, int fq) const {
        const int pn = u.pn;
        PG8_EPI_LOOP_F(
            const size_t off = (size_t)row * ::DM + pn * BM + cl;
            const f32x4 y0 = *(const f32x4*)(X2 + off) + sig(v0) * *(const f32x4*)(PW + off), y1 = *(const f32x4*)(X2 + off + 4) + sig(v1) * *(const f32x4*)(PW + off + 4);
            st_f32x8(Y + off, y0, y1); if (YB) st_bf16x8(YB + off, y0, y1);
        )
    }
};
template <class Epi, class Sched, bool ALIGN_EPI = false, bool SP2 = false>
__device__ __forceinline__ void gemm_phase(PG8_LAS unsigned char* lds, const Gemm g, const Sched& S, const Epi& E) {
    const int tid = threadIdx.x, wid = __builtin_amdgcn_readfirstlane(tid >> 6), lane = tid & 63, wr = wid >> 2, wc = wid & 3, fr = lane & 15, fq = lane >> 4;
    const int K = g.K, nt = K / BK;
    unsigned voffA[2], voffB[2];
#pragma unroll
    for (int i = 0; i < 2; ++i) { int R, C; stage_rc(tid * 16 + i * 8192, R, C); const int Rb = Epi::PERM ? ((R & ~31) + perm32(R & 31)) : R;
        voffA[i] = (unsigned)(R * K + C) * 2u; voffB[i] = (unsigned)(Rb * K + C) * 2u; }
    const size_t kstep = (size_t)(BK * 2);
    const size_t hstep = (size_t)HALF * K * 2;
    const size_t tstep = 2 * hstep;
    const unsigned ldsw = (unsigned)wid * 1024u;
    const int aoff = lds_byte(wr * 64 + fr, fq * 8), boff = lds_byte(wc * 32 + fr, fq * 8);
#define PG8_SA(b, h) (((b) * 2 + (h)) * HTB)
#define PG8_SB(b, h) ((4 + (b) * 2 + (h)) * HTB)
#define PG8_STAGE(bufoff, gbase, voff) do { _Pragma("unroll") for (int _i = 0; _i < 2; ++_i) \
        __builtin_amdgcn_global_load_lds((const unsigned*)((const char*)(gbase) + (voff)[_i]), (PG8_LAS unsigned*)(lds + (bufoff) + ldsw + _i * 8192), 16, 0, 0); } while (0)
#define PG8_LDA(dst, b, h) do { _Pragma("unroll") for (int m = 0; m < 4; ++m) _Pragma("unroll") for (int k = 0; k < 2; ++k) dst[m][k] = *(const PG8_LAS bf16x8*)(lds + PG8_SA(b, h) + aoff + m * 2048 + k * 1024); } while (0)
#define PG8_LDB(dst, b, h) do { _Pragma("unroll") for (int n = 0; n < 2; ++n) _Pragma("unroll") for (int k = 0; k < 2; ++k) dst[n][k] = *(const PG8_LAS bf16x8*)(lds + PG8_SB(b, h) + boff + n * 2048 + k * 1024); } while (0)
#define PG8_MMA(ai, bj, At, Bt) do { __builtin_amdgcn_s_setprio(1); _Pragma("unroll") for (int m = 0; m < 4; ++m) _Pragma("unroll") for (int n = 0; n < 2; ++n) _Pragma("unroll") for (int k = 0; k < 2; ++k) \
        acc[ai][bj][m][n] = __builtin_amdgcn_mfma_f32_16x16x32_bf16(Bt[n][k], At[m][k], acc[ai][bj][m][n], 0, 0, 0); __builtin_amdgcn_s_setprio(0); } while (0)
#define PG8_WAIT_V(n) asm volatile("s_waitcnt vmcnt(" #n ")" ::: "memory")
#define PG8_WAIT_L(n) asm volatile("s_waitcnt lgkmcnt(" #n ")" ::: "memory")
#define PG8_BAR __builtin_amdgcn_s_barrier()
#define PG8_SCHED __builtin_amdgcn_sched_barrier(0)
    Unit cur, nxt; int ui = 0;
    if (!S.next(0, cur)) return;
    f32x4 acc[2][2][4][2];
#pragma unroll
    for (int a = 0; a < 2; ++a)
#pragma unroll
        for (int b = 0; b < 2; ++b)
#pragma unroll
            for (int m = 0; m < 4; ++m)
#pragma unroll
                for (int n = 0; n < 2; ++n) acc[a][b][m][n] = (f32x4){0.f, 0.f, 0.f, 0.f};
    bf16x8 At[4][2], B0[2][2], B1[2][2];
    const char* cA = (const char*)g.A + (size_t)cur.pm * tstep; const char* cB = (const char*)g.Bt + (size_t)cur.pn * tstep;
    S.a_ready(cur);
    if constexpr (SP2) {
        PG8_STAGE(PG8_SB(0, 0), cB, voffB); PG8_STAGE(PG8_SB(0, 1), cB + hstep, voffB); PG8_STAGE(PG8_SA(0, 0), cA, voffA); PG8_STAGE(PG8_SA(0, 1), cA + hstep, voffA);
        if (wr == 1) PG8_BAR;
        PG8_WAIT_V(2); PG8_BAR;
        PG8_STAGE(PG8_SB(1, 0), cB + kstep, voffB); PG8_STAGE(PG8_SA(1, 0), cA + kstep, voffA); PG8_STAGE(PG8_SB(1, 1), cB + hstep + kstep, voffB);
        PG8_WAIT_V(6); PG8_BAR;
    } else {
        PG8_STAGE(PG8_SB(0, 0), cB, voffB); PG8_STAGE(PG8_SA(0, 0), cA, voffA); PG8_STAGE(PG8_SB(0, 1), cB + hstep, voffB); PG8_STAGE(PG8_SA(0, 1), cA + hstep, voffA);
        if (wr == 1) PG8_BAR;
        PG8_WAIT_V(4); PG8_BAR;
        PG8_STAGE(PG8_SB(1, 0), cB + kstep, voffB); PG8_STAGE(PG8_SA(1, 0), cA + kstep, voffA); PG8_STAGE(PG8_SB(1, 1), cB + hstep + kstep, voffB);
        PG8_WAIT_V(6); PG8_BAR;
    }
    for (;;) {
        const bool has_next = S.next(ui + 1, nxt);
        const char* nA = has_next ? (const char*)g.A + (size_t)nxt.pm * tstep : cA; const char* nB = has_next ? (const char*)g.Bt + (size_t)nxt.pn * tstep : cB;
        for (int t = 0; t < nt; t += 2) {
            const bool last = (t == nt - 2);
            const char* a1 = cA + (size_t)(t + 1) * kstep;
            const char* a2 = last ? nA : cA + (size_t)(t + 2) * kstep; const char* b2 = last ? nB : cB + (size_t)(t + 2) * kstep;
            const char* a3 = a2 + kstep; const char* b3 = b2 + kstep;
            if (last && has_next) S.a_ready(nxt);
            if constexpr (SP2) {
            PG8_LDB(B0, 0, 0); PG8_LDB(B1, 0, 1); PG8_SCHED; PG8_LDA(At, 0, 0); PG8_STAGE(PG8_SA(1, 1), a1 + hstep, voffA);
            PG8_WAIT_V(8); PG8_WAIT_L(0); PG8_BAR; PG8_MMA(0, 0, At, B0); PG8_MMA(0, 1, At, B1); PG8_BAR; PG8_SCHED;
            PG8_LDA(At, 0, 1); PG8_STAGE(PG8_SB(0, 0), b2, voffB); PG8_STAGE(PG8_SB(0, 1), b2 + hstep, voffB); PG8_STAGE(PG8_SA(0, 0), a2, voffA);
            PG8_WAIT_V(8); PG8_WAIT_L(0); PG8_BAR; PG8_MMA(1, 0, At, B0); PG8_MMA(1, 1, At, B1); PG8_BAR; PG8_SCHED;
            PG8_LDB(B0, 1, 0); PG8_LDB(B1, 1, 1); PG8_SCHED; PG8_LDA(At, 1, 0); PG8_STAGE(PG8_SA(0, 1), a2 + hstep, voffA);
            PG8_WAIT_V(8); PG8_WAIT_L(0); PG8_BAR; PG8_MMA(0, 0, At, B0); PG8_MMA(0, 1, At, B1); PG8_BAR; PG8_SCHED;
            PG8_LDA(At, 1, 1); PG8_STAGE(PG8_SB(1, 0), b3, voffB); PG8_STAGE(PG8_SB(1, 1), b3 + hstep, voffB); PG8_STAGE(PG8_SA(1, 0), a3, voffA);
            PG8_WAIT_V(8); PG8_WAIT_L(0); PG8_BAR; PG8_MMA(1, 0, At, B0); PG8_MMA(1, 1, At, B1); PG8_BAR; PG8_SCHED;
            } else {
            PG8_LDB(B0, 0, 0); PG8_SCHED; PG8_LDA(At, 0, 0); PG8_STAGE(PG8_SA(1, 1), a1 + hstep, voffA);
            PG8_WAIT_L(8); PG8_BAR; PG8_WAIT_L(0); PG8_MMA(0, 0, At, B0); PG8_BAR; PG8_SCHED;
            PG8_LDB(B1, 0, 1); PG8_STAGE(PG8_SB(0, 0), b2, voffB);
            PG8_BAR; PG8_WAIT_L(0); PG8_MMA(0, 1, At, B1); PG8_BAR;
            PG8_LDA(At, 0, 1); PG8_STAGE(PG8_SA(0, 0), a2, voffA);
            PG8_BAR; PG8_WAIT_L(0); PG8_MMA(1, 0, At, B0); PG8_BAR; PG8_SCHED;
            PG8_STAGE(PG8_SB(0, 1), b2 + hstep, voffB);
            PG8_WAIT_V(6); PG8_BAR; PG8_MMA(1, 1, At, B1); PG8_BAR;
            PG8_LDB(B0, 1, 0); PG8_SCHED; PG8_LDA(At, 1, 0); PG8_STAGE(PG8_SA(0, 1), a2 + hstep, voffA);
            PG8_WAIT_L(8); PG8_BAR; PG8_WAIT_L(0); PG8_MMA(0, 0, At, B0); PG8_BAR; PG8_SCHED;
            PG8_LDB(B1, 1, 1); PG8_STAGE(PG8_SB(1, 0), b3, voffB);
            PG8_BAR; PG8_WAIT_L(0); PG8_MMA(0, 1, At, B1); PG8_BAR;
            PG8_LDA(At, 1, 1); PG8_STAGE(PG8_SA(1, 0), a3, voffA);
            PG8_BAR; PG8_WAIT_L(0); PG8_MMA(1, 0, At, B0); PG8_BAR; PG8_SCHED;
            PG8_STAGE(PG8_SB(1, 1), b3 + hstep, voffB);
            PG8_WAIT_V(6); PG8_BAR; PG8_MMA(1, 1, At, B1); PG8_BAR;
            }
        }
        if constexpr (ALIGN_EPI) { if (wr == 0) PG8_BAR; }
        if constexpr (!Epi::AFTER_DRAIN) { E(acc, cur, wr, wc, fr, fq); S.done(cur); }
        if (!has_next) break;
#pragma unroll
        for (int a = 0; a < 2; ++a)
#pragma unroll
            for (int b = 0; b < 2; ++b)
#pragma unroll
                for (int m = 0; m < 4; ++m)
#pragma unroll
                    for (int n = 0; n < 2; ++n) acc[a][b][m][n] = (f32x4){0.f, 0.f, 0.f, 0.f};
        cur = nxt; cA = nA; cB = nB; ++ui;
        if constexpr (ALIGN_EPI) { if (wr == 1) PG8_BAR; }
    }
    PG8_WAIT_V(0);
    if constexpr (!ALIGN_EPI) { if (wr == 0) PG8_BAR; }
    PG8_BAR;
    if constexpr (Epi::AFTER_DRAIN) { E.fused(acc, cur, wr, wc, fr, fq, lds, wid, lane); S.done(cur); }
#undef PG8_SA
#undef PG8_SB
#undef PG8_STAGE
#undef PG8_LDA
#undef PG8_LDB
#undef PG8_MMA
#undef PG8_WAIT_V
#undef PG8_WAIT_L
#undef PG8_BAR
#undef PG8_SCHED
}
}
#define XB_TMO      128
#define XB_XCNT(j)  (256  + 64 * (j))
#define XB_XSUB(j)  (1280 + 64 * (j))
#define XB_XGEN(j)  (2304 + 64 * (j))
#define XB_TOP      3328
#define XB_TOPGEN   3392
#define XCD_BAR_WORDS 3456
#define XB_SPIN_CAP (1u << 18)

__device__ __forceinline__ unsigned xb_ld(unsigned* p)              { return __hip_atomic_load(p, __ATOMIC_RELAXED, __HIP_MEMORY_SCOPE_AGENT); }
__device__ __forceinline__ unsigned xb_add(unsigned* p, unsigned v) { return __hip_atomic_fetch_add(p, v, __ATOMIC_RELAXED, __HIP_MEMORY_SCOPE_AGENT); }
__device__ __forceinline__ unsigned xb_xcc_id() { return (unsigned)__builtin_amdgcn_s_getreg((3 << 11) | 20) & 0xFu; }
#define XB_SPIN(cond, bar) do { unsigned _sp = 0; while (cond) { __builtin_amdgcn_s_sleep(1); \
    if ((++_sp & 255u) == 0u) { if (xb_ld(&(bar)[XB_TMO])) break; if (_sp > XB_SPIN_CAP) { atomicAdd(&(bar)[XB_TMO], 1u); break; } } } } while (0)

struct XcdBarrier {
    unsigned* bar; unsigned x;
    volatile LAS unsigned* st;
};

__device__ __forceinline__ XcdBarrier xcd_barrier_post(unsigned* bar, volatile LAS unsigned* st) {
    XcdBarrier b; b.bar = bar; b.x = xb_xcc_id(); b.st = st;
    if (threadIdx.x == 0) (void)xb_add(&bar[XB_XCNT(b.x)], 1u);
    return b;
}
__device__ __forceinline__ void xcd_barrier_complete(unsigned* bar, unsigned x, unsigned& nloc, unsigned& nx) {
    const unsigned G = gridDim.x * gridDim.y * gridDim.z;
    unsigned sum, cnt, mine, sp = 0u;
    for (;;) {
        sum = 0u; cnt = 0u; mine = 0u;
#pragma unroll
        for (unsigned j = 0; j < 16; ++j) { const unsigned c = xb_ld(&bar[XB_XCNT(j)]); sum += c; cnt += (c > 0u) ? 1u : 0u; mine = (j == x) ? c : mine; }
        if (sum == G) break;
        __builtin_amdgcn_s_sleep(1);
        if ((++sp & 255u) == 0u) { if (xb_ld(&bar[XB_TMO])) break; if (sp > XB_SPIN_CAP) { atomicAdd(&bar[XB_TMO], 1u); break; } }
    }
    nloc = mine > 0u ? mine : 1u; nx = cnt > 0u ? cnt : 1u;
}

__device__ __forceinline__ void xcd_barrier(const XcdBarrier& b) {
    asm volatile("s_waitcnt vmcnt(0)" ::: "memory");
    __syncthreads();
    if (threadIdx.x == 0) {
        unsigned* bar = b.bar;
        __builtin_amdgcn_s_waitcnt(0);
        unsigned nloc = b.st[0], nx = b.st[1];
        if (nloc == 0u) { xcd_barrier_complete(bar, b.x, nloc, nx); b.st[0] = nloc; b.st[1] = nx; }
        const unsigned old = xb_add(&bar[XB_XSUB(b.x)], 1u);
        const unsigned gen = old / nloc;
        if (old + 1u == (gen + 1u) * nloc) {
            __builtin_amdgcn_fence(__ATOMIC_RELEASE, "agent");
            asm volatile("s_waitcnt vmcnt(0)" ::: "memory");
            const unsigned og = xb_add(&bar[XB_TOP], 1u);
            const unsigned tg = og / nx;
            if (og + 1u == (tg + 1u) * nx) xb_add(&bar[XB_TOPGEN], 1u);
            else XB_SPIN(xb_ld(&bar[XB_TOPGEN]) == tg, bar);
            __builtin_amdgcn_fence(__ATOMIC_ACQUIRE, "agent");
            xb_add(&bar[XB_XGEN(b.x)], 1u);
            asm volatile("s_waitcnt vmcnt(0)" ::: "memory");
        } else {
            XB_SPIN(xb_ld(&bar[XB_XGEN(b.x)]) == gen, bar);
            __builtin_amdgcn_fence(__ATOMIC_ACQUIRE, "agent");
            asm volatile("s_waitcnt vmcnt(0)" ::: "memory");
        }
    }
    __syncthreads();
}
#ifndef MK_PROBE
#define MK_PROBE 0
#endif
#define NREP(bit) (((MK_PROBE >> (bit)) & 1) ? 2 : 1)
#define NREP2(b1, b2) ((((MK_PROBE >> (b1)) | (MK_PROBE >> (b2))) & 1) ? 2 : 1)
#ifndef MK_GATE_PART
#define MK_GATE_PART 3
#endif
typedef GAS unsigned gu32;
#define RLX_AGENT __ATOMIC_RELAXED, __HIP_MEMORY_SCOPE_AGENT
#define MFMA32(a, b, c) __builtin_amdgcn_mfma_f32_32x32x16_bf16((a), (b), (c), 0, 0, 0)

struct Ctx { LAS unsigned char* lds; volatile LAS unsigned* MISC; int tid, lane, wave, G, bx, gw, NGW; };
__device__ __forceinline__ int crow(int r, int hi) { return (r & 3) + 8 * (r >> 2) + 4 * hi; }

__device__ __forceinline__ void p0_transpose_item(const float* W, int K, int N, int NP, bf16* WT, LAS float* scr, int item, int lane) {
    const int nblk = NP / 32, kb = item / nblk, nb = item % nblk, k0 = 64 * kb, n0 = 32 * nb;
    const int nn = n0 + (lane & 31);
#pragma unroll 8
    for (int i = 0; i < 32; ++i) { const int kk = 2 * i + (lane >> 5); scr[kk * 33 + (lane & 31)] = (nn < N) ? W[(size_t)(k0 + kk) * N + nn] : 0.f; }
    LDS_WAIT();
    const int c = lane & 7;
#pragma unroll
    for (int j = 0; j < 4; ++j) { const int n = (lane >> 3) + 8 * j; const LAS float* s = scr + (8 * c) * 33 + n;
        v4u o; o.x = pk2(s[0 * 33], s[1 * 33]); o.y = pk2(s[2 * 33], s[3 * 33]); o.z = pk2(s[4 * 33], s[5 * 33]); o.w = pk2(s[6 * 33], s[7 * 33]);
        *(v4u*)(WT + (size_t)(n0 + n) * K + k0 + 8 * c) = o; }
    LDS_WAIT();
}
__device__ __forceinline__ void transpose_job(const Ctx& C, const float* W, int K, int N, int NP, bf16* WT) {
    LAS float* scr = (LAS float*)(C.lds + C.wave * 16384);
    const int nitems = (K / 64) * (NP / 32);
    for (int it = C.gw; it < nitems; it += C.NGW) p0_transpose_item(W, K, N, NP, WT, scr, it, C.lane);
}
__device__ __forceinline__ void cvt_job(const Ctx& C, const float* src, bf16* dst, int nseg, int seglen, size_t sstride, size_t dstride) {
    const int vps = seglen / 8; const long total = (long)nseg * vps; const long NGT = (long)C.G * NTHREADS;
    for (long i = (long)C.bx * NTHREADS + C.tid; i < total; i += NGT) { const int seg = (int)(i / vps), off = (int)(i % vps) * 8;
        const f32x4 a = *(const f32x4*)(src + seg * sstride + off), b = *(const f32x4*)(src + seg * sstride + off + 4);
        v4u o; o.x = pk2(a.x, a.y); o.y = pk2(a.z, a.w); o.z = pk2(b.x, b.y); o.w = pk2(b.z, b.w); *(v4u*)(dst + seg * dstride + off) = o; }
}

__device__ __forceinline__ float wave_sum(float v) {
#pragma unroll
    for (int o = 1; o < 64; o <<= 1) v += __shfl_xor(v, o);
    return v;
}
__device__ __forceinline__ void ln_phase(const Ctx& C, float* RES, bf16* XO, const float* g, const float* b) {
    for (int row = C.gw; row < MT; row += C.NGW) {
        f32x4* xr = (f32x4*)(RES + (size_t)row * DM) + C.lane;
        f32x4 v[8]; float s = 0.f;
#pragma unroll
        for (int j = 0; j < 8; ++j) { v[j] = xr[64 * j]; s += (v[j].x + v[j].y) + (v[j].z + v[j].w); }
        const float mean = wave_sum(s) * (1.f / DM); float s2 = 0.f;
#pragma unroll
        for (int j = 0; j < 8; ++j) { v[j] = v[j] - mean; s2 += (v[j].x * v[j].x + v[j].y * v[j].y) + (v[j].z * v[j].z + v[j].w * v[j].w); }
        const float rstd = 1.f / sqrtf(wave_sum(s2) * (1.f / DM) + LN_EPS);
        v2u* o8 = (v2u*)(XO + (size_t)row * DM) + C.lane;
#pragma unroll
        for (int j = 0; j < 8; ++j) { const f32x4 gg = ((const f32x4*)g)[C.lane + 64 * j], bb = ((const f32x4*)b)[C.lane + 64 * j]; const f32x4 y = v[j] * rstd * gg + bb;
            xr[64 * j] = y; v2u w; w.x = pk2(y.x, y.y); w.y = pk2(y.z, y.w); o8[64 * j] = w; }
    }
}

constexpr int SC_QPITCH = 4112, SC_NITEMS = 160 + 2304;
__device__ __forceinline__ void scores_phase(const Ctx& C, unsigned* qhead, const bf16* QIB, const bf16* KIP, const bf16* KIS, const float* WI, float* SCP, float* SCS) {
    const int q = C.lane & 31, hh = C.lane >> 5;
    for (;;) {
        if (C.tid == 0) C.MISC[0] = __hip_atomic_fetch_add(qhead, 1u, RLX_AGENT);
        __syncthreads();
        int id = (int)C.MISC[0];
        __syncthreads();
        if (id >= SC_NITEMS) break;
        int row0, nk, ch, stride; const bf16* KI; float* SC;
        if (id < 160) { const int qt = id / 5; ch = id % 5; const int rs0 = qt * 32, b = rs0 >> 6; row0 = MP + rs0; KI = KIS + (size_t)b * SALL * HD; nk = SALL; SC = SCS + (size_t)rs0 * SALL; stride = SALL; }
        else { id -= 160; int k = 7; while (id >= 64 * (k + 1)) { id -= 64 * (k + 1); --k; }
            const int per = 4 * (k + 1), ci = id / per, rem = id % per, c = 16 * k + 15 - ci, tile4 = rem / (k + 1); ch = rem % (k + 1);
            const int b = tile4 >> 1, t0 = c * 64 + (tile4 & 1) * 32; row0 = b * SEQ + t0; KI = KIP + (size_t)b * SEQ * HD; nk = 64 * (c + 1); SC = SCP + (size_t)row0 * SEQ; stride = SEQ; }
        const int s_begin = ch * 1024, nkc = (nk - s_begin) < 1024 ? (nk - s_begin) : 1024, ntiles = nkc >> 5;
#pragma unroll 4
        for (int i = 0; i < 16; ++i) { const int p = C.tid + NTHREADS * i, qq = p >> 8, off = (p & 255) * 16;
            const v4u v = *(const v4u*)((const char*)QIB + (size_t)(row0 + qq) * (DM * 2) + off); *(LAS v4u*)(C.lds + qq * SC_QPITCH + off) = v; }
        LAS float* wl = (LAS float*)(C.lds + 32 * SC_QPITCH);
        { const int qq = C.tid >> 4, h2 = C.tid & 15; wl[qq * 17 + h2] = WI[(size_t)(row0 + qq) * 16 + h2]; }
        __syncthreads();
        const LAS unsigned char* qb = C.lds + q * SC_QPITCH + hh * 16;
        for (int ti = C.wave; ti < ntiles; ti += NWAVES) {
            const int s0 = s_begin + ti * 32;
            const bf16* kp = KI + (size_t)(s0 + q) * HD + 8 * hh;
            bf16x8 kf[8];
#pragma unroll
            for (int kk = 0; kk < 8; ++kk) kf[kk] = *(const bf16x8*)(kp + 16 * kk);
            f32x16 acc;
#pragma unroll
            for (int r = 0; r < 16; ++r) acc[r] = 0.f;
#pragma unroll 2
            for (int h = 0; h < 16; ++h) {
                f32x16 c; const float wh = wl[q * 17 + h];
#pragma unroll
                for (int r = 0; r < 16; ++r) c[r] = 0.f;
#pragma unroll
                for (int kk = 0; kk < 8; ++kk) { const bf16x8 bq = *(const LAS bf16x8*)(qb + h * 256 + kk * 32); c = MFMA32(kf[kk], bq, c); }
#pragma unroll
                for (int r = 0; r < 16; ++r) acc[r] += wh * __builtin_fmaxf(c[r], 0.f);
            }
            float* sp = SC + (size_t)q * stride + s0 + 4 * hh;
#pragma unroll
            for (int g = 0; g < 4; ++g) *(f32x4*)(sp + 8 * g) = (f32x4){acc[4 * g], acc[4 * g + 1], acc[4 * g + 2], acc[4 * g + 3]};
        }
        __syncthreads();
    }
}

__device__ __forceinline__ unsigned tokey(float f) { const unsigned u = __float_as_uint(f); return (u & 0x80000000u) ? ~u : (u | 0x80000000u); }
__device__ __forceinline__ void select_phase(const Ctx& C, const float* SCP, const float* SCS, int* IDX, int* CNT) {
    LAS unsigned* hist = (LAS unsigned*)(C.lds + C.wave * 1024);
    const int lane = C.lane; const unsigned long long ltm = (1ull << lane) - 1ull;
    for (int row = C.gw; row < MT; row += C.NGW) {
        int n; const float* sc;
        if (row < MP) { const int t = row & (SEQ - 1); n = 64 * ((t >> 6) + 1); sc = SCP + (size_t)row * SEQ; } else { n = SALL; sc = SCS + (size_t)(row - MP) * SALL; }
        int* ip = IDX + (size_t)row * TOPK;
        if (n <= TOPK) {
#pragma unroll
            for (int k = 0; k < 4; ++k) { const int i = lane + 64 * k; ip[i] = (i < n) ? i : 0; }
            if (lane == 0) CNT[row] = n;
            continue;
        }
        unsigned prefix = 0u, mask = 0u, krem = TOPK;
        for (int pass = 0; pass < 4; ++pass) {
            const int shift = 24 - 8 * pass;
            *(LAS v4u*)(hist + 4 * lane) = (v4u){0u, 0u, 0u, 0u};
            LDS_WAIT();
            for (int i = lane * 4; i < n; i += 256) { const f32x4 v = *(const f32x4*)(sc + i);
#pragma unroll
                for (int e = 0; e < 4; ++e) { const unsigned key = tokey(v[e]); if ((key & mask) == prefix) __hip_atomic_fetch_add(hist + ((key >> shift) & 255u), 1u, __ATOMIC_RELAXED, __HIP_MEMORY_SCOPE_WORKGROUP); } }
            LDS_WAIT();
            const v4u hc = *(const LAS v4u*)(hist + 4 * lane);
            const unsigned tot = hc.x + hc.y + hc.z + hc.w; unsigned x = tot;
#pragma unroll
            for (int o = 1; o < 64; o <<= 1) { const unsigned y = __shfl_down(x, o); if (lane + o < 64) x += y; }
            const unsigned a3 = x - tot, a2 = a3 + hc.w, a1 = a2 + hc.z, a0 = a1 + hc.y;
            int fe = -1; unsigned fa = 0u;
            if (a3 < krem && krem <= a3 + hc.w) { fe = 3; fa = a3; } else if (a2 < krem && krem <= a2 + hc.z) { fe = 2; fa = a2; }
            else if (a1 < krem && krem <= a1 + hc.y) { fe = 1; fa = a1; } else if (a0 < krem && krem <= a0 + hc.x) { fe = 0; fa = a0; }
            const unsigned long long bal = __ballot(fe >= 0); const int src = bal ? (__ffsll((long long)bal) - 1) : 0;
            const unsigned d = (unsigned)__shfl(4 * lane + fe, src), above = (unsigned)__shfl((int)fa, src);
            krem -= above; prefix |= d << shift; mask |= 0xffu << shift;
        }
        int outc = 0, eqs = 0;
        for (int i0 = 0; i0 < n; i0 += 64) { const unsigned key = tokey(sc[i0 + lane]); const bool gt = key > prefix, eq = key == prefix;
            const unsigned long long eqb = __ballot(eq); const int myr = eqs + __popcll(eqb & ltm); const bool sel = gt || (eq && (unsigned)myr < krem); eqs += __popcll(eqb);
            const unsigned long long sb = __ballot(sel); const int pos = outc + __popcll(sb & ltm); if (sel && pos < TOPK) ip[pos] = i0 + lane; outc += __popcll(sb); }
        if (lane == 0) CNT[row] = outc < TOPK ? outc : TOPK;
    }
}

__device__ __forceinline__ int t5_bucket(int n  ) {
    const int ret = (n < 0) ? 16 : 0; n = n < 0 ? -n : n;
    if (n < 8) return ret + n;
    const int lg = 31 - __builtin_clz((unsigned)(n * n));
    const int large = 2 + lg; return ret + (large < 15 ? large : 15);
}
__device__ __forceinline__ float dpp_quad_sum(float t) {
    t += __builtin_bit_cast(float, __builtin_amdgcn_mov_dpp(__builtin_bit_cast(int, t), 0xB1, 0xF, 0xF, true));
    t += __builtin_bit_cast(float, __builtin_amdgcn_mov_dpp(__builtin_bit_cast(int, t), 0x4E, 0xF, 0xF, true));
    return t;
}
__device__ __forceinline__ void sattn_task(int row, int g, int qpos, const bf16* Kb, const bf16* Vb, int cnt, const int* ip, const bf16* QB, bf16* OB,
                                           LAS int* idxl, LAS float* lg, const LAS float* biasl, int lane) {
#pragma unroll
    for (int k = 0; k < 4; ++k) { const int j = lane + 64 * k; const int v = ip[j]; idxl[j] = (j < cnt) ? v : 0; }
    const int kq = lane >> 2, c4 = lane & 3;
    unsigned qreg[4][16];
    { const bf16* qp = QB + (size_t)row * DM + (4 * g) * HD + 32 * c4;
#pragma unroll
      for (int hq = 0; hq < 4; ++hq)
#pragma unroll
          for (int i = 0; i < 4; ++i) { const v4u a = *(const v4u*)(qp + hq * HD + 8 * i); qreg[hq][4 * i] = a.x; qreg[hq][4 * i + 1] = a.y; qreg[hq][4 * i + 2] = a.z; qreg[hq][4 * i + 3] = a.w; } }
    LDS_WAIT();
    for (int r0 = 0; r0 < 16; r0 += 2) {
        v4u kd[2][4];
#pragma unroll
        for (int rr = 0; rr < 2; ++rr) { const int key = idxl[16 * (r0 + rr) + kq]; const bf16* kp = Kb + (size_t)key * KVW + 32 * c4;
#pragma unroll
            for (int i = 0; i < 4; ++i) kd[rr][i] = *(const v4u*)(kp + 8 * i); }
#pragma unroll
        for (int rr = 0; rr < 2; ++rr) { float s[4];
#pragma unroll
            for (int hq = 0; hq < 4; ++hq) { float t = 0.f;
#pragma unroll
                for (int i = 0; i < 4; ++i) { t = dot2bf(kd[rr][i].x, qreg[hq][4 * i], t); t = dot2bf(kd[rr][i].y, qreg[hq][4 * i + 1], t); t = dot2bf(kd[rr][i].z, qreg[hq][4 * i + 2], t); t = dot2bf(kd[rr][i].w, qreg[hq][4 * i + 3], t); }
                s[hq] = dpp_quad_sum(t); }
            const float sv = c4 == 0 ? s[0] : c4 == 1 ? s[1] : c4 == 2 ? s[2] : s[3];
            lg[(16 * (r0 + rr) + kq) * 4 + c4] = sv; }
    }
    LDS_WAIT();
    float l[4][4];
#pragma unroll
    for (int k = 0; k < 4; ++k) { const int j = lane + 64 * k; const f32x4 l4 = *(const LAS f32x4*)(lg + 4 * j); const int key = idxl[j]; const int bk = t5_bucket(qpos - key);
        const f32x4 b4 = *(const LAS f32x4*)(biasl + bk * 16 + 4 * g); const bool valid = j < cnt;
#pragma unroll
        for (int hq = 0; hq < 4; ++hq) l[k][hq] = valid ? l4[hq] * QK_SCALE + b4[hq] : -INFINITY; }
    LDS_WAIT();
#pragma unroll
    for (int hq = 0; hq < 4; ++hq) { float m = __builtin_fmaxf(__builtin_fmaxf(l[0][hq], l[1][hq]), __builtin_fmaxf(l[2][hq], l[3][hq]));
#pragma unroll
        for (int o = 1; o < 64; o <<= 1) m = __builtin_fmaxf(m, __shfl_xor(m, o));
        float sum = 0.f;
#pragma unroll
        for (int k = 0; k < 4; ++k) { l[k][hq] = __expf(l[k][hq] - m); sum += l[k][hq]; }
        sum = wave_sum(sum); const float inv = 1.0f / sum;
#pragma unroll
        for (int k = 0; k < 4; ++k) l[k][hq] *= inv; }
#pragma unroll
    for (int k = 0; k < 4; ++k) { const int j = lane + 64 * k; *(LAS f32x4*)(lg + 4 * j) = (f32x4){l[k][0], l[k][1], l[k][2], l[k][3]}; }
    LDS_WAIT();
    const int ks = lane >> 4, dc = lane & 15;
    f32x2 o[4][4];
#pragma unroll
    for (int hq = 0; hq < 4; ++hq)
#pragma unroll
        for (int i = 0; i < 4; ++i) o[hq][i] = (f32x2){0.f, 0.f};
    const bf16* vp = Vb + 8 * dc;
    for (int jb = 0; jb < TOPK; jb += 32) {
        v4u w[8]; f32x4 p4[8];
#pragma unroll
        for (int u = 0; u < 8; ++u) { const int j = jb + 4 * u + ks; const int key = idxl[j]; w[u] = *(const v4u*)(vp + (size_t)key * KVW); p4[u] = *(const LAS f32x4*)(lg + 4 * j); }
#pragma unroll
        for (int u = 0; u < 8; ++u) { const f32x2 v0 = (f32x2){bf_lo(w[u].x), bf_hi(w[u].x)}, v1 = (f32x2){bf_lo(w[u].y), bf_hi(w[u].y)}, v2 = (f32x2){bf_lo(w[u].z), bf_hi(w[u].z)}, v3 = (f32x2){bf_lo(w[u].w), bf_hi(w[u].w)};
#pragma unroll
            for (int hq = 0; hq < 4; ++hq) { const float ph = p4[u][hq]; o[hq][0] += ph * v0; o[hq][1] += ph * v1; o[hq][2] += ph * v2; o[hq][3] += ph * v3; } }
    }
    v4u st = (v4u){0u, 0u, 0u, 0u};
#pragma unroll
    for (int hq = 0; hq < 4; ++hq) { unsigned pk[4];
#pragma unroll
        for (int i = 0; i < 4; ++i) { float x = o[hq][i].x, y = o[hq][i].y; x += __shfl_xor(x, 16); x += __shfl_xor(x, 32); y += __shfl_xor(y, 16); y += __shfl_xor(y, 32); pk[i] = pk2(x, y); }
        if (ks == hq) st = (v4u){pk[0], pk[1], pk[2], pk[3]}; }
    *(v4u*)(OB + (size_t)row * DM + (4 * g + ks) * HD + 8 * dc) = st;
    LDS_WAIT();
}
__device__ __forceinline__ void sattn_phase(const Ctx& C, const float* rel_bias, const bf16* QB, const bf16* KAP, const bf16* VAP, const bf16* KAS, const bf16* VAS, const int* IDX, const int* CNT, bf16* OB) {
    LAS float* biasl = (LAS float*)C.lds;
    LAS int* idxl = (LAS int*)(C.lds + 2048 + C.wave * 5120); LAS float* lg = (LAS float*)(C.lds + 2048 + C.wave * 5120 + 1024);
    if (C.tid < 512) biasl[C.tid] = rel_bias[C.tid];
    __syncthreads();
    const int x8 = C.bx & 7, g = x8 & 3, par = x8 >> 2, wi = (C.bx >> 3) * NWAVES + C.wave, nw = (C.G >> 3) * NWAVES;
    for (int k = wi; k < SEQ + 512; k += nw) {
        if (k < SEQ) { const int row = par * SEQ + k;
            sattn_task(row, g, k, KAP + (size_t)par * SEQ * KVW + g * HD, VAP + (size_t)par * SEQ * KVW + g * HD, CNT[row], IDX + (size_t)row * TOPK, QB, OB, idxl, lg, biasl, C.lane); }
        else { const int j = k - SEQ, b = 2 * (j >> 6) + par, i = j & 63, row = MP + b * DECS + i;
            sattn_task(row, g, PAST + i, KAS + (size_t)b * SALL * KVW + g * HD, VAS + (size_t)b * SALL * KVW + g * HD, CNT[row], IDX + (size_t)row * TOPK, QB, OB, idxl, lg, biasl, C.lane); }
    }
}

constexpr int VT_PITCH = 72;
__device__ __forceinline__ bf16x8 pack8(const f32x4& a, const f32x4& b) { v4u w; w.x = pk2(a.x, a.y); w.y = pk2(a.z, a.w); w.z = pk2(b.x, b.y); w.w = pk2(b.z, b.w); return __builtin_bit_cast(bf16x8, w); }
__device__ __forceinline__ const float* sb_rowp(bool samp, int b, int s, int h, const float* newp, const float* cache) {
    if (!samp) return newp + (size_t)(b * SEQ + s) * DM + h * HD;
    if (s < PAST) return cache + ((size_t)(b * PAST + s) * 16 + h) * HD;
    return newp + (size_t)(b * DECS + (s - PAST)) * DM + h * HD;
}
__device__ __forceinline__ void sb_task(bool samp, int b, int h, int qpos0, int r0, const bf16* QB, const float* knew, const float* vnew, const float* kcache, const float* vcache, bf16* OB, LAS unsigned char* vt, int lane) {
    const int q = lane & 31, hh = lane >> 5;
    bf16x8 qf[8];
    { const bf16* qp = QB + (size_t)(r0 + q) * DM + h * HD + 8 * hh;
#pragma unroll
      for (int kk = 0; kk < 8; ++kk) qf[kk] = *(const bf16x8*)(qp + 16 * kk); }
    f32x16 O[4];
#pragma unroll
    for (int db = 0; db < 4; ++db)
#pragma unroll
        for (int r = 0; r < 16; ++r) O[db][r] = 0.f;
    float R = 1.f; const int t = qpos0 + q;
    for (int kt = qpos0 >> 5; kt >= 0; --kt) {
        const float* kb = sb_rowp(samp, b, 32 * kt, h, knew, kcache); const float* vb = sb_rowp(samp, b, 32 * kt, h, vnew, vcache);
        f32x16 c;
#pragma unroll
        for (int r = 0; r < 16; ++r) c[r] = 0.f;
        { const float* kl = kb + (size_t)q * DM + 8 * hh;
#pragma unroll
          for (int kk = 0; kk < 8; ++kk) { const f32x4 a = *(const f32x4*)(kl + 16 * kk), bq = *(const f32x4*)(kl + 16 * kk + 4); c = MFMA32(pack8(a, bq), qf[kk], c); } }
        { const int d4 = lane & 31, kq = lane >> 5;
#pragma unroll
          for (int i = 0; i < 8; ++i) { const int kp = kq + 2 * i; const float* v0p = vb + (size_t)(2 * kp) * DM + 4 * d4; const f32x4 va = *(const f32x4*)v0p, vb2 = *(const f32x4*)(v0p + DM);
#pragma unroll
              for (int e = 0; e < 4; ++e) *(LAS unsigned*)(vt + (4 * d4 + e) * VT_PITCH + 4 * kp) = pk2(va[e], vb2[e]); } }
        float om[16], be[16];
#pragma unroll
        for (int r = 0; r < 16; ++r) { const int s = 32 * kt + crow(r, hh); const float z = c[r] * QK_SCALE; const float a = __expf(-__builtin_fabsf(z)); const float rr = __builtin_amdgcn_rcpf(1.0f + a), ar = a * rr;
            const bool m = s < t; const float beta = z > 0.f ? rr : ar, omb = z > 0.f ? ar : rr; om[r] = m ? omb : 1.f; be[r] = m ? beta : 0.f; }
        float pg[4], pp[4], tt[4];
#pragma unroll
        for (int gi = 0; gi < 4; ++gi) { pg[gi] = (om[4 * gi] * om[4 * gi + 1]) * (om[4 * gi + 2] * om[4 * gi + 3]); pp[gi] = __shfl_xor(pg[gi], 32); tt[gi] = pg[gi] * pp[gi]; }
        float SB[4]; SB[3] = 1.f; SB[2] = tt[3]; SB[1] = tt[3] * tt[2]; SB[0] = SB[1] * tt[1];
        float A[16];
#pragma unroll
        for (int gi = 0; gi < 4; ++gi) { const float s3 = R * SB[gi] * (hh == 0 ? pp[gi] : 1.f), s2 = s3 * om[4 * gi + 3], s1 = s2 * om[4 * gi + 2], s0 = s1 * om[4 * gi + 1];
            A[4 * gi + 3] = be[4 * gi + 3] * s3; A[4 * gi + 2] = be[4 * gi + 2] * s2; A[4 * gi + 1] = be[4 * gi + 1] * s1; A[4 * gi] = be[4 * gi] * s0; }
        R = R * (SB[0] * tt[0]);
        bf16x8 pf[2];
#pragma unroll
        for (int s = 0; s < 2; ++s) { v4u w; w.x = pk2(A[8 * s], A[8 * s + 1]); w.y = pk2(A[8 * s + 2], A[8 * s + 3]); w.z = pk2(A[8 * s + 4], A[8 * s + 5]); w.w = pk2(A[8 * s + 6], A[8 * s + 7]); pf[s] = __builtin_bit_cast(bf16x8, w); }
        LDS_WAIT();
#pragma unroll
        for (int db = 0; db < 4; ++db)
#pragma unroll
            for (int s = 0; s < 2; ++s) { const LAS unsigned char* ap = vt + (32 * db + q) * VT_PITCH + (16 * s + 4 * hh) * 2; const v2u lo = *(const LAS v2u*)ap, hi2 = *(const LAS v2u*)(ap + 16);
                v4u w; w.x = lo.x; w.y = lo.y; w.z = hi2.x; w.w = hi2.y; O[db] = MFMA32(__builtin_bit_cast(bf16x8, w), pf[s], O[db]); }
        LDS_WAIT();
        if (__all(R == 0.f)) break;
    }
#pragma unroll
    for (int db = 0; db < 4; ++db)
#pragma unroll
        for (int rg = 0; rg < 4; ++rg) { v2u w; w.x = pk2(O[db][4 * rg], O[db][4 * rg + 1]); w.y = pk2(O[db][4 * rg + 2], O[db][4 * rg + 3]);
            *(v2u*)(OB + (size_t)(r0 + q) * DM + h * HD + 32 * db + 8 * rg + 4 * hh) = w; }
}
__device__ __forceinline__ void sbattn_phase(const Ctx& C, const bf16* QB, float* out, const float* kcache, const float* vcache, bf16* OB) {
    LAS unsigned char* vt = C.lds + C.wave * 9216;
    for (int id = C.gw; id < 8192 + 512; id += C.NGW) {
        if (id < 8192) { const int b = id >> 12, h = (id >> 8) & 15, qt = id & 255; sb_task(false, b, h, qt * 32, b * SEQ + qt * 32, QB, out + O_KBP, out + O_VBP, kcache, vcache, OB, vt, C.lane); }
        else { const int j = id - 8192, b = j >> 5, h = (j >> 1) & 15, hf = j & 1; sb_task(true, b, h, PAST + 32 * hf, MP + b * DECS + 32 * hf, QB, out + O_KBS, out + O_VBS, kcache, vcache, OB, vt, C.lane); }
    }
}

struct Args { const float* in[22]; float* out; unsigned char* ws; int ph_lo, ph_hi; };
__global__ void __launch_bounds__(NTHREADS, 2) mk_fwd(Args args) {
    extern __shared__ __attribute__((aligned(16))) unsigned char lds_raw[];
    Ctx C;
    C.lds = (LAS unsigned char*)lds_raw; C.MISC = (volatile LAS unsigned*)(C.lds + MISC_OFF);
    C.tid = threadIdx.x; C.lane = C.tid & 63; C.wave = __builtin_amdgcn_readfirstlane(C.tid >> 6);
    C.G = gridDim.x; C.bx = blockIdx.x; C.gw = C.bx * NWAVES + C.wave; C.NGW = C.G * NWAVES;
    unsigned char* ws = args.ws; unsigned* ctl = (unsigned*)(ws + WS_CTL); float* out = args.out;
    for (int u = C.tid; u < (LDS_BYTES - LDSCTL_OFF) / 4; u += NTHREADS) ((LAS unsigned*)(C.lds + LDSCTL_OFF))[u] = 0u;
    __syncthreads();
    XcdBarrier bar; bar.bar = ctl + CW_BAR; bar.x = 0; bar.st = nullptr;
    if (!MK_PER_PHASE) bar = xcd_barrier_post(ctl + CW_BAR, C.MISC + 8);
    const int lo = args.ph_lo, hi = args.ph_hi;
#define IN(k) (lo <= (k) && (k) < hi)
#define PH_ON(k) ((MK_PH_MASK >> (k)) & 1u)
#define SEAM(k) do { if (!MK_PER_PHASE && IN(k) && IN((k) + 1)) xcd_barrier(bar); } while (0)
    const float *x_prompt = args.in[0], *x_sample = args.in[1], *cache_k_a = args.in[2], *cache_v_a = args.in[3], *cache_kidx_a = args.in[4], *cache_k_b = args.in[5], *cache_v_b = args.in[6];
    const float *p_prompt = args.in[7], *p_sample = args.in[8], *rel_bias = args.in[9], *w_in_a = args.in[10], *w_out_a = args.in[11], *w_in_b = args.in[12], *w_out_b = args.in[13];
    const float *ln1_g = args.in[14], *ln1_b = args.in[15], *ln2_g = args.in[16], *ln2_b = args.in[17], *w_up = args.in[18], *w_down = args.in[19], *w_ple = args.in[20], *w_ple_gate = args.in[21];
    bf16 *WINA = (bf16*)(ws + WS_WINA), *WOUTA = (bf16*)(ws + WS_WOUTA), *WINB = (bf16*)(ws + WS_WINB), *WOUTB = (bf16*)(ws + WS_WOUTB), *WUP = (bf16*)(ws + WS_WUP), *WDOWN = (bf16*)(ws + WS_WDOWN), *WG = (bf16*)(ws + WS_WG), *WP = (bf16*)(ws + WS_WP);
    bf16 *PB = (bf16*)(ws + WS_PB), *XB = (bf16*)(ws + WS_XB), *X1B = (bf16*)(ws + WS_X1B), *X2B = (bf16*)(ws + WS_X2B), *QB = (bf16*)(ws + WS_QB), *OB = (bf16*)(ws + WS_OB), *QIB = (bf16*)(ws + WS_QIB);
    bf16 *KAP = (bf16*)(ws + WS_KAP), *VAP = (bf16*)(ws + WS_VAP), *KAS = (bf16*)(ws + WS_KAS), *VAS = (bf16*)(ws + WS_VAS), *KIP = (bf16*)(ws + WS_KIP), *KIS = (bf16*)(ws + WS_KIS), *HB = (bf16*)(ws + WS_H);
    float *WI = (float*)(ws + WS_WI), *RES = (float*)(ws + WS_RES), *Y0 = (float*)(ws + WS_Y0), *PW = (float*)(ws + WS_PW), *SCP = (float*)(ws + WS_SCP), *SCS = (float*)(ws + WS_SCS);
    int *IDX = (int*)(ws + WS_IDX), *CNT = (int*)(ws + WS_CNT);

    if (IN(0)) for (int rep_ = 0; rep_ < NREP(2); ++rep_) {
        transpose_job(C, w_in_a, DM, NINA, NINA_PAD, WINA); transpose_job(C, w_out_a, DM, DM, DM, WOUTA); transpose_job(C, w_in_b, DM, NINB, NINB, WINB); transpose_job(C, w_out_b, DM, DM, DM, WOUTB);
        for (int l = 0; l < 2; ++l) { transpose_job(C, w_up + (size_t)l * DM * DFF, DM, DFF, DFF, WUP + (size_t)l * DFF * DM); transpose_job(C, w_down + (size_t)l * DFF * DM, DFF, DM, DM, WDOWN + (size_t)l * DM * DFF);
            transpose_job(C, w_ple_gate + (size_t)l * DM * DM, DM, DM, DM, WG + (size_t)l * DM * DM); transpose_job(C, w_ple + (size_t)l * PLE * DM, PLE, DM, DM, WP + (size_t)l * DM * PLE); }
        cvt_job(C, x_prompt, XB, 1, MP * DM, 0, 0); cvt_job(C, x_sample, XB + (size_t)MP * DM, 1, MS * DM, 0, 0);
        for (int l = 0; l < 2; ++l) { cvt_job(C, p_prompt + (size_t)l * MP * PLE, PB + (size_t)l * MT * PLE, 1, MP * PLE, 0, 0); cvt_job(C, p_sample + (size_t)l * MS * PLE, PB + (size_t)l * MT * PLE + (size_t)MP * PLE, 1, MS * PLE, 0, 0); }
        cvt_job(C, cache_k_a, KAS, DECB, PAST * KVW, (size_t)PAST * KVW, (size_t)SALL * KVW); cvt_job(C, cache_v_a, VAS, DECB, PAST * KVW, (size_t)PAST * KVW, (size_t)SALL * KVW);
        cvt_job(C, cache_kidx_a, KIS, DECB, PAST * HD, (size_t)PAST * HD, (size_t)SALL * HD);
    }
    SEAM(0);
#define LAYER_BODY(l) do { \
        const int pb = (l == 0) ? 5 : 13; \
        if (l == 0) { \
            if (IN(1) && PH_ON(1)) { pg8::Gemm g{XB, WINA, MT, NINA_PAD, DM}; pg8::StaticOrder S; S.init(MT, NINA_PAD, C.G, C.bx); \
                pg8::EpiInA E{QB, QIB, KAP, KIP, WI, out}; \
                pg8::gemm_phase<pg8::EpiInA, pg8::StaticOrder, true, true>(C.lds, g, S, E); if (NREP(0) > 1) { pg8::gemm_phase<pg8::EpiInA, pg8::StaticOrder, true, true>(C.lds, g, S, E); } } \
            SEAM(1); \
            if (IN(2) && PH_ON(2)) for (int rep_ = 0; rep_ < NREP2(1, 4); ++rep_) scores_phase(C, ctl + CW_QSC + 64 * rep_, QIB, KIP, KIS, WI, SCP, SCS); \
            SEAM(2); \
            if (IN(3) && PH_ON(3)) for (int rep_ = 0; rep_ < NREP2(1, 5); ++rep_) select_phase(C, SCP, SCS, IDX, CNT); \
            SEAM(3); \
            if (IN(4) && PH_ON(4)) for (int rep_ = 0; rep_ < NREP2(1, 6); ++rep_) sattn_phase(C, rel_bias, QB, KAP, VAP, KAS, VAS, IDX, CNT, OB); \
            SEAM(4); \
        } else { \
            if (IN(11) && PH_ON(11)) { pg8::Gemm g{XB, WINB, MT, NINB, DM}; pg8::StaticOrder S; S.init(MT, NINB, C.G, C.bx); \
                pg8::EpiInB E{QB, out}; \
                pg8::gemm_phase<pg8::EpiInB, pg8::StaticOrder, true, true>(C.lds, g, S, E); if (NREP(0) > 1) { pg8::gemm_phase<pg8::EpiInB, pg8::StaticOrder, true, true>(C.lds, g, S, E); } } \
            SEAM(11); \
            if (IN(12) && PH_ON(12)) for (int rep_ = 0; rep_ < NREP(3); ++rep_) sbattn_phase(C, QB, out, cache_k_b, cache_v_b, OB); \
            SEAM(12); \
        } \
        if (IN(pb) && PH_ON(pb)) { pg8::Gemm g{OB, l == 0 ? WOUTA : WOUTB, MT, DM, DM}; pg8::StaticOrder S; S.init(MT, DM, C.G, C.bx); \
            pg8::EpiResid E{l == 0 ? x_prompt : Y0, l == 0 ? x_sample - (size_t)MP * DM : Y0, RES}; \
            pg8::gemm_phase<pg8::EpiResid, pg8::StaticOrder, true, true>(C.lds, g, S, E); if (NREP(0) > 1) { pg8::gemm_phase<pg8::EpiResid, pg8::StaticOrder, true, true>(C.lds, g, S, E); } } \
        SEAM(pb); \
        if (IN(pb + 1) && PH_ON(pb + 1)) ln_phase(C, RES, X1B, ln1_g + l * DM, ln1_b + l * DM); \
        SEAM(pb + 1); \
        if (IN(pb + 2) && PH_ON(pb + 2)) { pg8::Gemm g{X1B, WUP + (size_t)l * DFF * DM, MT, DFF, DM}; pg8::StaticOrder S; S.init(MT, DFF, C.G, C.bx); \
            pg8::EpiSqRelu E{HB}; \
            pg8::gemm_phase<pg8::EpiSqRelu, pg8::StaticOrder, true, true>(C.lds, g, S, E); if (NREP(0) > 1) { pg8::gemm_phase<pg8::EpiSqRelu, pg8::StaticOrder, true, true>(C.lds, g, S, E); } } \
        SEAM(pb + 2); \
        if (IN(pb + 3) && PH_ON(pb + 3)) { pg8::Gemm g{HB, WDOWN + (size_t)l * DM * DFF, MT, DM, DFF}; pg8::StaticOrder S; S.init(MT, DM, C.G, C.bx); \
            pg8::EpiResid E{RES, RES, RES}; \
            if (NREP(0) > 1) { pg8::EpiResid E2{RES, RES, PW}; pg8::gemm_phase<pg8::EpiResid, pg8::StaticOrder, true, true>(C.lds, g, S, E2); } pg8::gemm_phase<pg8::EpiResid, pg8::StaticOrder, true, true>(C.lds, g, S, E); } \
        SEAM(pb + 3); \
        if (IN(pb + 4) && PH_ON(pb + 4)) ln_phase(C, RES, X2B, ln2_g + l * DM, ln2_b + l * DM); \
        SEAM(pb + 4); \
        if (IN(pb + 5) && PH_ON(pb + 5)) { \
            if (MK_GATE_PART & 1) { int kple = PLE; asm volatile("" : "+s"(kple)); pg8::Gemm g{PB + (size_t)l * MT * PLE, WP + (size_t)l * DM * PLE, MT, DM, kple}; pg8::StaticOrder S; S.init(MT, DM, C.G, C.bx); \
              pg8::EpiStoreF32 E{PW}; \
              pg8::gemm_phase<pg8::EpiStoreF32, pg8::StaticOrder, true, true>(C.lds, g, S, E); if (NREP(0) > 1) { pg8::gemm_phase<pg8::EpiStoreF32, pg8::StaticOrder, true, true>(C.lds, g, S, E); } } \
            VM_WAIT(); __syncthreads(); \
            if (MK_GATE_PART & 2) { pg8::Gemm g{X2B, WG + (size_t)l * DM * DM, MT, DM, DM}; pg8::StaticOrder S; S.init(MT, DM, C.G, C.bx); \
              pg8::EpiGate E{RES, PW, l == 0 ? Y0 : out + O_Y, l == 0 ? XB : (bf16*)nullptr}; \
              pg8::gemm_phase<pg8::EpiGate, pg8::StaticOrder, true, true>(C.lds, g, S, E); if (NREP(0) > 1) { pg8::gemm_phase<pg8::EpiGate, pg8::StaticOrder, true, true>(C.lds, g, S, E); } } \
        } \
        SEAM(pb + 5); \
    } while (0)
    LAYER_BODY(0);
    LAYER_BODY(1);
#undef LAYER_BODY
#undef IN
#undef SEAM
}

extern "C" void kernel_launch(void* const* d_in, const int* in_sizes, int n_in, void* d_out, int out_size, void* d_ws, size_t ws_size, hipStream_t stream) {
    static int grid = 0;
    if (grid == 0) {
        if (n_in != 22 || out_size != (int)O_END || ws_size < WS_END) { fprintf(stderr, "kernel_launch: unexpected shapes (n_in %d, out %d, ws %zu)\n", n_in, out_size, ws_size); grid = -1; return; }
        int dev = 0, cus = 0;
        if (hipGetDevice(&dev) != hipSuccess || hipDeviceGetAttribute(&cus, hipDeviceAttributeMultiprocessorCount, dev) != hipSuccess) { grid = -1; return; }
        if (hipFuncSetAttribute((const void*)mk_fwd, hipFuncAttributeMaxDynamicSharedMemorySize, LDS_BYTES) != hipSuccess) { fprintf(stderr, "kernel_launch: hipFuncSetAttribute failed\n"); grid = -1; return; }
        int per_cu = 0;
        if (hipOccupancyMaxActiveBlocksPerMultiprocessor(&per_cu, (const void*)mk_fwd, NTHREADS, LDS_BYTES) != hipSuccess || per_cu < 1) fprintf(stderr, "kernel_launch: occupancy query reports %d\n", per_cu);
        (void)hipGetLastError();
        grid = cus - (cus % 8);
        if (grid < 8) grid = 8;
    }
    if (grid < 0) return;
    if (hipMemsetAsync((char*)d_ws + WS_CTL, 0, CTL_ZERO_BYTES, stream) != hipSuccess) return;
    Args a{};
    for (int i = 0; i < 22; ++i) a.in[i] = (const float*)d_in[i];
    a.out = (float*)d_out; a.ws = (unsigned char*)d_ws;
#if MK_PER_PHASE
    for (int p = 0; p < NPH; ++p) { a.ph_lo = p; a.ph_hi = p + 1; hipLaunchKernelGGL(mk_fwd, dim3(grid), dim3(NTHREADS), LDS_BYTES, stream, a); }
#else
    a.ph_lo = 0; a.ph_hi = NPH;
    hipLaunchKernelGGL(mk_fwd, dim3(grid), dim3(NTHREADS), LDS_BYTES, stream, a);
#endif
}
```

```cpp
#include <hip/hip_runtime.h>
#include <cstdio>
#include <cstdint>
#ifndef MK_PER_PHASE
#define MK_PER_PHASE 0
#endif
#ifndef MK_PH_MASK
#define MK_PH_MASK 0xffffffffu
#endif
constexpr int NWAVES = 8, NTHREADS = 512;
constexpr int DM = 2048, SEQ = 8192, MP = 16384, DECB = 16, DECS = 64, MS = 1024, MT = 17408, PAST = 4096, SALL = 4160;
constexpr int NINA = 5264, NINA_PAD = 5376, NINB = 6144, DFF = 8192, PLE = 256, HD = 128, KVW = 512, TOPK = 256;
constexpr float LN_EPS = 1e-5f, ALPHA = 1.41421356237309515f;
constexpr float QK_SCALE = 0.08838834764831845f;
constexpr float WI_SCALE = 0.25f * 0.08838834764831845f;
constexpr int NPH = 19;

constexpr size_t O_Y = 0;
constexpr size_t O_KAP = (size_t)MT * DM, O_VAP = O_KAP + (size_t)MP * KVW, O_KIP = O_VAP + (size_t)MP * KVW;
constexpr size_t O_KBP = O_KIP + (size_t)MP * HD, O_VBP = O_KBP + (size_t)MP * DM;
constexpr size_t O_KAS = O_VBP + (size_t)MP * DM, O_VAS = O_KAS + (size_t)MS * KVW, O_KIS = O_VAS + (size_t)MS * KVW;
constexpr size_t O_KBS = O_KIS + (size_t)MS * HD, O_VBS = O_KBS + (size_t)MS * DM, O_END = O_VBS + (size_t)MS * DM;
static_assert(O_END == 127008768, "d_out layout");

constexpr size_t MiB = 1u << 20;
constexpr size_t WS_CTL = 0, CTL_ZERO_BYTES = 1 * MiB;
constexpr size_t WS_WINA = 2 * MiB, WS_WOUTA = 23 * MiB, WS_WINB = 31 * MiB, WS_WOUTB = 55 * MiB, WS_WUP = 63 * MiB, WS_WDOWN = 127 * MiB, WS_WG = 191 * MiB, WS_WP = 207 * MiB;
constexpr size_t WS_PB = 210 * MiB, WS_XB = 228 * MiB, WS_X1B = 296 * MiB, WS_X2B = 364 * MiB, WS_QB = 432 * MiB, WS_OB = 500 * MiB, WS_QIB = 568 * MiB;
constexpr size_t WS_KAP = 636 * MiB, WS_VAP = 652 * MiB, WS_KAS = 668 * MiB, WS_VAS = 733 * MiB, WS_KIP = 798 * MiB, WS_KIS = 802 * MiB, WS_WI = 819 * MiB;
constexpr size_t WS_IDX = 821 * MiB, WS_CNT = 838 * MiB, WS_RES = 840 * MiB, WS_Y0 = 976 * MiB, WS_PW = 1112 * MiB, WS_H = 1248 * MiB;
constexpr size_t WS_SCP = 1248 * MiB  , WS_SCS = 1760 * MiB, WS_PART = 1778 * MiB  , WS_END = 1842 * MiB;
static_assert(WS_WINA + (size_t)NINA_PAD * DM * 2 <= WS_WOUTA && WS_PB + (size_t)2 * MT * PLE * 2 <= WS_XB && WS_XB + (size_t)MT * DM * 2 <= WS_X1B && WS_KAS + (size_t)DECB * SALL * KVW * 2 <= WS_VAS
              && WS_KIS + (size_t)DECB * SALL * HD * 2 <= WS_WI && WS_WI + (size_t)MT * 16 * 4 <= WS_IDX && WS_IDX + (size_t)MT * TOPK * 4 <= WS_CNT && WS_RES + (size_t)MT * DM * 4 <= WS_Y0
              && WS_H + (size_t)MT * DFF * 2 <= WS_SCS && WS_SCP + (size_t)MP * SEQ * 4 <= WS_SCS && WS_SCS + (size_t)MS * SALL * 4 <= WS_PART && WS_PART + (size_t)8 * MS * DM * 4 <= WS_END, "d_ws map");
constexpr size_t D_VAP = (WS_VAP - WS_KAP) / 2, D_KAS = (WS_KAS - WS_KAP) / 2, D_VAS = (WS_VAS - WS_KAP) / 2, D_KIS = (WS_KIS - WS_KIP) / 2;
constexpr int CW_BAR = 4096;
constexpr int CW_QSC = 8192;

constexpr int RING_BYTES = 135168;
constexpr int LDSCTL_OFF = RING_BYTES, MISC_OFF = LDSCTL_OFF + 320;
constexpr int LDS_BYTES = 147456;
static_assert(MISC_OFF + 128 <= LDS_BYTES, "LDS map");

#define GAS __attribute__((address_space(1)))
#define LAS __attribute__((address_space(3)))
typedef unsigned short bf16;
typedef unsigned v4u __attribute__((ext_vector_type(4)));
typedef unsigned v2u __attribute__((ext_vector_type(2)));
typedef float f32x4 __attribute__((ext_vector_type(4)));
typedef float f32x2 __attribute__((ext_vector_type(2)));
typedef float f32x16 __attribute__((ext_vector_type(16)));
typedef short bf16x8 __attribute__((ext_vector_type(8)));
typedef __bf16 bf16x2_t __attribute__((ext_vector_type(2)));
#define LDS_WAIT() asm volatile("s_waitcnt lgkmcnt(0)" ::: "memory")
#define VM_WAIT() asm volatile("s_waitcnt vmcnt(0)" ::: "memory")
__device__ __forceinline__ unsigned pk2(float lo, float hi) { f32x2 v = {lo, hi}; bf16x2_t b = __builtin_convertvector(v, bf16x2_t); return __builtin_bit_cast(unsigned, b); }
__device__ __forceinline__ float bf_lo(unsigned w) { return __uint_as_float(w << 16); }
__device__ __forceinline__ float bf_hi(unsigned w) { return __uint_as_float(w & 0xffff0000u); }
__device__ __forceinline__ float dot2bf(unsigned a, unsigned b, float c) { return __builtin_amdgcn_fdot2_f32_bf16(__builtin_bit_cast(bf16x2_t, a), __builtin_bit_cast(bf16x2_t, b), c, false); }
namespace pg8 {
#define PG8_LAS __attribute__((address_space(3)))
typedef unsigned short bf16_t;
typedef short bf16x8 __attribute__((ext_vector_type(8)));
typedef float f32x4 __attribute__((ext_vector_type(4)));
typedef unsigned u32x4 __attribute__((ext_vector_type(4)));
constexpr int BM = 256, BK = 64, HALF = 128, HTB = HALF * BK * 2  , STAGE_BYTES = 8 * HTB, NXCD = 8, WGM = 8;

__host__ __device__ __forceinline__ int lds_byte(int r, int c) { const int st = (r >> 4) * 2 + (c >> 5), rr = r & 15, cc = c & 31, ob = rr * 64 + cc * 2; return st * 1024 + (ob ^ (((ob >> 9) & 1) << 5)); }
__host__ __device__ __forceinline__ void stage_rc(int b, int& R, int& C) { const int st = b / 1024, sb = b % 1024, swz = sb ^ (((sb >> 9) & 1) << 5); R = (st >> 1) * 16 + swz / 64; C = (st & 1) * 32 + (swz % 64) / 2; }
__host__ __device__ __forceinline__ int perm32(int rho) { const int n = rho >> 4, i = rho & 15; return 8 * (i >> 2) + 4 * n + (i & 3); }

struct Unit { int pm, pn, ks; };
struct Gemm { const bf16_t* A; const bf16_t* Bt; int M, N, K, ld; };

struct StaticOrder {
    int nM, nN, nwg, G, c;
    __host__ __device__ void init(int M, int N, int G_, int c_) { nM = M / BM; nN = N / BM; nwg = nM * nN; G = G_; c = c_; }
    __host__ __device__ bool next(int i, Unit& u) const {
        const long L = (long)i * G + c; if (L >= nwg) return false;
        int wgid = (int)L; { const int q = nwg / NXCD, r = nwg % NXCD, xcd = wgid % NXCD, off = wgid / NXCD; wgid = (xcd < r ? xcd * (q + 1) : r * (q + 1) + (xcd - r) * q) + off; }
        const int nig = WGM * nN, gid = wgid / nig, fm = gid * WGM, gsz = (nM - fm) < WGM ? (nM - fm) : WGM;
        u.pm = fm + ((wgid % nig) % gsz); u.pn = (wgid % nig) / gsz; u.ks = 0; return true;
    }
    __device__ __forceinline__ void a_ready(const Unit&) const {}
    __device__ __forceinline__ void done(const Unit&) const {}
};

__device__ __forceinline__ unsigned cvt_pk_bf16(float lo, float hi) { unsigned r; asm volatile("v_cvt_pk_bf16_f32 %0, %1, %2" : "=v"(r) : "v"(lo), "v"(hi)); return r; }
typedef float f32x2 __attribute__((ext_vector_type(2)));
__device__ __forceinline__ void st_bf16x8(bf16_t* p, const f32x4& a, const f32x4& b) { u32x4 w; w.x = ::pk2(a[0], a[1]); w.y = ::pk2(a[2], a[3]); w.z = ::pk2(b[0], b[1]); w.w = ::pk2(b[2], b[3]); *(u32x4*)p = w; }
__device__ __forceinline__ void st_f32x8(float* p, const f32x4& a, const f32x4& b) { *(f32x4*)p = a; *(f32x4*)(p + 4) = b; }
#define PG8_EPI_LOOP(...) \
    _Pragma("unroll") for (int ai = 0; ai < 2; ++ai) _Pragma("unroll") for (int m = 0; m < 4; ++m) { const int row = u.pm * BM + ai * HALF + wr * 64 + m * 16 + fr; \
        _Pragma("unroll") for (int bj = 0; bj < 2; ++bj) { const int cl = bj * HALF + wc * 32 + 8 * fq; const f32x4 v0 = acc[ai][bj][m][0], v1 = acc[ai][bj][m][1]; __VA_ARGS__ } }
#define PG8_EPI_LOOP_F(...) \
    _Pragma("unroll") for (int ai = 0; ai < 2; ++ai) _Pragma("unroll") for (int m = 0; m < 4; ++m) { const int row = u.pm * BM + ai * HALF + wr * 64 + m * 16 + fr; \
        _Pragma("unroll") for (int bj = 0; bj < 2; ++bj) { const int cl = bj * HALF + wc * 32 + 8 * fq; const f32x4 v0 = acc[ai][bj][m][0], v1 = acc[ai][bj][m][1]; __VA_ARGS__ } asm volatile("" ::: "memory"); }

struct EpiInA {
    static constexpr bool PERM = true, AFTER_DRAIN = false;
    bf16_t *Q, *QI, *KAP, *KIP; float* WI; float* out;
    __device__ __forceinline__ void operator()(const f32x4 (&acc)[2][2][4][2], const Unit& u, int wr, int wc, int fr, int fq) const {
        const int pn = u.pn; const bool samp = u.pm >= 64;
        float* fb = nullptr; bf16_t* bb; int ld; bool remap = false;
        if (pn < 8) { bb = Q + pn * BM; ld = ::DM; }
        else if (pn < 12) { const bool isv = pn >= 10; const int c0 = (pn & 1) * BM; ld = ::KVW; remap = samp;
            fb = out + (samp ? (isv ? ::O_VAS : ::O_KAS) - (size_t)::MP * ::KVW : (isv ? ::O_VAP : ::O_KAP)) + c0;
            bb = KAP + (samp ? (isv ? ::D_VAS : ::D_KAS) : (isv ? ::D_VAP : (size_t)0)) + c0; }
        else if (pn < 20) { bb = QI + (pn - 12) * BM; ld = ::DM; }
        else { ld = ::HD; remap = samp; fb = out + (samp ? ::O_KIS - (size_t)::MP * ::HD : ::O_KIP); bb = KIP + (samp ? ::D_KIS : (size_t)0); }
        PG8_EPI_LOOP(
            const int rs = row - ::MP; const size_t brow = remap ? ((size_t)(rs >> 6) * ::SALL + ::PAST + (rs & 63)) : (size_t)row;
            if (pn == 20 && cl >= 128) { if (cl < 144) st_f32x8(WI + (size_t)row * 16 + (cl - 128), v0 * ::WI_SCALE, v1 * ::WI_SCALE); }
            else { if (fb) st_f32x8(fb + (size_t)row * ld + cl, v0, v1); st_bf16x8(bb + brow * ld + cl, v0, v1); }
        )
    }
};
struct EpiInB {
    static constexpr bool PERM = true, AFTER_DRAIN = false;
    bf16_t* Q; float* out;
    __device__ __forceinline__ void operator()(const f32x4 (&acc)[2][2][4][2], const Unit& u, int wr, int wc, int fr, int fq) const {
        const int pn = u.pn; const bool samp = u.pm >= 64;
        PG8_EPI_LOOP(
            if (pn < 8) st_bf16x8(Q + (size_t)row * ::DM + pn * BM + cl, v0, v1);
            else { const bool isv = pn >= 16; const int c = (pn - (isv ? 16 : 8)) * BM + cl;
                float* of = out + (samp ? (isv ? ::O_VBS : ::O_KBS) + (size_t)(row - ::MP) * ::DM : (isv ? ::O_VBP : ::O_KBP) + (size_t)row * ::DM) + c; st_f32x8(of, v0, v1); }
        )
    }
};
struct EpiResid {
    static constexpr bool PERM = true, AFTER_DRAIN = false;
    const float* x; float* RES;
    __device__ __forceinline__ void operator()(const f32x4 (&acc)[2][2][4][2], const Unit& u, int wr, int wc, int fr, int fq) const {
        const int pn = u.pn;
        PG8_EPI_LOOP_F(
            const size_t off = (size_t)row * ::DM + pn * BM + cl; const f32x4 x0 = *(const f32x4*)(x + off), x1 = *(const f32x4*)(x + off + 4);
            st_f32x8(RES + off, x0 * ::ALPHA + v0, x1 * ::ALPHA + v1);
        )
    }
};
struct EpiPart {
    static constexpr bool PERM = true, AFTER_DRAIN = false;
    float* PART;
    __device__ __forceinline__ void operator()(const f32x4 (&acc)[2][2][4][2], const Unit& u, int wr, int wc, int fr, int fq) const {
        const int pn = u.pn; float* base = PART + (size_t)u.ks * ::MS * ::DM;
        PG8_EPI_LOOP( st_f32x8(base + (size_t)(row - ::MP) * ::DM + pn * BM + cl, v0, v1); )
    }
};
struct SplitOrder {
    int G, c;
    __device__ __forceinline__ bool next(int i, Unit& u) const { const int L = i * G + c; if (L >= 256) return false; u.pm = 64 + (L & 3); u.pn = (L >> 2) & 7; u.ks = L >> 5; return true; }
    __device__ __forceinline__ void a_ready(const Unit&) const {}
    __device__ __forceinline__ void done(const Unit&) const {}
};
struct EpiSqRelu {
    static constexpr bool PERM = true, AFTER_DRAIN = false;
    bf16_t* H;
    __device__ __forceinline__ void operator()(const f32x4 (&acc)[2][2][4][2], const Unit& u, int wr, int wc, int fr, int fq) const {
        const int pn = u.pn;
        PG8_EPI_LOOP(
            f32x4 a = __builtin_elementwise_max(v0, (f32x4){0.f, 0.f, 0.f, 0.f}), b = __builtin_elementwise_max(v1, (f32x4){0.f, 0.f, 0.f, 0.f});
            st_bf16x8(H + (size_t)row * ::DFF + pn * BM + cl, a * a, b * b);
        )
    }
};
struct EpiStoreF32 {
    static constexpr bool PERM = true, AFTER_DRAIN = false;
    float* C;
    __device__ __forceinline__ void operator()(const f32x4 (&acc)[2][2][4][2], const Unit& u, int wr, int wc, int fr, int fq) const {
        const int pn = u.pn;
        PG8_EPI_LOOP( st_f32x8(C + (size_t)row * ::DM + pn * BM + cl, v0, v1); )
    }
};
struct EpiGate {
    static constexpr bool PERM = true, AFTER_DRAIN = false;
    const float* X2; const float* PW; float* Y; bf16_t* YB;
    __device__ __forceinline__ f32x4 sig(const f32x4& v) const { f32x4 r;
#pragma unroll
        for (int i = 0; i < 4; ++i) r[i] = __builtin_amdgcn_rcpf(1.0f + __expf(-v[i])); return r; }
    __device__ __forceinline__ void operator()(const f32x4 (&acc)[2][2][4][2], const Unit& u, int wr, int wc, int fr, int fq) const {
        const int pn = u.pn;
        PG8_EPI_LOOP_F(
            const size_t off = (size_t)row * ::DM + pn * BM + cl;
            const f32x4 y0 = *(const f32x4*)(X2 + off) + sig(v0) * *(const f32x4*)(PW + off), y1 = *(const f32x4*)(X2 + off + 4) + sig(v1) * *(const f32x4*)(PW + off + 4);
            st_f32x8(Y + off, y0, y1); if (YB) st_bf16x8(YB + off, y0, y1);
        )
    }
};
template <class Epi, class Sched, bool ALIGN_EPI = false, bool SP2 = false>
__device__ __forceinline__ void gemm_phase(PG8_LAS unsigned char* lds, const Gemm g, const Sched& S, const Epi& E) {
    const int tid = threadIdx.x, wid = __builtin_amdgcn_readfirstlane(tid >> 6), lane = tid & 63, wr = wid >> 2, wc = wid & 3, fr = lane & 15, fq = lane >> 4;
    const int K = g.ld, nt = g.K / BK;
    const size_t kslice = (size_t)g.K * 2;
    unsigned voffA[2], voffB[2];
#pragma unroll
    for (int i = 0; i < 2; ++i) { int R, C; stage_rc(tid * 16 + i * 8192, R, C); const int Rb = Epi::PERM ? ((R & ~31) + perm32(R & 31)) : R;
        voffA[i] = (unsigned)(R * K + C) * 2u; voffB[i] = (unsigned)(Rb * K + C) * 2u; }
    const size_t kstep = (size_t)(BK * 2);
    const size_t hstep = (size_t)HALF * K * 2;
    const size_t tstep = 2 * hstep;
    const unsigned ldsw = (unsigned)wid * 1024u;
    const int aoff = lds_byte(wr * 64 + fr, fq * 8), boff = lds_byte(wc * 32 + fr, fq * 8);
#define PG8_SA(b, h) (((b) * 2 + (h)) * HTB)
#define PG8_SB(b, h) ((4 + (b) * 2 + (h)) * HTB)
#define PG8_STAGE(bufoff, gbase, voff) do { _Pragma("unroll") for (int _i = 0; _i < 2; ++_i) \
        __builtin_amdgcn_global_load_lds((const unsigned*)((const char*)(gbase) + (voff)[_i]), (PG8_LAS unsigned*)(lds + (bufoff) + ldsw + _i * 8192), 16, 0, 0); } while (0)
#define PG8_LDA(dst, b, h) do { _Pragma("unroll") for (int m = 0; m < 4; ++m) _Pragma("unroll") for (int k = 0; k < 2; ++k) dst[m][k] = *(const PG8_LAS bf16x8*)(lds + PG8_SA(b, h) + aoff + m * 2048 + k * 1024); } while (0)
#define PG8_LDB(dst, b, h) do { _Pragma("unroll") for (int n = 0; n < 2; ++n) _Pragma("unroll") for (int k = 0; k < 2; ++k) dst[n][k] = *(const PG8_LAS bf16x8*)(lds + PG8_SB(b, h) + boff + n * 2048 + k * 1024); } while (0)
#define PG8_MMA(ai, bj, At, Bt) do { __builtin_amdgcn_s_setprio(1); _Pragma("unroll") for (int m = 0; m < 4; ++m) _Pragma("unroll") for (int n = 0; n < 2; ++n) _Pragma("unroll") for (int k = 0; k < 2; ++k) \
        acc[ai][bj][m][n] = __builtin_amdgcn_mfma_f32_16x16x32_bf16(Bt[n][k], At[m][k], acc[ai][bj][m][n], 0, 0, 0); __builtin_amdgcn_s_setprio(0); } while (0)
#define PG8_WAIT_V(n) asm volatile("s_waitcnt vmcnt(" #n ")" ::: "memory")
#define PG8_WAIT_L(n) asm volatile("s_waitcnt lgkmcnt(" #n ")" ::: "memory")
#define PG8_BAR __builtin_amdgcn_s_barrier()
#define PG8_SCHED __builtin_amdgcn_sched_barrier(0)
    Unit cur, nxt; int ui = 0;
    if (!S.next(0, cur)) return;
    f32x4 acc[2][2][4][2];
#pragma unroll
    for (int a = 0; a < 2; ++a)
#pragma unroll
        for (int b = 0; b < 2; ++b)
#pragma unroll
            for (int m = 0; m < 4; ++m)
#pragma unroll
                for (int n = 0; n < 2; ++n) acc[a][b][m][n] = (f32x4){0.f, 0.f, 0.f, 0.f};
    bf16x8 At[4][2], B0[2][2], B1[2][2];
    const char* cA = (const char*)g.A + (size_t)cur.pm * tstep + cur.ks * kslice; const char* cB = (const char*)g.Bt + (size_t)cur.pn * tstep + cur.ks * kslice;
    S.a_ready(cur);
    if constexpr (SP2) {
        PG8_STAGE(PG8_SB(0, 0), cB, voffB); PG8_STAGE(PG8_SB(0, 1), cB + hstep, voffB); PG8_STAGE(PG8_SA(0, 0), cA, voffA); PG8_STAGE(PG8_SA(0, 1), cA + hstep, voffA);
        if (wr == 1) PG8_BAR;
        PG8_WAIT_V(2); PG8_BAR;
        PG8_STAGE(PG8_SB(1, 0), cB + kstep, voffB); PG8_STAGE(PG8_SA(1, 0), cA + kstep, voffA); PG8_STAGE(PG8_SB(1, 1), cB + hstep + kstep, voffB);
        PG8_WAIT_V(6); PG8_BAR;
    } else {
        PG8_STAGE(PG8_SB(0, 0), cB, voffB); PG8_STAGE(PG8_SA(0, 0), cA, voffA); PG8_STAGE(PG8_SB(0, 1), cB + hstep, voffB); PG8_STAGE(PG8_SA(0, 1), cA + hstep, voffA);
        if (wr == 1) PG8_BAR;
        PG8_WAIT_V(4); PG8_BAR;
        PG8_STAGE(PG8_SB(1, 0), cB + kstep, voffB); PG8_STAGE(PG8_SA(1, 0), cA + kstep, voffA); PG8_STAGE(PG8_SB(1, 1), cB + hstep + kstep, voffB);
        PG8_WAIT_V(6); PG8_BAR;
    }
    for (;;) {
        const bool has_next = S.next(ui + 1, nxt);
        const char* nA = has_next ? (const char*)g.A + (size_t)nxt.pm * tstep + nxt.ks * kslice : cA; const char* nB = has_next ? (const char*)g.Bt + (size_t)nxt.pn * tstep + nxt.ks * kslice : cB;
        for (int t = 0; t < nt; t += 2) {
            const bool last = (t == nt - 2);
            const char* a1 = cA + (size_t)(t + 1) * kstep;
            const char* a2 = last ? nA : cA + (size_t)(t + 2) * kstep; const char* b2 = last ? nB : cB + (size_t)(t + 2) * kstep;
            const char* a3 = a2 + kstep; const char* b3 = b2 + kstep;
            if (last && has_next) S.a_ready(nxt);
            if constexpr (SP2) {
            PG8_LDB(B0, 0, 0); PG8_LDB(B1, 0, 1); PG8_SCHED; PG8_LDA(At, 0, 0); PG8_STAGE(PG8_SA(1, 1), a1 + hstep, voffA);
            PG8_WAIT_V(8); PG8_WAIT_L(0); PG8_BAR; PG8_MMA(0, 0, At, B0); PG8_MMA(0, 1, At, B1); PG8_BAR; PG8_SCHED;
            PG8_LDA(At, 0, 1); PG8_STAGE(PG8_SB(0, 0), b2, voffB); PG8_STAGE(PG8_SB(0, 1), b2 + hstep, voffB); PG8_STAGE(PG8_SA(0, 0), a2, voffA);
            PG8_WAIT_V(8); PG8_WAIT_L(0); PG8_BAR; PG8_MMA(1, 0, At, B0); PG8_MMA(1, 1, At, B1); PG8_BAR; PG8_SCHED;
            PG8_LDB(B0, 1, 0); PG8_LDB(B1, 1, 1); PG8_SCHED; PG8_LDA(At, 1, 0); PG8_STAGE(PG8_SA(0, 1), a2 + hstep, voffA);
            PG8_WAIT_V(8); PG8_WAIT_L(0); PG8_BAR; PG8_MMA(0, 0, At, B0); PG8_MMA(0, 1, At, B1); PG8_BAR; PG8_SCHED;
            PG8_LDA(At, 1, 1); PG8_STAGE(PG8_SB(1, 0), b3, voffB); PG8_STAGE(PG8_SB(1, 1), b3 + hstep, voffB); PG8_STAGE(PG8_SA(1, 0), a3, voffA);
            PG8_WAIT_V(8); PG8_WAIT_L(0); PG8_BAR; PG8_MMA(1, 0, At, B0); PG8_MMA(1, 1, At, B1); PG8_BAR; PG8_SCHED;
            } else {
            PG8_LDB(B0, 0, 0); PG8_SCHED; PG8_LDA(At, 0, 0); PG8_STAGE(PG8_SA(1, 1), a1 + hstep, voffA);
            PG8_WAIT_L(8); PG8_BAR; PG8_WAIT_L(0); PG8_MMA(0, 0, At, B0); PG8_BAR; PG8_SCHED;
            PG8_LDB(B1, 0, 1); PG8_STAGE(PG8_SB(0, 0), b2, voffB);
            PG8_BAR; PG8_WAIT_L(0); PG8_MMA(0, 1, At, B1); PG8_BAR;
            PG8_LDA(At, 0, 1); PG8_STAGE(PG8_SA(0, 0), a2, voffA);
            PG8_BAR; PG8_WAIT_L(0); PG8_MMA(1, 0, At, B0); PG8_BAR; PG8_SCHED;
            PG8_STAGE(PG8_SB(0, 1), b2 + hstep, voffB);
            PG8_WAIT_V(6); PG8_BAR; PG8_MMA(1, 1, At, B1); PG8_BAR;
            PG8_LDB(B0, 1, 0); PG8_SCHED; PG8_LDA(At, 1, 0); PG8_STAGE(PG8_SA(0, 1), a2 + hstep, voffA);
            PG8_WAIT_L(8); PG8_BAR; PG8_WAIT_L(0); PG8_MMA(0, 0, At, B0); PG8_BAR; PG8_SCHED;
            PG8_LDB(B1, 1, 1); PG8_STAGE(PG8_SB(1, 0), b3, voffB);
            PG8_BAR; PG8_WAIT_L(0); PG8_MMA(0, 1, At, B1); PG8_BAR;
            PG8_LDA(At, 1, 1); PG8_STAGE(PG8_SA(1, 0), a3, voffA);
            PG8_BAR; PG8_WAIT_L(0); PG8_MMA(1, 0, At, B0); PG8_BAR; PG8_SCHED;
            PG8_STAGE(PG8_SB(1, 1), b3 + hstep, voffB);
            PG8_WAIT_V(6); PG8_BAR; PG8_MMA(1, 1, At, B1); PG8_BAR;
            }
        }
        if constexpr (ALIGN_EPI) { if (wr == 0) PG8_BAR; }
        if constexpr (!Epi::AFTER_DRAIN) { E(acc, cur, wr, wc, fr, fq); S.done(cur); }
        if (!has_next) break;
#pragma unroll
        for (int a = 0; a < 2; ++a)
#pragma unroll
            for (int b = 0; b < 2; ++b)
#pragma unroll
                for (int m = 0; m < 4; ++m)
#pragma unroll
                    for (int n = 0; n < 2; ++n) acc[a][b][m][n] = (f32x4){0.f, 0.f, 0.f, 0.f};
        cur = nxt; cA = nA; cB = nB; ++ui;
        if constexpr (ALIGN_EPI) { if (wr == 1) PG8_BAR; }
    }
    PG8_WAIT_V(0);
    if constexpr (!ALIGN_EPI) { if (wr == 0) PG8_BAR; }
    PG8_BAR;
    if constexpr (Epi::AFTER_DRAIN) { E.fused(acc, cur, wr, wc, fr, fq, lds, wid, lane); S.done(cur); }
#undef PG8_SA
#undef PG8_SB
#undef PG8_STAGE
#undef PG8_LDA
#undef PG8_LDB
#undef PG8_MMA
#undef PG8_WAIT_V
#undef PG8_WAIT_L
#undef PG8_BAR
#undef PG8_SCHED
}
}
#define XB_TMO      128
#define XB_XCNT(j)  (256  + 64 * (j))
#define XB_XSUB(j)  (1280 + 64 * (j))
#define XB_XGEN(j)  (2304 + 64 * (j))
#define XB_TOP      3328
#define XB_TOPGEN   3392
#define XCD_BAR_WORDS 3456
#define XB_SPIN_CAP (1u << 18)

__device__ __forceinline__ unsigned xb_ld(unsigned* p)              { return __hip_atomic_load(p, __ATOMIC_RELAXED, __HIP_MEMORY_SCOPE_AGENT); }
__device__ __forceinline__ unsigned xb_add(unsigned* p, unsigned v) { return __hip_atomic_fetch_add(p, v, __ATOMIC_RELAXED, __HIP_MEMORY_SCOPE_AGENT); }
__device__ __forceinline__ unsigned xb_xcc_id() { return (unsigned)__builtin_amdgcn_s_getreg((3 << 11) | 20) & 0xFu; }
#define XB_SPIN(cond, bar) do { unsigned _sp = 0; while (cond) { __builtin_amdgcn_s_sleep(1); \
    if ((++_sp & 255u) == 0u) { if (xb_ld(&(bar)[XB_TMO])) break; if (_sp > XB_SPIN_CAP) { atomicAdd(&(bar)[XB_TMO], 1u); break; } } } } while (0)

struct XcdBarrier {
    unsigned* bar; unsigned x;
    volatile LAS unsigned* st;
};

__device__ __forceinline__ XcdBarrier xcd_barrier_post(unsigned* bar, volatile LAS unsigned* st) {
    XcdBarrier b; b.bar = bar; b.x = xb_xcc_id(); b.st = st;
    if (threadIdx.x == 0) (void)xb_add(&bar[XB_XCNT(b.x)], 1u);
    return b;
}
__device__ __forceinline__ void xcd_barrier_complete(unsigned* bar, unsigned x, unsigned& nloc, unsigned& nx) {
    const unsigned G = gridDim.x * gridDim.y * gridDim.z;
    unsigned sum, cnt, mine, sp = 0u;
    for (;;) {
        sum = 0u; cnt = 0u; mine = 0u;
#pragma unroll
        for (unsigned j = 0; j < 16; ++j) { const unsigned c = xb_ld(&bar[XB_XCNT(j)]); sum += c; cnt += (c > 0u) ? 1u : 0u; mine = (j == x) ? c : mine; }
        if (sum == G) break;
        __builtin_amdgcn_s_sleep(1);
        if ((++sp & 255u) == 0u) { if (xb_ld(&bar[XB_TMO])) break; if (sp > XB_SPIN_CAP) { atomicAdd(&bar[XB_TMO], 1u); break; } }
    }
    nloc = mine > 0u ? mine : 1u; nx = cnt > 0u ? cnt : 1u;
}

__device__ __forceinline__ void xcd_barrier(const XcdBarrier& b) {
    asm volatile("s_waitcnt vmcnt(0)" ::: "memory");
    __syncthreads();
    if (threadIdx.x == 0) {
        unsigned* bar = b.bar;
        __builtin_amdgcn_s_waitcnt(0);
        unsigned nloc = b.st[0], nx = b.st[1];
        if (nloc == 0u) { xcd_barrier_complete(bar, b.x, nloc, nx); b.st[0] = nloc; b.st[1] = nx; }
        const unsigned old = xb_add(&bar[XB_XSUB(b.x)], 1u);
        const unsigned gen = old / nloc;
        if (old + 1u == (gen + 1u) * nloc) {
            __builtin_amdgcn_fence(__ATOMIC_RELEASE, "agent");
            asm volatile("s_waitcnt vmcnt(0)" ::: "memory");
            const unsigned og = xb_add(&bar[XB_TOP], 1u);
            const unsigned tg = og / nx;
            if (og + 1u == (tg + 1u) * nx) xb_add(&bar[XB_TOPGEN], 1u);
            else XB_SPIN(xb_ld(&bar[XB_TOPGEN]) == tg, bar);
            __builtin_amdgcn_fence(__ATOMIC_ACQUIRE, "agent");
            xb_add(&bar[XB_XGEN(b.x)], 1u);
            asm volatile("s_waitcnt vmcnt(0)" ::: "memory");
        } else {
            XB_SPIN(xb_ld(&bar[XB_XGEN(b.x)]) == gen, bar);
            __builtin_amdgcn_fence(__ATOMIC_ACQUIRE, "agent");
            asm volatile("s_waitcnt vmcnt(0)" ::: "memory");
        }
    }
    __syncthreads();
}
#ifndef MK_PROBE
#define MK_PROBE 0
#endif
#define NREP(bit) (((MK_PROBE >> (bit)) & 1) ? 2 : 1)
#define GEMM2X(call) do { call; if (NREP(0) > 1) { call; } } while (0)
#define NREP2(b1, b2) ((((MK_PROBE >> (b1)) | (MK_PROBE >> (b2))) & 1) ? 2 : 1)
#ifndef MK_GATE_PART
#define MK_GATE_PART 3
#endif
typedef GAS unsigned gu32;
#define RLX_AGENT __ATOMIC_RELAXED, __HIP_MEMORY_SCOPE_AGENT
#define MFMA32(a, b, c) __builtin_amdgcn_mfma_f32_32x32x16_bf16((a), (b), (c), 0, 0, 0)

struct Ctx { LAS unsigned char* lds; volatile LAS unsigned* MISC; int tid, lane, wave, G, bx, gw, NGW; };
__device__ __forceinline__ int crow(int r, int hi) { return (r & 3) + 8 * (r >> 2) + 4 * hi; }

__device__ __forceinline__ void p0_transpose_item(const float* W, int K, int N, int NP, bf16* WT, LAS float* scr, int item, int lane) {
    const int nblk = NP / 32, kb = item / nblk, nb = item % nblk, k0 = 64 * kb, n0 = 32 * nb;
    const int nn = n0 + (lane & 31);
#pragma unroll 8
    for (int i = 0; i < 32; ++i) { const int kk = 2 * i + (lane >> 5); scr[kk * 33 + (lane & 31)] = (nn < N) ? W[(size_t)(k0 + kk) * N + nn] : 0.f; }
    LDS_WAIT();
    const int c = lane & 7;
#pragma unroll
    for (int j = 0; j < 4; ++j) { const int n = (lane >> 3) + 8 * j; const LAS float* s = scr + (8 * c) * 33 + n;
        v4u o; o.x = pk2(s[0 * 33], s[1 * 33]); o.y = pk2(s[2 * 33], s[3 * 33]); o.z = pk2(s[4 * 33], s[5 * 33]); o.w = pk2(s[6 * 33], s[7 * 33]);
        *(v4u*)(WT + (size_t)(n0 + n) * K + k0 + 8 * c) = o; }
    LDS_WAIT();
}
__device__ __forceinline__ void transpose_job(const Ctx& C, const float* W, int K, int N, int NP, bf16* WT) {
    LAS float* scr = (LAS float*)(C.lds + C.wave * 16384);
    const int nitems = (K / 64) * (NP / 32);
    for (int it = C.gw; it < nitems; it += C.NGW) p0_transpose_item(W, K, N, NP, WT, scr, it, C.lane);
}
__device__ __forceinline__ void cvt_job(const Ctx& C, const float* src, bf16* dst, int nseg, int seglen, size_t sstride, size_t dstride) {
    const int vps = seglen / 8; const long total = (long)nseg * vps; const long NGT = (long)C.G * NTHREADS;
    for (long i = (long)C.bx * NTHREADS + C.tid; i < total; i += NGT) { const int seg = (int)(i / vps), off = (int)(i % vps) * 8;
        const f32x4 a = *(const f32x4*)(src + seg * sstride + off), b = *(const f32x4*)(src + seg * sstride + off + 4);
        v4u o; o.x = pk2(a.x, a.y); o.y = pk2(a.z, a.w); o.z = pk2(b.x, b.y); o.w = pk2(b.z, b.w); *(v4u*)(dst + seg * dstride + off) = o; }
}

__device__ __forceinline__ float wave_sum(float v) {
#pragma unroll
    for (int o = 1; o < 64; o <<= 1) v += __shfl_xor(v, o);
    return v;
}
__device__ __forceinline__ void ln_phase(const Ctx& C, float* RES, bf16* XO, const float* g, const float* b, const float* xs, const float* PART) {
    for (int row = C.gw; row < MT; row += C.NGW) {
        f32x4* xr = (f32x4*)(RES + (size_t)row * DM) + C.lane;
        f32x4 v[8]; float s = 0.f;
        if (row < MP) {
#pragma unroll
            for (int j = 0; j < 8; ++j) v[j] = xr[64 * j];
        } else {
            const f32x4* xp = (const f32x4*)(xs + (size_t)row * DM) + C.lane;
#pragma unroll
            for (int j = 0; j < 8; ++j) v[j] = xp[64 * j] * ALPHA;
#pragma unroll 2
            for (int ks = 0; ks < 8; ++ks) { const f32x4* pp = (const f32x4*)(PART + ((size_t)ks * MS + (row - MP)) * DM) + C.lane;
#pragma unroll
                for (int j = 0; j < 8; ++j) v[j] += pp[64 * j]; }
        }
#pragma unroll
        for (int j = 0; j < 8; ++j) s += (v[j].x + v[j].y) + (v[j].z + v[j].w);
        const float mean = wave_sum(s) * (1.f / DM); float s2 = 0.f;
#pragma unroll
        for (int j = 0; j < 8; ++j) { v[j] = v[j] - mean; s2 += (v[j].x * v[j].x + v[j].y * v[j].y) + (v[j].z * v[j].z + v[j].w * v[j].w); }
        const float rstd = 1.f / sqrtf(wave_sum(s2) * (1.f / DM) + LN_EPS);
        v2u* o8 = (v2u*)(XO + (size_t)row * DM) + C.lane;
#pragma unroll
        for (int j = 0; j < 8; ++j) { const f32x4 gg = ((const f32x4*)g)[C.lane + 64 * j], bb = ((const f32x4*)b)[C.lane + 64 * j]; const f32x4 y = v[j] * rstd * gg + bb;
            xr[64 * j] = y; v2u w; w.x = pk2(y.x, y.y); w.y = pk2(y.z, y.w); o8[64 * j] = w; }
    }
}

constexpr int SC_QPITCH = 4112, SC_NITEMS = 160 + 2304;
__device__ __forceinline__ void scores_phase(const Ctx& C, unsigned* qhead, const bf16* QIB, const bf16* KIP, const bf16* KIS, const float* WI, float* SCP, float* SCS) {
    const int q = C.lane & 31, hh = C.lane >> 5;
    for (;;) {
        if (C.tid == 0) C.MISC[0] = __hip_atomic_fetch_add(qhead, 1u, RLX_AGENT);
        __syncthreads();
        int id = (int)C.MISC[0];
        __syncthreads();
        if (id >= SC_NITEMS) break;
        int row0, nk, ch, stride; const bf16* KI; float* SC;
        if (id < 160) { const int qt = id / 5; ch = id % 5; const int rs0 = qt * 32, b = rs0 >> 6; row0 = MP + rs0; KI = KIS + (size_t)b * SALL * HD; nk = SALL; SC = SCS + (size_t)rs0 * SALL; stride = SALL; }
        else { id -= 160; int k = 7; while (id >= 64 * (k + 1)) { id -= 64 * (k + 1); --k; }
            const int per = 4 * (k + 1), ci = id / per, rem = id % per, c = 16 * k + 15 - ci, tile4 = rem / (k + 1); ch = rem % (k + 1);
            const int b = tile4 >> 1, t0 = c * 64 + (tile4 & 1) * 32; row0 = b * SEQ + t0; KI = KIP + (size_t)b * SEQ * HD; nk = 64 * (c + 1); SC = SCP + (size_t)row0 * SEQ; stride = SEQ; }
        const int s_begin = ch * 1024, nkc = (nk - s_begin) < 1024 ? (nk - s_begin) : 1024, ntiles = nkc >> 5;
#pragma unroll 4
        for (int i = 0; i < 16; ++i) { const int p = C.tid + NTHREADS * i, qq = p >> 8, off = (p & 255) * 16;
            const v4u v = *(const v4u*)((const char*)QIB + (size_t)(row0 + qq) * (DM * 2) + off); *(LAS v4u*)(C.lds + qq * SC_QPITCH + off) = v; }
        LAS float* wl = (LAS float*)(C.lds + 32 * SC_QPITCH);
        { const int qq = C.tid >> 4, h2 = C.tid & 15; wl[qq * 17 + h2] = WI[(size_t)(row0 + qq) * 16 + h2]; }
        __syncthreads();
        const LAS unsigned char* qb = C.lds + q * SC_QPITCH + hh * 16;
        for (int ti = C.wave; ti < ntiles; ti += NWAVES) {
            const int s0 = s_begin + ti * 32;
            const bf16* kp = KI + (size_t)(s0 + q) * HD + 8 * hh;
            bf16x8 kf[8];
#pragma unroll
            for (int kk = 0; kk < 8; ++kk) kf[kk] = *(const bf16x8*)(kp + 16 * kk);
            f32x16 acc;
#pragma unroll
            for (int r = 0; r < 16; ++r) acc[r] = 0.f;
#pragma unroll 2
            for (int h = 0; h < 16; ++h) {
                f32x16 c; const float wh = wl[q * 17 + h];
#pragma unroll
                for (int r = 0; r < 16; ++r) c[r] = 0.f;
#pragma unroll
                for (int kk = 0; kk < 8; ++kk) { const bf16x8 bq = *(const LAS bf16x8*)(qb + h * 256 + kk * 32); c = MFMA32(kf[kk], bq, c); }
#pragma unroll
                for (int r = 0; r < 16; ++r) acc[r] += wh * __builtin_fmaxf(c[r], 0.f);
            }
            float* sp = SC + (size_t)q * stride + s0 + 4 * hh;
#pragma unroll
            for (int g = 0; g < 4; ++g) *(f32x4*)(sp + 8 * g) = (f32x4){acc[4 * g], acc[4 * g + 1], acc[4 * g + 2], acc[4 * g + 3]};
        }
        __syncthreads();
    }
}

__device__ __forceinline__ unsigned tokey(float f) { const unsigned u = __float_as_uint(f); return (u & 0x80000000u) ? ~u : (u | 0x80000000u); }
__device__ __forceinline__ void select_phase(const Ctx& C, const float* SCP, const float* SCS, int* IDX, int* CNT) {
    LAS unsigned* hist = (LAS unsigned*)(C.lds + C.wave * 1024);
    const int lane = C.lane; const unsigned long long ltm = (1ull << lane) - 1ull;
    for (int row = C.gw; row < MT; row += C.NGW) {
        int n; const float* sc;
        if (row < MP) { const int t = row & (SEQ - 1); n = 64 * ((t >> 6) + 1); sc = SCP + (size_t)row * SEQ; } else { n = SALL; sc = SCS + (size_t)(row - MP) * SALL; }
        int* ip = IDX + (size_t)row * TOPK;
        if (n <= TOPK) {
#pragma unroll
            for (int k = 0; k < 4; ++k) { const int i = lane + 64 * k; ip[i] = (i < n) ? i : 0; }
            if (lane == 0) CNT[row] = n;
            continue;
        }
        unsigned prefix = 0u, mask = 0u, krem = TOPK;
        for (int pass = 0; pass < 4; ++pass) {
            const int shift = 24 - 8 * pass;
            *(LAS v4u*)(hist + 4 * lane) = (v4u){0u, 0u, 0u, 0u};
            LDS_WAIT();
            for (int i = lane * 4; i < n; i += 256) { const f32x4 v = *(const f32x4*)(sc + i);
#pragma unroll
                for (int e = 0; e < 4; ++e) { const unsigned key = tokey(v[e]); if ((key & mask) == prefix) __hip_atomic_fetch_add(hist + ((key >> shift) & 255u), 1u, __ATOMIC_RELAXED, __HIP_MEMORY_SCOPE_WORKGROUP); } }
            LDS_WAIT();
            const v4u hc = *(const LAS v4u*)(hist + 4 * lane);
            const unsigned tot = hc.x + hc.y + hc.z + hc.w; unsigned x = tot;
#pragma unroll
            for (int o = 1; o < 64; o <<= 1) { const unsigned y = __shfl_down(x, o); if (lane + o < 64) x += y; }
            const unsigned a3 = x - tot, a2 = a3 + hc.w, a1 = a2 + hc.z, a0 = a1 + hc.y;
            int fe = -1; unsigned fa = 0u;
            if (a3 < krem && krem <= a3 + hc.w) { fe = 3; fa = a3; } else if (a2 < krem && krem <= a2 + hc.z) { fe = 2; fa = a2; }
            else if (a1 < krem && krem <= a1 + hc.y) { fe = 1; fa = a1; } else if (a0 < krem && krem <= a0 + hc.x) { fe = 0; fa = a0; }
            const unsigned long long bal = __ballot(fe >= 0); const int src = bal ? (__ffsll((long long)bal) - 1) : 0;
            const unsigned d = (unsigned)__shfl(4 * lane + fe, src), above = (unsigned)__shfl((int)fa, src);
            krem -= above; prefix |= d << shift; mask |= 0xffu << shift;
        }
        int outc = 0, eqs = 0;
        for (int i0 = 0; i0 < n; i0 += 64) { const unsigned key = tokey(sc[i0 + lane]); const bool gt = key > prefix, eq = key == prefix;
            const unsigned long long eqb = __ballot(eq); const int myr = eqs + __popcll(eqb & ltm); const bool sel = gt || (eq && (unsigned)myr < krem); eqs += __popcll(eqb);
            const unsigned long long sb = __ballot(sel); const int pos = outc + __popcll(sb & ltm); if (sel && pos < TOPK) ip[pos] = i0 + lane; outc += __popcll(sb); }
        if (lane == 0) CNT[row] = outc < TOPK ? outc : TOPK;
    }
}

__device__ __forceinline__ int t5_bucket(int n  ) {
    const int ret = (n < 0) ? 16 : 0; n = n < 0 ? -n : n;
    if (n < 8) return ret + n;
    const int lg = 31 - __builtin_clz((unsigned)(n * n));
    const int large = 2 + lg; return ret + (large < 15 ? large : 15);
}
__device__ __forceinline__ float dpp_quad_sum(float t) {
    t += __builtin_bit_cast(float, __builtin_amdgcn_mov_dpp(__builtin_bit_cast(int, t), 0xB1, 0xF, 0xF, true));
    t += __builtin_bit_cast(float, __builtin_amdgcn_mov_dpp(__builtin_bit_cast(int, t), 0x4E, 0xF, 0xF, true));
    return t;
}
__device__ __forceinline__ void sattn_task(int row, int g, int qpos, const bf16* Kb, const bf16* Vb, int cnt, const int* ip, const bf16* QB, bf16* OB,
                                           LAS int* idxl, LAS float* lg, const LAS float* biasl, int lane) {
#pragma unroll
    for (int k = 0; k < 4; ++k) { const int j = lane + 64 * k; const int v = ip[j]; idxl[j] = (j < cnt) ? v : 0; }
    const int kq = lane >> 2, c4 = lane & 3;
    unsigned qreg[4][16];
    { const bf16* qp = QB + (size_t)row * DM + (4 * g) * HD + 32 * c4;
#pragma unroll
      for (int hq = 0; hq < 4; ++hq)
#pragma unroll
          for (int i = 0; i < 4; ++i) { const v4u a = *(const v4u*)(qp + hq * HD + 8 * i); qreg[hq][4 * i] = a.x; qreg[hq][4 * i + 1] = a.y; qreg[hq][4 * i + 2] = a.z; qreg[hq][4 * i + 3] = a.w; } }
    LDS_WAIT();
    for (int r0 = 0; r0 < 16; r0 += 2) {
        v4u kd[2][4];
#pragma unroll
        for (int rr = 0; rr < 2; ++rr) { const int key = idxl[16 * (r0 + rr) + kq]; const bf16* kp = Kb + (size_t)key * KVW + 32 * c4;
#pragma unroll
            for (int i = 0; i < 4; ++i) kd[rr][i] = *(const v4u*)(kp + 8 * i); }
#pragma unroll
        for (int rr = 0; rr < 2; ++rr) { float s[4];
#pragma unroll
            for (int hq = 0; hq < 4; ++hq) { float t = 0.f;
#pragma unroll
                for (int i = 0; i < 4; ++i) { t = dot2bf(kd[rr][i].x, qreg[hq][4 * i], t); t = dot2bf(kd[rr][i].y, qreg[hq][4 * i + 1], t); t = dot2bf(kd[rr][i].z, qreg[hq][4 * i + 2], t); t = dot2bf(kd[rr][i].w, qreg[hq][4 * i + 3], t); }
                s[hq] = dpp_quad_sum(t); }
            const float sv = c4 == 0 ? s[0] : c4 == 1 ? s[1] : c4 == 2 ? s[2] : s[3];
            lg[(16 * (r0 + rr) + kq) * 4 + c4] = sv; }
    }
    LDS_WAIT();
    float l[4][4];
#pragma unroll
    for (int k = 0; k < 4; ++k) { const int j = lane + 64 * k; const f32x4 l4 = *(const LAS f32x4*)(lg + 4 * j); const int key = idxl[j]; const int bk = t5_bucket(qpos - key);
        const f32x4 b4 = *(const LAS f32x4*)(biasl + bk * 16 + 4 * g); const bool valid = j < cnt;
#pragma unroll
        for (int hq = 0; hq < 4; ++hq) l[k][hq] = valid ? l4[hq] * QK_SCALE + b4[hq] : -INFINITY; }
    LDS_WAIT();
#pragma unroll
    for (int hq = 0; hq < 4; ++hq) { float m = __builtin_fmaxf(__builtin_fmaxf(l[0][hq], l[1][hq]), __builtin_fmaxf(l[2][hq], l[3][hq]));
#pragma unroll
        for (int o = 1; o < 64; o <<= 1) m = __builtin_fmaxf(m, __shfl_xor(m, o));
        float sum = 0.f;
#pragma unroll
        for (int k = 0; k < 4; ++k) { l[k][hq] = __expf(l[k][hq] - m); sum += l[k][hq]; }
        sum = wave_sum(sum); const float inv = 1.0f / sum;
#pragma unroll
        for (int k = 0; k < 4; ++k) l[k][hq] *= inv; }
#pragma unroll
    for (int k = 0; k < 4; ++k) { const int j = lane + 64 * k; *(LAS f32x4*)(lg + 4 * j) = (f32x4){l[k][0], l[k][1], l[k][2], l[k][3]}; }
    LDS_WAIT();
    const int ks = lane >> 4, dc = lane & 15;
    f32x2 o[4][4];
#pragma unroll
    for (int hq = 0; hq < 4; ++hq)
#pragma unroll
        for (int i = 0; i < 4; ++i) o[hq][i] = (f32x2){0.f, 0.f};
    const bf16* vp = Vb + 8 * dc;
    for (int jb = 0; jb < TOPK; jb += 32) {
        v4u w[8]; f32x4 p4[8];
#pragma unroll
        for (int u = 0; u < 8; ++u) { const int j = jb + 4 * u + ks; const int key = idxl[j]; w[u] = *(const v4u*)(vp + (size_t)key * KVW); p4[u] = *(const LAS f32x4*)(lg + 4 * j); }
#pragma unroll
        for (int u = 0; u < 8; ++u) { const f32x2 v0 = (f32x2){bf_lo(w[u].x), bf_hi(w[u].x)}, v1 = (f32x2){bf_lo(w[u].y), bf_hi(w[u].y)}, v2 = (f32x2){bf_lo(w[u].z), bf_hi(w[u].z)}, v3 = (f32x2){bf_lo(w[u].w), bf_hi(w[u].w)};
#pragma unroll
            for (int hq = 0; hq < 4; ++hq) { const float ph = p4[u][hq]; o[hq][0] += ph * v0; o[hq][1] += ph * v1; o[hq][2] += ph * v2; o[hq][3] += ph * v3; } }
    }
    v4u st = (v4u){0u, 0u, 0u, 0u};
#pragma unroll
    for (int hq = 0; hq < 4; ++hq) { unsigned pk[4];
#pragma unroll
        for (int i = 0; i < 4; ++i) { float x = o[hq][i].x, y = o[hq][i].y; x += __shfl_xor(x, 16); x += __shfl_xor(x, 32); y += __shfl_xor(y, 16); y += __shfl_xor(y, 32); pk[i] = pk2(x, y); }
        if (ks == hq) st = (v4u){pk[0], pk[1], pk[2], pk[3]}; }
    *(v4u*)(OB + (size_t)row * DM + (4 * g + ks) * HD + 8 * dc) = st;
    LDS_WAIT();
}
__device__ __forceinline__ void sattn_phase(const Ctx& C, const float* rel_bias, const bf16* QB, const bf16* KAP, const bf16* VAP, const bf16* KAS, const bf16* VAS, const int* IDX, const int* CNT, bf16* OB) {
    LAS float* biasl = (LAS float*)C.lds;
    LAS int* idxl = (LAS int*)(C.lds + 2048 + C.wave * 5120); LAS float* lg = (LAS float*)(C.lds + 2048 + C.wave * 5120 + 1024);
    if (C.tid < 512) biasl[C.tid] = rel_bias[C.tid];
    __syncthreads();
    const int x8 = C.bx & 7, g = x8 & 3, par = x8 >> 2, wi = (C.bx >> 3) * NWAVES + C.wave, nw = (C.G >> 3) * NWAVES;
    for (int k = wi; k < SEQ + 512; k += nw) {
        if (k < SEQ) { const int row = par * SEQ + k;
            sattn_task(row, g, k, KAP + (size_t)par * SEQ * KVW + g * HD, VAP + (size_t)par * SEQ * KVW + g * HD, CNT[row], IDX + (size_t)row * TOPK, QB, OB, idxl, lg, biasl, C.lane); }
        else { const int j = k - SEQ, b = 2 * (j >> 6) + par, i = j & 63, row = MP + b * DECS + i;
            sattn_task(row, g, PAST + i, KAS + (size_t)b * SALL * KVW + g * HD, VAS + (size_t)b * SALL * KVW + g * HD, CNT[row], IDX + (size_t)row * TOPK, QB, OB, idxl, lg, biasl, C.lane); }
    }
}

constexpr int VT_PITCH = 72;
__device__ __forceinline__ bf16x8 pack8(const f32x4& a, const f32x4& b) { v4u w; w.x = pk2(a.x, a.y); w.y = pk2(a.z, a.w); w.z = pk2(b.x, b.y); w.w = pk2(b.z, b.w); return __builtin_bit_cast(bf16x8, w); }
__device__ __forceinline__ const float* sb_rowp(bool samp, int b, int s, int h, const float* newp, const float* cache) {
    if (!samp) return newp + (size_t)(b * SEQ + s) * DM + h * HD;
    if (s < PAST) return cache + ((size_t)(b * PAST + s) * 16 + h) * HD;
    return newp + (size_t)(b * DECS + (s - PAST)) * DM + h * HD;
}
__device__ __forceinline__ void sb_task(bool samp, int b, int h, int qpos0, int r0, const bf16* QB, const float* knew, const float* vnew, const float* kcache, const float* vcache, bf16* OB, LAS unsigned char* vt, int lane) {
    const int q = lane & 31, hh = lane >> 5;
    bf16x8 qf[8];
    { const bf16* qp = QB + (size_t)(r0 + q) * DM + h * HD + 8 * hh;
#pragma unroll
      for (int kk = 0; kk < 8; ++kk) qf[kk] = *(const bf16x8*)(qp + 16 * kk); }
    f32x16 O[4];
#pragma unroll
    for (int db = 0; db < 4; ++db)
#pragma unroll
        for (int r = 0; r < 16; ++r) O[db][r] = 0.f;
    float R = 1.f; const int t = qpos0 + q;
    for (int kt = qpos0 >> 5; kt >= 0; --kt) {
        const float* kb = sb_rowp(samp, b, 32 * kt, h, knew, kcache); const float* vb = sb_rowp(samp, b, 32 * kt, h, vnew, vcache);
        f32x16 c;
#pragma unroll
        for (int r = 0; r < 16; ++r) c[r] = 0.f;
        { const float* kl = kb + (size_t)q * DM + 8 * hh;
#pragma unroll
          for (int kk = 0; kk < 8; ++kk) { const f32x4 a = *(const f32x4*)(kl + 16 * kk), bq = *(const f32x4*)(kl + 16 * kk + 4); c = MFMA32(pack8(a, bq), qf[kk], c); } }
        { const int d4 = lane & 31, kq = lane >> 5;
#pragma unroll
          for (int i = 0; i < 8; ++i) { const int kp = kq + 2 * i; const float* v0p = vb + (size_t)(2 * kp) * DM + 4 * d4; const f32x4 va = *(const f32x4*)v0p, vb2 = *(const f32x4*)(v0p + DM);
#pragma unroll
              for (int e = 0; e < 4; ++e) *(LAS unsigned*)(vt + (4 * d4 + e) * VT_PITCH + 4 * kp) = pk2(va[e], vb2[e]); } }
        float om[16], be[16];
#pragma unroll
        for (int r = 0; r < 16; ++r) { const int s = 32 * kt + crow(r, hh); const float z = c[r] * QK_SCALE; const float a = __expf(-__builtin_fabsf(z)); const float rr = __builtin_amdgcn_rcpf(1.0f + a), ar = a * rr;
            const bool m = s < t; const float beta = z > 0.f ? rr : ar, omb = z > 0.f ? ar : rr; om[r] = m ? omb : 1.f; be[r] = m ? beta : 0.f; }
        float pg[4], pp[4], tt[4];
#pragma unroll
        for (int gi = 0; gi < 4; ++gi) { pg[gi] = (om[4 * gi] * om[4 * gi + 1]) * (om[4 * gi + 2] * om[4 * gi + 3]); pp[gi] = __shfl_xor(pg[gi], 32); tt[gi] = pg[gi] * pp[gi]; }
        float SB[4]; SB[3] = 1.f; SB[2] = tt[3]; SB[1] = tt[3] * tt[2]; SB[0] = SB[1] * tt[1];
        float A[16];
#pragma unroll
        for (int gi = 0; gi < 4; ++gi) { const float s3 = R * SB[gi] * (hh == 0 ? pp[gi] : 1.f), s2 = s3 * om[4 * gi + 3], s1 = s2 * om[4 * gi + 2], s0 = s1 * om[4 * gi + 1];
            A[4 * gi + 3] = be[4 * gi + 3] * s3; A[4 * gi + 2] = be[4 * gi + 2] * s2; A[4 * gi + 1] = be[4 * gi + 1] * s1; A[4 * gi] = be[4 * gi] * s0; }
        R = R * (SB[0] * tt[0]);
        bf16x8 pf[2];
#pragma unroll
        for (int s = 0; s < 2; ++s) { v4u w; w.x = pk2(A[8 * s], A[8 * s + 1]); w.y = pk2(A[8 * s + 2], A[8 * s + 3]); w.z = pk2(A[8 * s + 4], A[8 * s + 5]); w.w = pk2(A[8 * s + 6], A[8 * s + 7]); pf[s] = __builtin_bit_cast(bf16x8, w); }
        LDS_WAIT();
#pragma unroll
        for (int db = 0; db < 4; ++db)
#pragma unroll
            for (int s = 0; s < 2; ++s) { const LAS unsigned char* ap = vt + (32 * db + q) * VT_PITCH + (16 * s + 4 * hh) * 2; const v2u lo = *(const LAS v2u*)ap, hi2 = *(const LAS v2u*)(ap + 16);
                v4u w; w.x = lo.x; w.y = lo.y; w.z = hi2.x; w.w = hi2.y; O[db] = MFMA32(__builtin_bit_cast(bf16x8, w), pf[s], O[db]); }
        LDS_WAIT();
        if (__all(R == 0.f)) break;
    }
#pragma unroll
    for (int db = 0; db < 4; ++db)
#pragma unroll
        for (int rg = 0; rg < 4; ++rg) { v2u w; w.x = pk2(O[db][4 * rg], O[db][4 * rg + 1]); w.y = pk2(O[db][4 * rg + 2], O[db][4 * rg + 3]);
            *(v2u*)(OB + (size_t)(r0 + q) * DM + h * HD + 32 * db + 8 * rg + 4 * hh) = w; }
}
__device__ __forceinline__ void sbattn_phase(const Ctx& C, const bf16* QB, float* out, const float* kcache, const float* vcache, bf16* OB) {
    LAS unsigned char* vt = C.lds + C.wave * 9216;
    for (int id = C.gw; id < 8192 + 512; id += C.NGW) {
        if (id < 8192) { const int b = id >> 12, h = (id >> 8) & 15, qt = id & 255; sb_task(false, b, h, qt * 32, b * SEQ + qt * 32, QB, out + O_KBP, out + O_VBP, kcache, vcache, OB, vt, C.lane); }
        else { const int j = id - 8192, b = j >> 5, h = (j >> 1) & 15, hf = j & 1; sb_task(true, b, h, PAST + 32 * hf, MP + b * DECS + 32 * hf, QB, out + O_KBS, out + O_VBS, kcache, vcache, OB, vt, C.lane); }
    }
}

struct Args { const float* in[22]; float* out; unsigned char* ws; int ph_lo, ph_hi; };
__global__ void __launch_bounds__(NTHREADS, 2) mk_fwd(Args args) {
    extern __shared__ __attribute__((aligned(16))) unsigned char lds_raw[];
    Ctx C;
    C.lds = (LAS unsigned char*)lds_raw; C.MISC = (volatile LAS unsigned*)(C.lds + MISC_OFF);
    C.tid = threadIdx.x; C.lane = C.tid & 63; C.wave = __builtin_amdgcn_readfirstlane(C.tid >> 6);
    C.G = gridDim.x; C.bx = blockIdx.x; C.gw = C.bx * NWAVES + C.wave; C.NGW = C.G * NWAVES;
    unsigned char* ws = args.ws; unsigned* ctl = (unsigned*)(ws + WS_CTL); float* out = args.out;
    for (int u = C.tid; u < (LDS_BYTES - LDSCTL_OFF) / 4; u += NTHREADS) ((LAS unsigned*)(C.lds + LDSCTL_OFF))[u] = 0u;
    __syncthreads();
    XcdBarrier bar; bar.bar = ctl + CW_BAR; bar.x = 0; bar.st = nullptr;
    if (!MK_PER_PHASE) bar = xcd_barrier_post(ctl + CW_BAR, C.MISC + 8);
    const int lo = args.ph_lo, hi = args.ph_hi;
#define IN(k) (lo <= (k) && (k) < hi)
#define PH_ON(k) ((MK_PH_MASK >> (k)) & 1u)
#define SEAM(k) do { if (!MK_PER_PHASE && IN(k) && IN((k) + 1)) xcd_barrier(bar); } while (0)
    const float *x_prompt = args.in[0], *x_sample = args.in[1], *cache_k_a = args.in[2], *cache_v_a = args.in[3], *cache_kidx_a = args.in[4], *cache_k_b = args.in[5], *cache_v_b = args.in[6];
    const float *p_prompt = args.in[7], *p_sample = args.in[8], *rel_bias = args.in[9], *w_in_a = args.in[10], *w_out_a = args.in[11], *w_in_b = args.in[12], *w_out_b = args.in[13];
    const float *ln1_g = args.in[14], *ln1_b = args.in[15], *ln2_g = args.in[16], *ln2_b = args.in[17], *w_up = args.in[18], *w_down = args.in[19], *w_ple = args.in[20], *w_ple_gate = args.in[21];
    bf16 *WINA = (bf16*)(ws + WS_WINA), *WOUTA = (bf16*)(ws + WS_WOUTA), *WINB = (bf16*)(ws + WS_WINB), *WOUTB = (bf16*)(ws + WS_WOUTB), *WUP = (bf16*)(ws + WS_WUP), *WDOWN = (bf16*)(ws + WS_WDOWN), *WG = (bf16*)(ws + WS_WG), *WP = (bf16*)(ws + WS_WP);
    bf16 *PB = (bf16*)(ws + WS_PB), *XB = (bf16*)(ws + WS_XB), *X1B = (bf16*)(ws + WS_X1B), *X2B = (bf16*)(ws + WS_X2B), *QB = (bf16*)(ws + WS_QB), *OB = (bf16*)(ws + WS_OB), *QIB = (bf16*)(ws + WS_QIB);
    bf16 *KAP = (bf16*)(ws + WS_KAP), *VAP = (bf16*)(ws + WS_VAP), *KAS = (bf16*)(ws + WS_KAS), *VAS = (bf16*)(ws + WS_VAS), *KIP = (bf16*)(ws + WS_KIP), *KIS = (bf16*)(ws + WS_KIS), *HB = (bf16*)(ws + WS_H);
    float *WI = (float*)(ws + WS_WI), *RES = (float*)(ws + WS_RES), *Y0 = (float*)(ws + WS_Y0), *PW = (float*)(ws + WS_PW), *SCP = (float*)(ws + WS_SCP), *SCS = (float*)(ws + WS_SCS), *PART = (float*)(ws + WS_PART);
    int *IDX = (int*)(ws + WS_IDX), *CNT = (int*)(ws + WS_CNT);

    if (IN(0)) for (int rep_ = 0; rep_ < NREP(2); ++rep_) {
        transpose_job(C, w_in_a, DM, NINA, NINA_PAD, WINA); transpose_job(C, w_out_a, DM, DM, DM, WOUTA); transpose_job(C, w_in_b, DM, NINB, NINB, WINB); transpose_job(C, w_out_b, DM, DM, DM, WOUTB);
        for (int l = 0; l < 2; ++l) { transpose_job(C, w_up + (size_t)l * DM * DFF, DM, DFF, DFF, WUP + (size_t)l * DFF * DM); transpose_job(C, w_down + (size_t)l * DFF * DM, DFF, DM, DM, WDOWN + (size_t)l * DM * DFF);
            transpose_job(C, w_ple_gate + (size_t)l * DM * DM, DM, DM, DM, WG + (size_t)l * DM * DM); transpose_job(C, w_ple + (size_t)l * PLE * DM, PLE, DM, DM, WP + (size_t)l * DM * PLE); }
        cvt_job(C, x_prompt, XB, 1, MP * DM, 0, 0); cvt_job(C, x_sample, XB + (size_t)MP * DM, 1, MS * DM, 0, 0);
        for (int l = 0; l < 2; ++l) { cvt_job(C, p_prompt + (size_t)l * MP * PLE, PB + (size_t)l * MT * PLE, 1, MP * PLE, 0, 0); cvt_job(C, p_sample + (size_t)l * MS * PLE, PB + (size_t)l * MT * PLE + (size_t)MP * PLE, 1, MS * PLE, 0, 0); }
        cvt_job(C, cache_k_a, KAS, DECB, PAST * KVW, (size_t)PAST * KVW, (size_t)SALL * KVW); cvt_job(C, cache_v_a, VAS, DECB, PAST * KVW, (size_t)PAST * KVW, (size_t)SALL * KVW);
        cvt_job(C, cache_kidx_a, KIS, DECB, PAST * HD, (size_t)PAST * HD, (size_t)SALL * HD);
    }
    SEAM(0);
#define LAYER_BODY(l) do { \
        const int pb = (l == 0) ? 5 : 13; \
        if (l == 0) { \
            if (IN(1) && PH_ON(1)) { pg8::Gemm g{XB, WINA, MT, NINA_PAD, DM, DM}; pg8::StaticOrder S; S.init(MT, NINA_PAD, C.G, C.bx); \
                pg8::EpiInA E{QB, QIB, KAP, KIP, WI, out}; \
                pg8::gemm_phase<pg8::EpiInA, pg8::StaticOrder, true, true>(C.lds, g, S, E); if (NREP(0) > 1) { pg8::gemm_phase<pg8::EpiInA, pg8::StaticOrder, true, true>(C.lds, g, S, E); } } \
            SEAM(1); \
            if (IN(2) && PH_ON(2)) for (int rep_ = 0; rep_ < NREP2(1, 4); ++rep_) scores_phase(C, ctl + CW_QSC + 64 * rep_, QIB, KIP, KIS, WI, SCP, SCS); \
            SEAM(2); \
            if (IN(3) && PH_ON(3)) for (int rep_ = 0; rep_ < NREP2(1, 5); ++rep_) select_phase(C, SCP, SCS, IDX, CNT); \
            SEAM(3); \
            if (IN(4) && PH_ON(4)) for (int rep_ = 0; rep_ < NREP2(1, 6); ++rep_) sattn_phase(C, rel_bias, QB, KAP, VAP, KAS, VAS, IDX, CNT, OB); \
            SEAM(4); \
        } else { \
            if (IN(11) && PH_ON(11)) { pg8::Gemm g{XB, WINB, MT, NINB, DM, DM}; pg8::StaticOrder S; S.init(MT, NINB, C.G, C.bx); \
                pg8::EpiInB E{QB, out}; \
                pg8::gemm_phase<pg8::EpiInB, pg8::StaticOrder, true, true>(C.lds, g, S, E); if (NREP(0) > 1) { pg8::gemm_phase<pg8::EpiInB, pg8::StaticOrder, true, true>(C.lds, g, S, E); } } \
            SEAM(11); \
            if (IN(12) && PH_ON(12)) for (int rep_ = 0; rep_ < NREP(3); ++rep_) sbattn_phase(C, QB, out, cache_k_b, cache_v_b, OB); \
            SEAM(12); \
        } \
        if (IN(pb) && PH_ON(pb)) { \
            { pg8::Gemm g{OB, l == 0 ? WOUTA : WOUTB, MP, DM, DM, DM}; pg8::StaticOrder S; S.init(MP, DM, C.G, C.bx); pg8::EpiResid E{l == 0 ? x_prompt : Y0, RES}; \
              GEMM2X((pg8::gemm_phase<pg8::EpiResid, pg8::StaticOrder, true, true>(C.lds, g, S, E))); } \
            { int ksl = 256; asm volatile("" : "+s"(ksl)); pg8::Gemm g{OB, l == 0 ? WOUTA : WOUTB, MT, DM, ksl, DM}; pg8::SplitOrder S{C.G, C.bx}; pg8::EpiPart E{PART}; \
              GEMM2X((pg8::gemm_phase<pg8::EpiPart, pg8::SplitOrder, true, true>(C.lds, g, S, E))); } } \
        SEAM(pb); \
        if (IN(pb + 1) && PH_ON(pb + 1)) ln_phase(C, RES, X1B, ln1_g + l * DM, ln1_b + l * DM, l == 0 ? x_sample - (size_t)MP * DM : Y0, PART); \
        SEAM(pb + 1); \
        if (IN(pb + 2) && PH_ON(pb + 2)) { pg8::Gemm g{X1B, WUP + (size_t)l * DFF * DM, MT, DFF, DM, DM}; pg8::StaticOrder S; S.init(MT, DFF, C.G, C.bx); \
            pg8::EpiSqRelu E{HB}; \
            GEMM2X((pg8::gemm_phase<pg8::EpiSqRelu, pg8::StaticOrder, true, true>(C.lds, g, S, E))); } \
        SEAM(pb + 2); \
        if (IN(pb + 3) && PH_ON(pb + 3)) { \
            { pg8::Gemm g{HB, WDOWN + (size_t)l * DM * DFF, MP, DM, DFF, DFF}; pg8::StaticOrder S; S.init(MP, DM, C.G, C.bx); pg8::EpiResid E{RES, RES}; \
              if (NREP(0) > 1) { pg8::EpiResid E2{RES, PW}; pg8::gemm_phase<pg8::EpiResid, pg8::StaticOrder, true, true>(C.lds, g, S, E2); } \
              pg8::gemm_phase<pg8::EpiResid, pg8::StaticOrder, true, true>(C.lds, g, S, E); } \
            { int ksl = 1024; asm volatile("" : "+s"(ksl)); pg8::Gemm g{HB, WDOWN + (size_t)l * DM * DFF, MT, DM, ksl, DFF}; pg8::SplitOrder S{C.G, C.bx}; pg8::EpiPart E{PART}; \
              GEMM2X((pg8::gemm_phase<pg8::EpiPart, pg8::SplitOrder, true, true>(C.lds, g, S, E))); } } \
        SEAM(pb + 3); \
        if (IN(pb + 4) && PH_ON(pb + 4)) ln_phase(C, RES, X2B, ln2_g + l * DM, ln2_b + l * DM, RES, PART); \
        SEAM(pb + 4); \
        if (IN(pb + 5) && PH_ON(pb + 5)) { \
            if (MK_GATE_PART & 1) { int kple = PLE; asm volatile("" : "+s"(kple)); pg8::Gemm g{PB + (size_t)l * MT * PLE, WP + (size_t)l * DM * PLE, MT, DM, kple, PLE}; pg8::StaticOrder S; S.init(MT, DM, C.G, C.bx); \
              pg8::EpiStoreF32 E{PW}; \
              pg8::gemm_phase<pg8::EpiStoreF32, pg8::StaticOrder, true, true>(C.lds, g, S, E); if (NREP(0) > 1) { pg8::gemm_phase<pg8::EpiStoreF32, pg8::StaticOrder, true, true>(C.lds, g, S, E); } } \
            VM_WAIT(); __syncthreads(); \
            if (MK_GATE_PART & 2) { pg8::Gemm g{X2B, WG + (size_t)l * DM * DM, MT, DM, DM, DM}; pg8::StaticOrder S; S.init(MT, DM, C.G, C.bx); \
              pg8::EpiGate E{RES, PW, l == 0 ? Y0 : out + O_Y, l == 0 ? XB : (bf16*)nullptr}; \
              pg8::gemm_phase<pg8::EpiGate, pg8::StaticOrder, true, true>(C.lds, g, S, E); if (NREP(0) > 1) { pg8::gemm_phase<pg8::EpiGate, pg8::StaticOrder, true, true>(C.lds, g, S, E); } } \
        } \
        SEAM(pb + 5); \
    } while (0)
    LAYER_BODY(0);
    LAYER_BODY(1);
#undef LAYER_BODY
#undef IN
#undef SEAM
}

extern "C" void kernel_launch(void* const* d_in, const int* in_sizes, int n_in, void* d_out, int out_size, void* d_ws, size_t ws_size, hipStream_t stream) {
    static int grid = 0;
    if (grid == 0) {
        if (n_in != 22 || out_size != (int)O_END || ws_size < WS_END) { fprintf(stderr, "kernel_launch: unexpected shapes (n_in %d, out %d, ws %zu)\n", n_in, out_size, ws_size); grid = -1; return; }
        int dev = 0, cus = 0;
        if (hipGetDevice(&dev) != hipSuccess || hipDeviceGetAttribute(&cus, hipDeviceAttributeMultiprocessorCount, dev) != hipSuccess) { grid = -1; return; }
        if (hipFuncSetAttribute((const void*)mk_fwd, hipFuncAttributeMaxDynamicSharedMemorySize, LDS_BYTES) != hipSuccess) { fprintf(stderr, "kernel_launch: hipFuncSetAttribute failed\n"); grid = -1; return; }
        int per_cu = 0;
        if (hipOccupancyMaxActiveBlocksPerMultiprocessor(&per_cu, (const void*)mk_fwd, NTHREADS, LDS_BYTES) != hipSuccess || per_cu < 1) fprintf(stderr, "kernel_launch: occupancy query reports %d\n", per_cu);
        (void)hipGetLastError();
        grid = cus - (cus % 8);
        if (grid < 8) grid = 8;
    }
    if (grid < 0) return;
    if (hipMemsetAsync((char*)d_ws + WS_CTL, 0, CTL_ZERO_BYTES, stream) != hipSuccess) return;
    Args a{};
    for (int i = 0; i < 22; ++i) a.in[i] = (const float*)d_in[i];
    a.out = (float*)d_out; a.ws = (unsigned char*)d_ws;
#if MK_PER_PHASE
    for (int p = 0; p < NPH; ++p) { a.ph_lo = p; a.ph_hi = p + 1; hipLaunchKernelGGL(mk_fwd, dim3(grid), dim3(NTHREADS), LDS_BYTES, stream, a); }
#else
    a.ph_lo = 0; a.ph_hi = NPH;
    hipLaunchKernelGGL(mk_fwd, dim3(grid), dim3(NTHREADS), LDS_BYTES, stream, a);
#endif
}
```

```cpp
#include <hip/hip_runtime.h>
#include <cstdio>
#include <cstdint>
#ifndef MK_PER_PHASE
#define MK_PER_PHASE 0
#endif
#ifndef MK_PH_MASK
#define MK_PH_MASK 0xffffffffu
#endif
constexpr int NWAVES = 8, NTHREADS = 512;
constexpr int DM = 2048, SEQ = 8192, MP = 16384, DECB = 16, DECS = 64, MS = 1024, MT = 17408, PAST = 4096, SALL = 4160;
constexpr int NINA = 5264, NINA_PAD = 5376, NINB = 6144, DFF = 8192, PLE = 256, HD = 128, KVW = 512, TOPK = 256;
constexpr float LN_EPS = 1e-5f, ALPHA = 1.41421356237309515f;
constexpr float QK_SCALE = 0.08838834764831845f;
constexpr float WI_SCALE = 0.25f * 0.08838834764831845f;
constexpr int NPH = 19;

constexpr size_t O_Y = 0;
constexpr size_t O_KAP = (size_t)MT * DM, O_VAP = O_KAP + (size_t)MP * KVW, O_KIP = O_VAP + (size_t)MP * KVW;
constexpr size_t O_KBP = O_KIP + (size_t)MP * HD, O_VBP = O_KBP + (size_t)MP * DM;
constexpr size_t O_KAS = O_VBP + (size_t)MP * DM, O_VAS = O_KAS + (size_t)MS * KVW, O_KIS = O_VAS + (size_t)MS * KVW;
constexpr size_t O_KBS = O_KIS + (size_t)MS * HD, O_VBS = O_KBS + (size_t)MS * DM, O_END = O_VBS + (size_t)MS * DM;
static_assert(O_END == 127008768, "d_out layout");

constexpr size_t MiB = 1u << 20;
constexpr size_t WS_CTL = 0, CTL_ZERO_BYTES = 1 * MiB;
constexpr size_t WS_WINA = 2 * MiB, WS_WOUTA = 23 * MiB, WS_WINB = 31 * MiB, WS_WOUTB = 55 * MiB, WS_WUP = 63 * MiB, WS_WDOWN = 127 * MiB, WS_WG = 191 * MiB, WS_WP = 207 * MiB;
constexpr size_t WS_PB = 210 * MiB, WS_XB = 228 * MiB, WS_X1B = 296 * MiB, WS_X2B = 364 * MiB, WS_QB = 432 * MiB, WS_OB = 500 * MiB, WS_QIB = 568 * MiB;
constexpr size_t WS_KAP = 636 * MiB, WS_VAP = 652 * MiB, WS_KAS = 668 * MiB, WS_VAS = 733 * MiB, WS_KIP = 798 * MiB, WS_KIS = 802 * MiB, WS_WI = 819 * MiB;
constexpr size_t WS_IDX = 821 * MiB, WS_CNT = 838 * MiB, WS_RES = 840 * MiB, WS_Y0 = 976 * MiB, WS_PW = 1112 * MiB, WS_H = 1248 * MiB;
constexpr size_t WS_SCP = 1248 * MiB  , WS_SCS = 1760 * MiB, WS_PART = 1778 * MiB  , WS_END = 1842 * MiB;
static_assert(WS_WINA + (size_t)NINA_PAD * DM * 2 <= WS_WOUTA && WS_PB + (size_t)2 * MT * PLE * 2 <= WS_XB && WS_XB + (size_t)MT * DM * 2 <= WS_X1B && WS_KAS + (size_t)DECB * SALL * KVW * 2 <= WS_VAS
              && WS_KIS + (size_t)DECB * SALL * HD * 2 <= WS_WI && WS_WI + (size_t)MT * 16 * 4 <= WS_IDX && WS_IDX + (size_t)MT * TOPK * 4 <= WS_CNT && WS_RES + (size_t)MT * DM * 4 <= WS_Y0
              && WS_H + (size_t)MT * DFF * 2 <= WS_SCS && WS_SCP + (size_t)MP * SEQ * 4 <= WS_SCS && WS_SCS + (size_t)MS * SALL * 4 <= WS_PART && WS_PART + (size_t)8 * MS * DM * 4 <= WS_END, "d_ws map");
constexpr size_t D_VAP = (WS_VAP - WS_KAP) / 2, D_KAS = (WS_KAS - WS_KAP) / 2, D_VAS = (WS_VAS - WS_KAP) / 2, D_KIS = (WS_KIS - WS_KIP) / 2;
constexpr int CW_BAR = 4096;
constexpr int CW_QSC = 8192;

constexpr int RING_BYTES = 135168;
constexpr int LDSCTL_OFF = RING_BYTES, MISC_OFF = LDSCTL_OFF + 320;
constexpr int LDS_BYTES = 147456;
static_assert(MISC_OFF + 128 <= LDS_BYTES, "LDS map");

#define GAS __attribute__((address_space(1)))
#define LAS __attribute__((address_space(3)))
typedef unsigned short bf16;
typedef unsigned v4u __attribute__((ext_vector_type(4)));
typedef unsigned v2u __attribute__((ext_vector_type(2)));
typedef float f32x4 __attribute__((ext_vector_type(4)));
typedef float f32x2 __attribute__((ext_vector_type(2)));
typedef float f32x16 __attribute__((ext_vector_type(16)));
typedef short bf16x8 __attribute__((ext_vector_type(8)));
typedef __bf16 bf16x2_t __attribute__((ext_vector_type(2)));
#define LDS_WAIT() asm volatile("s_waitcnt lgkmcnt(0)" ::: "memory")
#define VM_WAIT() asm volatile("s_waitcnt vmcnt(0)" ::: "memory")
__device__ __forceinline__ unsigned pk2(float lo, float hi) { f32x2 v = {lo, hi}; bf16x2_t b = __builtin_convertvector(v, bf16x2_t); return __builtin_bit_cast(unsigned, b); }
__device__ __forceinline__ float bf_lo(unsigned w) { return __uint_as_float(w << 16); }
__device__ __forceinline__ float bf_hi(unsigned w) { return __uint_as_float(w & 0xffff0000u); }
__device__ __forceinline__ float dot2bf(unsigned a, unsigned b, float c) { return __builtin_amdgcn_fdot2_f32_bf16(__builtin_bit_cast(bf16x2_t, a), __builtin_bit_cast(bf16x2_t, b), c, false); }
namespace pg8 {
#define PG8_LAS __attribute__((address_space(3)))
typedef unsigned short bf16_t;
typedef short bf16x8 __attribute__((ext_vector_type(8)));
typedef float f32x4 __attribute__((ext_vector_type(4)));
typedef unsigned u32x4 __attribute__((ext_vector_type(4)));
constexpr int BM = 256, BK = 64, HALF = 128, HTB = HALF * BK * 2  , STAGE_BYTES = 8 * HTB, NXCD = 8, WGM = 8;

__host__ __device__ __forceinline__ int lds_byte(int r, int c) { const int st = (r >> 4) * 2 + (c >> 5), rr = r & 15, cc = c & 31, ob = rr * 64 + cc * 2; return st * 1024 + (ob ^ (((ob >> 9) & 1) << 5)); }
__host__ __device__ __forceinline__ void stage_rc(int b, int& R, int& C) { const int st = b / 1024, sb = b % 1024, swz = sb ^ (((sb >> 9) & 1) << 5); R = (st >> 1) * 16 + swz / 64; C = (st & 1) * 32 + (swz % 64) / 2; }
__host__ __device__ __forceinline__ int perm32(int rho) { const int n = rho >> 4, i = rho & 15; return 8 * (i >> 2) + 4 * n + (i & 3); }

struct Unit { int pm, pn, ks; };
struct Gemm { const bf16_t* A; const bf16_t* Bt; int M, N, K, ld; };

struct StaticOrder {
    int nM, nN, nwg, G, c;
    __host__ __device__ void init(int M, int N, int G_, int c_) { nM = M / BM; nN = N / BM; nwg = nM * nN; G = G_; c = c_; }
    __host__ __device__ bool next(int i, Unit& u) const {
        const long L = (long)i * G + c; if (L >= nwg) return false;
        int wgid = (int)L; { const int q = nwg / NXCD, r = nwg % NXCD, xcd = wgid % NXCD, off = wgid / NXCD; wgid = (xcd < r ? xcd * (q + 1) : r * (q + 1) + (xcd - r) * q) + off; }
        const int nig = WGM * nN, gid = wgid / nig, fm = gid * WGM, gsz = (nM - fm) < WGM ? (nM - fm) : WGM;
        u.pm = fm + ((wgid % nig) % gsz); u.pn = (wgid % nig) / gsz; u.ks = 0; return true;
    }
    __device__ __forceinline__ void a_ready(const Unit&) const {}
    __device__ __forceinline__ void done(const Unit&) const {}
};

__device__ __forceinline__ unsigned cvt_pk_bf16(float lo, float hi) { unsigned r; asm volatile("v_cvt_pk_bf16_f32 %0, %1, %2" : "=v"(r) : "v"(lo), "v"(hi)); return r; }
typedef float f32x2 __attribute__((ext_vector_type(2)));
__device__ __forceinline__ void st_bf16x8(bf16_t* p, const f32x4& a, const f32x4& b) { u32x4 w; w.x = ::pk2(a[0], a[1]); w.y = ::pk2(a[2], a[3]); w.z = ::pk2(b[0], b[1]); w.w = ::pk2(b[2], b[3]); *(u32x4*)p = w; }
__device__ __forceinline__ void st_f32x8(float* p, const f32x4& a, const f32x4& b) { *(f32x4*)p = a; *(f32x4*)(p + 4) = b; }
#define PG8_EPI_LOOP(...) \
    _Pragma("unroll") for (int ai = 0; ai < 2; ++ai) _Pragma("unroll") for (int m = 0; m < 4; ++m) { const int row = u.pm * BM + ai * HALF + wr * 64 + m * 16 + fr; \
        _Pragma("unroll") for (int bj = 0; bj < 2; ++bj) { const int cl = bj * HALF + wc * 32 + 8 * fq; const f32x4 v0 = acc[ai][bj][m][0], v1 = acc[ai][bj][m][1]; __VA_ARGS__ } }
#define PG8_EPI_LOOP_F(...) \
    _Pragma("unroll") for (int ai = 0; ai < 2; ++ai) _Pragma("unroll") for (int m = 0; m < 4; ++m) { const int row = u.pm * BM + ai * HALF + wr * 64 + m * 16 + fr; \
        _Pragma("unroll") for (int bj = 0; bj < 2; ++bj) { const int cl = bj * HALF + wc * 32 + 8 * fq; const f32x4 v0 = acc[ai][bj][m][0], v1 = acc[ai][bj][m][1]; __VA_ARGS__ } asm volatile("" ::: "memory"); }

struct EpiInA {
    static constexpr bool PERM = true, AFTER_DRAIN = false;
    bf16_t *Q, *QI, *KAP, *KIP; float* WI; float* out;
    __device__ __forceinline__ void operator()(const f32x4 (&acc)[2][2][4][2], const Unit& u, int wr, int wc, int fr, int fq) const {
        const int pn = u.pn; const bool samp = u.pm >= 64;
        float* fb = nullptr; bf16_t* bb; int ld; bool remap = false;
        if (pn < 8) { bb = Q + pn * BM; ld = ::DM; }
        else if (pn < 12) { const bool isv = pn >= 10; const int c0 = (pn & 1) * BM; ld = ::KVW; remap = samp;
            fb = out + (samp ? (isv ? ::O_VAS : ::O_KAS) - (size_t)::MP * ::KVW : (isv ? ::O_VAP : ::O_KAP)) + c0;
            bb = KAP + (samp ? (isv ? ::D_VAS : ::D_KAS) : (isv ? ::D_VAP : (size_t)0)) + c0; }
        else if (pn < 20) { bb = QI + (pn - 12) * BM; ld = ::DM; }
        else { ld = ::HD; remap = samp; fb = out + (samp ? ::O_KIS - (size_t)::MP * ::HD : ::O_KIP); bb = KIP + (samp ? ::D_KIS : (size_t)0); }
        PG8_EPI_LOOP(
            const int rs = row - ::MP; const size_t brow = remap ? ((size_t)(rs >> 6) * ::SALL + ::PAST + (rs & 63)) : (size_t)row;
            if (pn == 20 && cl >= 128) { if (cl < 144) st_f32x8(WI + (size_t)row * 16 + (cl - 128), v0 * ::WI_SCALE, v1 * ::WI_SCALE); }
            else { if (fb) st_f32x8(fb + (size_t)row * ld + cl, v0, v1); st_bf16x8(bb + brow * ld + cl, v0, v1); }
        )
    }
};
struct EpiInB {
    static constexpr bool PERM = true, AFTER_DRAIN = false;
    bf16_t* Q; float* out;
    __device__ __forceinline__ void operator()(const f32x4 (&acc)[2][2][4][2], const Unit& u, int wr, int wc, int fr, int fq) const {
        const int pn = u.pn; const bool samp = u.pm >= 64;
        PG8_EPI_LOOP(
            if (pn < 8) st_bf16x8(Q + (size_t)row * ::DM + pn * BM + cl, v0, v1);
            else { const bool isv = pn >= 16; const int c = (pn - (isv ? 16 : 8)) * BM + cl;
                float* of = out + (samp ? (isv ? ::O_VBS : ::O_KBS) + (size_t)(row - ::MP) * ::DM : (isv ? ::O_VBP : ::O_KBP) + (size_t)row * ::DM) + c; st_f32x8(of, v0, v1); }
        )
    }
};
struct EpiResid {
    static constexpr bool PERM = true, AFTER_DRAIN = false;
    const float* x; float* RES;
    __device__ __forceinline__ void operator()(const f32x4 (&acc)[2][2][4][2], const Unit& u, int wr, int wc, int fr, int fq) const {
        const int pn = u.pn;
        PG8_EPI_LOOP_F(
            const size_t off = (size_t)row * ::DM + pn * BM + cl; const f32x4 x0 = *(const f32x4*)(x + off), x1 = *(const f32x4*)(x + off + 4);
            st_f32x8(RES + off, x0 * ::ALPHA + v0, x1 * ::ALPHA + v1);
        )
    }
};
struct EpiPart {
    static constexpr bool PERM = true, AFTER_DRAIN = false;
    float* PART;
    __device__ __forceinline__ void operator()(const f32x4 (&acc)[2][2][4][2], const Unit& u, int wr, int wc, int fr, int fq) const {
        const int pn = u.pn; float* base = PART + (size_t)u.ks * ::MS * ::DM;
        PG8_EPI_LOOP( st_f32x8(base + (size_t)(row - ::MP) * ::DM + pn * BM + cl, v0, v1); )
    }
};
struct SplitOrder {
    int G, c;
    __device__ __forceinline__ bool next(int i, Unit& u) const { const int L = i * G + c; if (L >= 256) return false; u.pm = 64 + (L & 3); u.pn = (L >> 2) & 7; u.ks = L >> 5; return true; }
    __device__ __forceinline__ void a_ready(const Unit&) const {}
    __device__ __forceinline__ void done(const Unit&) const {}
};
struct EpiSqRelu {
    static constexpr bool PERM = true, AFTER_DRAIN = false;
    bf16_t* H;
    __device__ __forceinline__ void operator()(const f32x4 (&acc)[2][2][4][2], const Unit& u, int wr, int wc, int fr, int fq) const {
        const int pn = u.pn;
        PG8_EPI_LOOP(
            f32x4 a = __builtin_elementwise_max(v0, (f32x4){0.f, 0.f, 0.f, 0.f}), b = __builtin_elementwise_max(v1, (f32x4){0.f, 0.f, 0.f, 0.f});
            st_bf16x8(H + (size_t)row * ::DFF + pn * BM + cl, a * a, b * b);
        )
    }
};
struct EpiStoreF32 {
    static constexpr bool PERM = true, AFTER_DRAIN = false;
    float* C;
    __device__ __forceinline__ void operator()(const f32x4 (&acc)[2][2][4][2], const Unit& u, int wr, int wc, int fr, int fq) const {
        const int pn = u.pn;
        PG8_EPI_LOOP( st_f32x8(C + (size_t)row * ::DM + pn * BM + cl, v0, v1); )
    }
};
struct EpiGate {
    static constexpr bool PERM = true, AFTER_DRAIN = false;
    const float* X2; const float* PW; float* Y; bf16_t* YB;
    __device__ __forceinline__ f32x4 sig(const f32x4& v) const { f32x4 r;
#pragma unroll
        for (int i = 0; i < 4; ++i) r[i] = __builtin_amdgcn_rcpf(1.0f + __expf(-v[i])); return r; }
    __device__ __forceinline__ void operator()(const f32x4 (&acc)[2][2][4][2], const Unit& u, int wr, int wc, int fr, int fq) const {
        const int pn = u.pn;
        PG8_EPI_LOOP_F(
            const size_t off = (size_t)row * ::DM + pn * BM + cl;
            const f32x4 y0 = *(const f32x4*)(X2 + off) + sig(v0) * *(const f32x4*)(PW + off), y1 = *(const f32x4*)(X2 + off + 4) + sig(v1) * *(const f32x4*)(PW + off + 4);
            st_f32x8(Y + off, y0, y1); if (YB) st_bf16x8(YB + off, y0, y1);
        )
    }
};
template <class Epi, class Sched, bool ALIGN_EPI = false, bool SP2 = false>
__device__ __forceinline__ void gemm_phase(PG8_LAS unsigned char* lds, const Gemm g, const Sched& S, const Epi& E) {
    const int tid = threadIdx.x, wid = __builtin_amdgcn_readfirstlane(tid >> 6), lane = tid & 63, wr = wid >> 2, wc = wid & 3, fr = lane & 15, fq = lane >> 4;
    const int K = g.ld, nt = g.K / BK;
    const size_t kslice = (size_t)g.K * 2;
    unsigned voffA[2], voffB[2];
#pragma unroll
    for (int i = 0; i < 2; ++i) { int R, C; stage_rc(tid * 16 + i * 8192, R, C); const int Rb = Epi::PERM ? ((R & ~31) + perm32(R & 31)) : R;
        voffA[i] = (unsigned)(R * K + C) * 2u; voffB[i] = (unsigned)(Rb * K + C) * 2u; }
    const size_t kstep = (size_t)(BK * 2);
    const size_t hstep = (size_t)HALF * K * 2;
    const size_t tstep = 2 * hstep;
    const unsigned ldsw = (unsigned)wid * 1024u;
    const int aoff = lds_byte(wr * 64 + fr, fq * 8), boff = lds_byte(wc * 32 + fr, fq * 8);
#define PG8_SA(b, h) (((b) * 2 + (h)) * HTB)
#define PG8_SB(b, h) ((4 + (b) * 2 + (h)) * HTB)
#define PG8_STAGE(bufoff, gbase, voff) do { _Pragma("unroll") for (int _i = 0; _i < 2; ++_i) \
        __builtin_amdgcn_global_load_lds((const unsigned*)((const char*)(gbase) + (voff)[_i]), (PG8_LAS unsigned*)(lds + (bufoff) + ldsw + _i * 8192), 16, 0, 0); } while (0)
#define PG8_LDA(dst, b, h) do { _Pragma("unroll") for (int m = 0; m < 4; ++m) _Pragma("unroll") for (int k = 0; k < 2; ++k) dst[m][k] = *(const PG8_LAS bf16x8*)(lds + PG8_SA(b, h) + aoff + m * 2048 + k * 1024); } while (0)
#define PG8_LDB(dst, b, h) do { _Pragma("unroll") for (int n = 0; n < 2; ++n) _Pragma("unroll") for (int k = 0; k < 2; ++k) dst[n][k] = *(const PG8_LAS bf16x8*)(lds + PG8_SB(b, h) + boff + n * 2048 + k * 1024); } while (0)
#define PG8_MMA(ai, bj, At, Bt) do { __builtin_amdgcn_s_setprio(1); _Pragma("unroll") for (int m = 0; m < 4; ++m) _Pragma("unroll") for (int n = 0; n < 2; ++n) _Pragma("unroll") for (int k = 0; k < 2; ++k) \
        acc[ai][bj][m][n] = __builtin_amdgcn_mfma_f32_16x16x32_bf16(Bt[n][k], At[m][k], acc[ai][bj][m][n], 0, 0, 0); __builtin_amdgcn_s_setprio(0); } while (0)
#define PG8_WAIT_V(n) asm volatile("s_waitcnt vmcnt(" #n ")" ::: "memory")
#define PG8_WAIT_L(n) asm volatile("s_waitcnt lgkmcnt(" #n ")" ::: "memory")
#define PG8_BAR __builtin_amdgcn_s_barrier()
#define PG8_SCHED __builtin_amdgcn_sched_barrier(0)
    Unit cur, nxt; int ui = 0;
    if (!S.next(0, cur)) return;
    f32x4 acc[2][2][4][2];
#pragma unroll
    for (int a = 0; a < 2; ++a)
#pragma unroll
        for (int b = 0; b < 2; ++b)
#pragma unroll
            for (int m = 0; m < 4; ++m)
#pragma unroll
                for (int n = 0; n < 2; ++n) acc[a][b][m][n] = (f32x4){0.f, 0.f, 0.f, 0.f};
    bf16x8 At[4][2], B0[2][2], B1[2][2];
    const char* cA = (const char*)g.A + (size_t)cur.pm * tstep + cur.ks * kslice; const char* cB = (const char*)g.Bt + (size_t)cur.pn * tstep + cur.ks * kslice;
    S.a_ready(cur);
    if constexpr (SP2) {
        PG8_STAGE(PG8_SB(0, 0), cB, voffB); PG8_STAGE(PG8_SB(0, 1), cB + hstep, voffB); PG8_STAGE(PG8_SA(0, 0), cA, voffA); PG8_STAGE(PG8_SA(0, 1), cA + hstep, voffA);
        if (wr == 1) PG8_BAR;
        PG8_WAIT_V(2); PG8_BAR;
        PG8_STAGE(PG8_SB(1, 0), cB + kstep, voffB); PG8_STAGE(PG8_SA(1, 0), cA + kstep, voffA); PG8_STAGE(PG8_SB(1, 1), cB + hstep + kstep, voffB);
        PG8_WAIT_V(6); PG8_BAR;
    } else {
        PG8_STAGE(PG8_SB(0, 0), cB, voffB); PG8_STAGE(PG8_SA(0, 0), cA, voffA); PG8_STAGE(PG8_SB(0, 1), cB + hstep, voffB); PG8_STAGE(PG8_SA(0, 1), cA + hstep, voffA);
        if (wr == 1) PG8_BAR;
        PG8_WAIT_V(4); PG8_BAR;
        PG8_STAGE(PG8_SB(1, 0), cB + kstep, voffB); PG8_STAGE(PG8_SA(1, 0), cA + kstep, voffA); PG8_STAGE(PG8_SB(1, 1), cB + hstep + kstep, voffB);
        PG8_WAIT_V(6); PG8_BAR;
    }
    for (;;) {
        const bool has_next = S.next(ui + 1, nxt);
        const char* nA = has_next ? (const char*)g.A + (size_t)nxt.pm * tstep + nxt.ks * kslice : cA; const char* nB = has_next ? (const char*)g.Bt + (size_t)nxt.pn * tstep + nxt.ks * kslice : cB;
        for (int t = 0; t < nt; t += 2) {
            const bool last = (t == nt - 2);
            const char* a1 = cA + (size_t)(t + 1) * kstep;
            const char* a2 = last ? nA : cA + (size_t)(t + 2) * kstep; const char* b2 = last ? nB : cB + (size_t)(t + 2) * kstep;
            const char* a3 = a2 + kstep; const char* b3 = b2 + kstep;
            if (last && has_next) S.a_ready(nxt);
            if constexpr (SP2) {
            PG8_LDB(B0, 0, 0); PG8_LDB(B1, 0, 1); PG8_SCHED; PG8_LDA(At, 0, 0); PG8_STAGE(PG8_SA(1, 1), a1 + hstep, voffA);
            PG8_WAIT_V(8); PG8_WAIT_L(0); PG8_BAR; PG8_MMA(0, 0, At, B0); PG8_MMA(0, 1, At, B1); PG8_BAR; PG8_SCHED;
            PG8_LDA(At, 0, 1); PG8_STAGE(PG8_SB(0, 0), b2, voffB); PG8_STAGE(PG8_SB(0, 1), b2 + hstep, voffB); PG8_STAGE(PG8_SA(0, 0), a2, voffA);
            PG8_WAIT_V(8); PG8_WAIT_L(0); PG8_BAR; PG8_MMA(1, 0, At, B0); PG8_MMA(1, 1, At, B1); PG8_BAR; PG8_SCHED;
            PG8_LDB(B0, 1, 0); PG8_LDB(B1, 1, 1); PG8_SCHED; PG8_LDA(At, 1, 0); PG8_STAGE(PG8_SA(0, 1), a2 + hstep, voffA);
            PG8_WAIT_V(8); PG8_WAIT_L(0); PG8_BAR; PG8_MMA(0, 0, At, B0); PG8_MMA(0, 1, At, B1); PG8_BAR; PG8_SCHED;
            PG8_LDA(At, 1, 1); PG8_STAGE(PG8_SB(1, 0), b3, voffB); PG8_STAGE(PG8_SB(1, 1), b3 + hstep, voffB); PG8_STAGE(PG8_SA(1, 0), a3, voffA);
            PG8_WAIT_V(8); PG8_WAIT_L(0); PG8_BAR; PG8_MMA(1, 0, At, B0); PG8_MMA(1, 1, At, B1); PG8_BAR; PG8_SCHED;
            } else {
            PG8_LDB(B0, 0, 0); PG8_SCHED; PG8_LDA(At, 0, 0); PG8_STAGE(PG8_SA(1, 1), a1 + hstep, voffA);
            PG8_WAIT_L(8); PG8_BAR; PG8_WAIT_L(0); PG8_MMA(0, 0, At, B0); PG8_BAR; PG8_SCHED;
            PG8_LDB(B1, 0, 1); PG8_STAGE(PG8_SB(0, 0), b2, voffB);
            PG8_BAR; PG8_WAIT_L(0); PG8_MMA(0, 1, At, B1); PG8_BAR;
            PG8_LDA(At, 0, 1); PG8_STAGE(PG8_SA(0, 0), a2, voffA);
            PG8_BAR; PG8_WAIT_L(0); PG8_MMA(1, 0, At, B0); PG8_BAR; PG8_SCHED;
            PG8_STAGE(PG8_SB(0, 1), b2 + hstep, voffB);
            PG8_WAIT_V(6); PG8_BAR; PG8_MMA(1, 1, At, B1); PG8_BAR;
            PG8_LDB(B0, 1, 0); PG8_SCHED; PG8_LDA(At, 1, 0); PG8_STAGE(PG8_SA(0, 1), a2 + hstep, voffA);
            PG8_WAIT_L(8); PG8_BAR; PG8_WAIT_L(0); PG8_MMA(0, 0, At, B0); PG8_BAR; PG8_SCHED;
            PG8_LDB(B1, 1, 1); PG8_STAGE(PG8_SB(1, 0), b3, voffB);
            PG8_BAR; PG8_WAIT_L(0); PG8_MMA(0, 1, At, B1); PG8_BAR;
            PG8_LDA(At, 1, 1); PG8_STAGE(PG8_SA(1, 0), a3, voffA);
            PG8_BAR; PG8_WAIT_L(0); PG8_MMA(1, 0, At, B0); PG8_BAR; PG8_SCHED;
            PG8_STAGE(PG8_SB(1, 1), b3 + hstep, voffB);
            PG8_WAIT_V(6); PG8_BAR; PG8_MMA(1, 1, At, B1); PG8_BAR;
            }
        }
        if constexpr (ALIGN_EPI) { if (wr == 0) PG8_BAR; }
        if constexpr (!Epi::AFTER_DRAIN) { E(acc, cur, wr, wc, fr, fq); S.done(cur); }
        if (!has_next) break;
#pragma unroll
        for (int a = 0; a < 2; ++a)
#pragma unroll
            for (int b = 0; b < 2; ++b)
#pragma unroll
                for (int m = 0; m < 4; ++m)
#pragma unroll
                    for (int n = 0; n < 2; ++n) acc[a][b][m][n] = (f32x4){0.f, 0.f, 0.f, 0.f};
        cur = nxt; cA = nA; cB = nB; ++ui;
        if constexpr (ALIGN_EPI) { if (wr == 1) PG8_BAR; }
    }
    PG8_WAIT_V(0);
    if constexpr (!ALIGN_EPI) { if (wr == 0) PG8_BAR; }
    PG8_BAR;
    if constexpr (Epi::AFTER_DRAIN) { E.fused(acc, cur, wr, wc, fr, fq, lds, wid, lane); S.done(cur); }
#undef PG8_SA
#undef PG8_SB
#undef PG8_STAGE
#undef PG8_LDA
#undef PG8_LDB
#undef PG8_MMA
#undef PG8_WAIT_V
#undef PG8_WAIT_L
#undef PG8_BAR
#undef PG8_SCHED
}
}
#define XB_TMO      128
#define XB_XCNT(j)  (256  + 64 * (j))
#define XB_XSUB(j)  (1280 + 64 * (j))
#define XB_XGEN(j)  (2304 + 64 * (j))
#define XB_TOP      3328
#define XB_TOPGEN   3392
#define XCD_BAR_WORDS 3456
#define XB_SPIN_CAP (1u << 18)

__device__ __forceinline__ unsigned xb_ld(unsigned* p)              { return __hip_atomic_load(p, __ATOMIC_RELAXED, __HIP_MEMORY_SCOPE_AGENT); }
__device__ __forceinline__ unsigned xb_add(unsigned* p, unsigned v) { return __hip_atomic_fetch_add(p, v, __ATOMIC_RELAXED, __HIP_MEMORY_SCOPE_AGENT); }
__device__ __forceinline__ unsigned xb_xcc_id() { return (unsigned)__builtin_amdgcn_s_getreg((3 << 11) | 20) & 0xFu; }
#define XB_SPIN(cond, bar) do { unsigned _sp = 0; while (cond) { __builtin_amdgcn_s_sleep(1); \
    if ((++_sp & 255u) == 0u) { if (xb_ld(&(bar)[XB_TMO])) break; if (_sp > XB_SPIN_CAP) { atomicAdd(&(bar)[XB_TMO], 1u); break; } } } } while (0)

struct XcdBarrier {
    unsigned* bar; unsigned x;
    volatile LAS unsigned* st;
};

__device__ __forceinline__ XcdBarrier xcd_barrier_post(unsigned* bar, volatile LAS unsigned* st) {
    XcdBarrier b; b.bar = bar; b.x = xb_xcc_id(); b.st = st;
    if (threadIdx.x == 0) (void)xb_add(&bar[XB_XCNT(b.x)], 1u);
    return b;
}
__device__ __forceinline__ void xcd_barrier_complete(unsigned* bar, unsigned x, unsigned& nloc, unsigned& nx) {
    const unsigned G = gridDim.x * gridDim.y * gridDim.z;
    unsigned sum, cnt, mine, sp = 0u;
    for (;;) {
        sum = 0u; cnt = 0u; mine = 0u;
#pragma unroll
        for (unsigned j = 0; j < 16; ++j) { const unsigned c = xb_ld(&bar[XB_XCNT(j)]); sum += c; cnt += (c > 0u) ? 1u : 0u; mine = (j == x) ? c : mine; }
        if (sum == G) break;
        __builtin_amdgcn_s_sleep(1);
        if ((++sp & 255u) == 0u) { if (xb_ld(&bar[XB_TMO])) break; if (sp > XB_SPIN_CAP) { atomicAdd(&bar[XB_TMO], 1u); break; } }
    }
    nloc = mine > 0u ? mine : 1u; nx = cnt > 0u ? cnt : 1u;
}

__device__ __forceinline__ void xcd_barrier(const XcdBarrier& b) {
    asm volatile("s_waitcnt vmcnt(0)" ::: "memory");
    __syncthreads();
    if (threadIdx.x == 0) {
        unsigned* bar = b.bar;
        __builtin_amdgcn_s_waitcnt(0);
        unsigned nloc = b.st[0], nx = b.st[1];
        if (nloc == 0u) { xcd_barrier_complete(bar, b.x, nloc, nx); b.st[0] = nloc; b.st[1] = nx; }
        const unsigned old = xb_add(&bar[XB_XSUB(b.x)], 1u);
        const unsigned gen = old / nloc;
        if (old + 1u == (gen + 1u) * nloc) {
            __builtin_amdgcn_fence(__ATOMIC_RELEASE, "agent");
            asm volatile("s_waitcnt vmcnt(0)" ::: "memory");
            const unsigned og = xb_add(&bar[XB_TOP], 1u);
            const unsigned tg = og / nx;
            if (og + 1u == (tg + 1u) * nx) xb_add(&bar[XB_TOPGEN], 1u);
            else XB_SPIN(xb_ld(&bar[XB_TOPGEN]) == tg, bar);
            __builtin_amdgcn_fence(__ATOMIC_ACQUIRE, "agent");
            xb_add(&bar[XB_XGEN(b.x)], 1u);
            asm volatile("s_waitcnt vmcnt(0)" ::: "memory");
        } else {
            XB_SPIN(xb_ld(&bar[XB_XGEN(b.x)]) == gen, bar);
            __builtin_amdgcn_fence(__ATOMIC_ACQUIRE, "agent");
            asm volatile("s_waitcnt vmcnt(0)" ::: "memory");
        }
    }
    __syncthreads();
}
#ifndef MK_PROBE
#define MK_PROBE 0
#endif
#define NREP(bit) (((MK_PROBE >> (bit)) & 1) ? 2 : 1)
#define GEMM2X(call) do { call; if (NREP(0) > 1) { call; } } while (0)
#define NREP2(b1, b2) ((((MK_PROBE >> (b1)) | (MK_PROBE >> (b2))) & 1) ? 2 : 1)
#ifndef MK_GATE_PART
#define MK_GATE_PART 3
#endif
typedef GAS unsigned gu32;
#define RLX_AGENT __ATOMIC_RELAXED, __HIP_MEMORY_SCOPE_AGENT
#define MFMA32(a, b, c) __builtin_amdgcn_mfma_f32_32x32x16_bf16((a), (b), (c), 0, 0, 0)

struct Ctx { LAS unsigned char* lds; volatile LAS unsigned* MISC; int tid, lane, wave, G, bx, gw, NGW; };
__device__ __forceinline__ int crow(int r, int hi) { return (r & 3) + 8 * (r >> 2) + 4 * hi; }

__device__ __forceinline__ void p0_transpose_item(const float* W, int K, int N, int NP, bf16* WT, LAS float* scr, int item, int lane) {
    const int nblk = NP / 32, kb = item / nblk, nb = item % nblk, k0 = 64 * kb, n0 = 32 * nb;
    const int nn = n0 + (lane & 31);
#pragma unroll 8
    for (int i = 0; i < 32; ++i) { const int kk = 2 * i + (lane >> 5); scr[kk * 33 + (lane & 31)] = (nn < N) ? W[(size_t)(k0 + kk) * N + nn] : 0.f; }
    LDS_WAIT();
    const int c = lane & 7;
#pragma unroll
    for (int j = 0; j < 4; ++j) { const int n = (lane >> 3) + 8 * j; const LAS float* s = scr + (8 * c) * 33 + n;
        v4u o; o.x = pk2(s[0 * 33], s[1 * 33]); o.y = pk2(s[2 * 33], s[3 * 33]); o.z = pk2(s[4 * 33], s[5 * 33]); o.w = pk2(s[6 * 33], s[7 * 33]);
        *(v4u*)(WT + (size_t)(n0 + n) * K + k0 + 8 * c) = o; }
    LDS_WAIT();
}
__device__ __forceinline__ void transpose_job(const Ctx& C, const float* W, int K, int N, int NP, bf16* WT) {
    LAS float* scr = (LAS float*)(C.lds + C.wave * 16384);
    const int nitems = (K / 64) * (NP / 32);
    for (int it = C.gw; it < nitems; it += C.NGW) p0_transpose_item(W, K, N, NP, WT, scr, it, C.lane);
}
__device__ __forceinline__ void cvt_job(const Ctx& C, const float* src, bf16* dst, int nseg, int seglen, size_t sstride, size_t dstride) {
    const int vps = seglen / 8; const long total = (long)nseg * vps; const long NGT = (long)C.G * NTHREADS;
    for (long i = (long)C.bx * NTHREADS + C.tid; i < total; i += NGT) { const int seg = (int)(i / vps), off = (int)(i % vps) * 8;
        const f32x4 a = *(const f32x4*)(src + seg * sstride + off), b = *(const f32x4*)(src + seg * sstride + off + 4);
        v4u o; o.x = pk2(a.x, a.y); o.y = pk2(a.z, a.w); o.z = pk2(b.x, b.y); o.w = pk2(b.z, b.w); *(v4u*)(dst + seg * dstride + off) = o; }
}

__device__ __forceinline__ float wave_sum(float v) {
#pragma unroll
    for (int o = 1; o < 64; o <<= 1) v += __shfl_xor(v, o);
    return v;
}
__device__ __forceinline__ void ln_phase(const Ctx& C, float* RES, bf16* XO, const float* g, const float* b, const float* xs, const float* PART) {
    for (int row = C.gw; row < MT; row += C.NGW) {
        f32x4* xr = (f32x4*)(RES + (size_t)row * DM) + C.lane;
        f32x4 v[8]; float s = 0.f;
        if (row < MP) {
#pragma unroll
            for (int j = 0; j < 8; ++j) v[j] = xr[64 * j];
        } else {
            const f32x4* xp = (const f32x4*)(xs + (size_t)row * DM) + C.lane;
#pragma unroll
            for (int j = 0; j < 8; ++j) v[j] = xp[64 * j] * ALPHA;
#pragma unroll 2
            for (int ks = 0; ks < 8; ++ks) { const f32x4* pp = (const f32x4*)(PART + ((size_t)ks * MS + (row - MP)) * DM) + C.lane;
#pragma unroll
                for (int j = 0; j < 8; ++j) v[j] += pp[64 * j]; }
        }
#pragma unroll
        for (int j = 0; j < 8; ++j) s += (v[j].x + v[j].y) + (v[j].z + v[j].w);
        const float mean = wave_sum(s) * (1.f / DM); float s2 = 0.f;
#pragma unroll
        for (int j = 0; j < 8; ++j) { v[j] = v[j] - mean; s2 += (v[j].x * v[j].x + v[j].y * v[j].y) + (v[j].z * v[j].z + v[j].w * v[j].w); }
        const float rstd = 1.f / sqrtf(wave_sum(s2) * (1.f / DM) + LN_EPS);
        v2u* o8 = (v2u*)(XO + (size_t)row * DM) + C.lane;
#pragma unroll
        for (int j = 0; j < 8; ++j) { const f32x4 gg = ((const f32x4*)g)[C.lane + 64 * j], bb = ((const f32x4*)b)[C.lane + 64 * j]; const f32x4 y = v[j] * rstd * gg + bb;
            xr[64 * j] = y; v2u w; w.x = pk2(y.x, y.y); w.y = pk2(y.z, y.w); o8[64 * j] = w; }
    }
}

constexpr int SC_QPITCH = 4112, SC_NITEMS = 160 + 2304;
__device__ __forceinline__ void scores_phase(const Ctx& C, unsigned* qhead, const bf16* QIB, const bf16* KIP, const bf16* KIS, const float* WI, float* SCP, float* SCS) {
    const int q = C.lane & 31, hh = C.lane >> 5;
    for (;;) {
        if (C.tid == 0) C.MISC[0] = __hip_atomic_fetch_add(qhead, 1u, RLX_AGENT);
        __syncthreads();
        int id = (int)C.MISC[0];
        __syncthreads();
        if (id >= SC_NITEMS) break;
        int row0, nk, ch, stride; const bf16* KI; float* SC;
        if (id < 160) { const int qt = id / 5; ch = id % 5; const int rs0 = qt * 32, b = rs0 >> 6; row0 = MP + rs0; KI = KIS + (size_t)b * SALL * HD; nk = SALL; SC = SCS + (size_t)rs0 * SALL; stride = SALL; }
        else { id -= 160; int k = 7; while (id >= 64 * (k + 1)) { id -= 64 * (k + 1); --k; }
            const int per = 4 * (k + 1), ci = id / per, rem = id % per, c = 16 * k + 15 - ci, tile4 = rem / (k + 1); ch = rem % (k + 1);
            const int b = tile4 >> 1, t0 = c * 64 + (tile4 & 1) * 32; row0 = b * SEQ + t0; KI = KIP + (size_t)b * SEQ * HD; nk = 64 * (c + 1); SC = SCP + (size_t)row0 * SEQ; stride = SEQ; }
        const int s_begin = ch * 1024, nkc = (nk - s_begin) < 1024 ? (nk - s_begin) : 1024, ntiles = nkc >> 5;
#pragma unroll 4
        for (int i = 0; i < 16; ++i) { const int p = C.tid + NTHREADS * i, qq = p >> 8, off = (p & 255) * 16;
            const v4u v = *(const v4u*)((const char*)QIB + (size_t)(row0 + qq) * (DM * 2) + off); *(LAS v4u*)(C.lds + qq * SC_QPITCH + off) = v; }
        LAS float* wl = (LAS float*)(C.lds + 32 * SC_QPITCH);
        { const int qq = C.tid >> 4, h2 = C.tid & 15; wl[qq * 17 + h2] = WI[(size_t)(row0 + qq) * 16 + h2]; }
        __syncthreads();
        const LAS unsigned char* qb = C.lds + q * SC_QPITCH + hh * 16;
        for (int ti = C.wave; ti < ntiles; ti += NWAVES) {
            const int s0 = s_begin + ti * 32;
            const bf16* kp = KI + (size_t)(s0 + q) * HD + 8 * hh;
            bf16x8 kf[8];
#pragma unroll
            for (int kk = 0; kk < 8; ++kk) kf[kk] = *(const bf16x8*)(kp + 16 * kk);
            f32x16 acc;
#pragma unroll
            for (int r = 0; r < 16; ++r) acc[r] = 0.f;
#pragma unroll 2
            for (int h = 0; h < 16; ++h) {
                f32x16 c; const float wh = wl[q * 17 + h];
#pragma unroll
                for (int r = 0; r < 16; ++r) c[r] = 0.f;
#pragma unroll
                for (int kk = 0; kk < 8; ++kk) { const bf16x8 bq = *(const LAS bf16x8*)(qb + h * 256 + kk * 32); c = MFMA32(kf[kk], bq, c); }
#pragma unroll
                for (int r = 0; r < 16; ++r) acc[r] += wh * __builtin_fmaxf(c[r], 0.f);
            }
            float* sp = SC + (size_t)q * stride + s0 + 4 * hh;
#pragma unroll
            for (int g = 0; g < 4; ++g) *(f32x4*)(sp + 8 * g) = (f32x4){acc[4 * g], acc[4 * g + 1], acc[4 * g + 2], acc[4 * g + 3]};
        }
        __syncthreads();
    }
}

__device__ __forceinline__ unsigned tokey(float f) { const unsigned u = __float_as_uint(f); return (u & 0x80000000u) ? ~u : (u | 0x80000000u); }
__device__ __forceinline__ void select_phase(const Ctx& C, const float* SCP, const float* SCS, int* IDX, int* CNT) {
    LAS unsigned* hist = (LAS unsigned*)(C.lds + C.wave * 1024);
    const int lane = C.lane; const unsigned long long ltm = (1ull << lane) - 1ull;
    for (int row = C.gw; row < MT; row += C.NGW) {
        int n; const float* sc;
        if (row < MP) { const int t = row & (SEQ - 1); n = 64 * ((t >> 6) + 1); sc = SCP + (size_t)row * SEQ; } else { n = SALL; sc = SCS + (size_t)(row - MP) * SALL; }
        int* ip = IDX + (size_t)row * TOPK;
        if (n <= TOPK) {
#pragma unroll
            for (int k = 0; k < 4; ++k) { const int i = lane + 64 * k; ip[i] = (i < n) ? i : 0; }
            if (lane == 0) CNT[row] = n;
            continue;
        }
        v4u kreg[32];
#pragma unroll
        for (int it = 0; it < 32; ++it) { kreg[it] = (v4u){0u, 0u, 0u, 0u};
            if (it * 256 < n) { if (it * 256 + lane * 4 < n) { const f32x4 v = *(const f32x4*)(sc + it * 256 + lane * 4); kreg[it] = (v4u){tokey(v.x), tokey(v.y), tokey(v.z), tokey(v.w)}; } } }
        unsigned prefix = 0u, mask = 0u, krem = TOPK;
        for (int pass = 0; pass < 4; ++pass) {
            const int shift = 24 - 8 * pass;
            *(LAS v4u*)(hist + 4 * lane) = (v4u){0u, 0u, 0u, 0u};
            LDS_WAIT();
#pragma unroll
            for (int it = 0; it < 32; ++it) if (it * 256 < n) {
#pragma unroll
                for (int e = 0; e < 4; ++e) { const unsigned key = kreg[it][e]; if ((key & mask) == prefix && it * 256 + lane * 4 < n) __hip_atomic_fetch_add(hist + ((key >> shift) & 255u), 1u, __ATOMIC_RELAXED, __HIP_MEMORY_SCOPE_WORKGROUP); } }
            LDS_WAIT();
            const v4u hc = *(const LAS v4u*)(hist + 4 * lane);
            const unsigned tot = hc.x + hc.y + hc.z + hc.w; unsigned x = tot;
#pragma unroll
            for (int o = 1; o < 64; o <<= 1) { const unsigned y = __shfl_down(x, o); if (lane + o < 64) x += y; }
            const unsigned a3 = x - tot, a2 = a3 + hc.w, a1 = a2 + hc.z, a0 = a1 + hc.y;
            int fe = -1; unsigned fa = 0u;
            if (a3 < krem && krem <= a3 + hc.w) { fe = 3; fa = a3; } else if (a2 < krem && krem <= a2 + hc.z) { fe = 2; fa = a2; }
            else if (a1 < krem && krem <= a1 + hc.y) { fe = 1; fa = a1; } else if (a0 < krem && krem <= a0 + hc.x) { fe = 0; fa = a0; }
            const unsigned long long bal = __ballot(fe >= 0); const int src = bal ? (__ffsll((long long)bal) - 1) : 0;
            const unsigned d = (unsigned)__shfl(4 * lane + fe, src), above = (unsigned)__shfl((int)fa, src);
            krem -= above; prefix |= d << shift; mask |= 0xffu << shift;
        }
        int outc = 0, eqs = 0;
#pragma unroll
        for (int it = 0; it < 32; ++it) if (it * 256 < n) {
            const bool inr = it * 256 + lane * 4 < n;
            bool eq[4], sel[4];
#pragma unroll
            for (int e = 0; e < 4; ++e) { eq[e] = inr && kreg[it][e] == prefix; sel[e] = inr && kreg[it][e] > prefix; }
            const unsigned long long anyeq = __ballot(eq[0] || eq[1] || eq[2] || eq[3]);
            if (anyeq) {
                const int mine = (int)eq[0] + (int)eq[1] + (int)eq[2] + (int)eq[3];
                int below = 0, total = 0;
#pragma unroll
                for (int e = 0; e < 4; ++e) { const unsigned long long bb = __ballot(eq[e]); below += __popcll(bb & ltm); total += __popcll(bb); }
                int r = eqs + below;
#pragma unroll
                for (int e = 0; e < 4; ++e) { if (eq[e]) { if ((unsigned)r < krem) sel[e] = true; ++r; } }
                eqs += total; (void)mine;
            }
#pragma unroll
            for (int e = 0; e < 4; ++e) { const unsigned long long sb = __ballot(sel[e]); const int pos = outc + __popcll(sb & ltm); if (sel[e] && pos < TOPK) ip[pos] = it * 256 + lane * 4 + e; outc += __popcll(sb); }
        }
        if (lane == 0) CNT[row] = outc < TOPK ? outc : TOPK;
    }
}

__device__ __forceinline__ int t5_bucket(int n  ) {
    const int ret = (n < 0) ? 16 : 0; n = n < 0 ? -n : n;
    if (n < 8) return ret + n;
    const int lg = 31 - __builtin_clz((unsigned)(n * n));
    const int large = 2 + lg; return ret + (large < 15 ? large : 15);
}
__device__ __forceinline__ float dpp_quad_sum(float t) {
    t += __builtin_bit_cast(float, __builtin_amdgcn_mov_dpp(__builtin_bit_cast(int, t), 0xB1, 0xF, 0xF, true));
    t += __builtin_bit_cast(float, __builtin_amdgcn_mov_dpp(__builtin_bit_cast(int, t), 0x4E, 0xF, 0xF, true));
    return t;
}
__device__ __forceinline__ void sattn_task(int row, int g, int qpos, const bf16* Kb, const bf16* Vb, int cnt, const int* ip, const bf16* QB, bf16* OB,
                                           LAS int* idxl, LAS float* lg, const LAS float* biasl, int lane) {
#pragma unroll
    for (int k = 0; k < 4; ++k) { const int j = lane + 64 * k; const int v = ip[j]; idxl[j] = (j < cnt) ? v : 0; }
    const int kq = lane >> 2, c4 = lane & 3;
    unsigned qreg[4][16];
    { const bf16* qp = QB + (size_t)row * DM + (4 * g) * HD + 32 * c4;
#pragma unroll
      for (int hq = 0; hq < 4; ++hq)
#pragma unroll
          for (int i = 0; i < 4; ++i) { const v4u a = *(const v4u*)(qp + hq * HD + 8 * i); qreg[hq][4 * i] = a.x; qreg[hq][4 * i + 1] = a.y; qreg[hq][4 * i + 2] = a.z; qreg[hq][4 * i + 3] = a.w; } }
    LDS_WAIT();
    for (int r0 = 0; r0 < 16; r0 += 2) {
        v4u kd[2][4];
#pragma unroll
        for (int rr = 0; rr < 2; ++rr) { const int key = idxl[16 * (r0 + rr) + kq]; const bf16* kp = Kb + (size_t)key * KVW + 32 * c4;
#pragma unroll
            for (int i = 0; i < 4; ++i) kd[rr][i] = *(const v4u*)(kp + 8 * i); }
#pragma unroll
        for (int rr = 0; rr < 2; ++rr) { float s[4];
#pragma unroll
            for (int hq = 0; hq < 4; ++hq) { float t = 0.f;
#pragma unroll
                for (int i = 0; i < 4; ++i) { t = dot2bf(kd[rr][i].x, qreg[hq][4 * i], t); t = dot2bf(kd[rr][i].y, qreg[hq][4 * i + 1], t); t = dot2bf(kd[rr][i].z, qreg[hq][4 * i + 2], t); t = dot2bf(kd[rr][i].w, qreg[hq][4 * i + 3], t); }
                s[hq] = dpp_quad_sum(t); }
            const float sv = c4 == 0 ? s[0] : c4 == 1 ? s[1] : c4 == 2 ? s[2] : s[3];
            lg[(16 * (r0 + rr) + kq) * 4 + c4] = sv; }
    }
    LDS_WAIT();
    float l[4][4];
#pragma unroll
    for (int k = 0; k < 4; ++k) { const int j = lane + 64 * k; const f32x4 l4 = *(const LAS f32x4*)(lg + 4 * j); const int key = idxl[j]; const int bk = t5_bucket(qpos - key);
        const f32x4 b4 = *(const LAS f32x4*)(biasl + bk * 16 + 4 * g); const bool valid = j < cnt;
#pragma unroll
        for (int hq = 0; hq < 4; ++hq) l[k][hq] = valid ? l4[hq] * QK_SCALE + b4[hq] : -INFINITY; }
    LDS_WAIT();
#pragma unroll
    for (int hq = 0; hq < 4; ++hq) { float m = __builtin_fmaxf(__builtin_fmaxf(l[0][hq], l[1][hq]), __builtin_fmaxf(l[2][hq], l[3][hq]));
#pragma unroll
        for (int o = 1; o < 64; o <<= 1) m = __builtin_fmaxf(m, __shfl_xor(m, o));
        float sum = 0.f;
#pragma unroll
        for (int k = 0; k < 4; ++k) { l[k][hq] = __expf(l[k][hq] - m); sum += l[k][hq]; }
        sum = wave_sum(sum); const float inv = 1.0f / sum;
#pragma unroll
        for (int k = 0; k < 4; ++k) l[k][hq] *= inv; }
#pragma unroll
    for (int k = 0; k < 4; ++k) { const int j = lane + 64 * k; *(LAS f32x4*)(lg + 4 * j) = (f32x4){l[k][0], l[k][1], l[k][2], l[k][3]}; }
    LDS_WAIT();
    const int ks = lane >> 4, dc = lane & 15;
    f32x2 o[4][4];
#pragma unroll
    for (int hq = 0; hq < 4; ++hq)
#pragma unroll
        for (int i = 0; i < 4; ++i) o[hq][i] = (f32x2){0.f, 0.f};
    const bf16* vp = Vb + 8 * dc;
    for (int jb = 0; jb < TOPK; jb += 32) {
        v4u w[8]; f32x4 p4[8];
#pragma unroll
        for (int u = 0; u < 8; ++u) { const int j = jb + 4 * u + ks; const int key = idxl[j]; w[u] = *(const v4u*)(vp + (size_t)key * KVW); p4[u] = *(const LAS f32x4*)(lg + 4 * j); }
#pragma unroll
        for (int u = 0; u < 8; ++u) { const f32x2 v0 = (f32x2){bf_lo(w[u].x), bf_hi(w[u].x)}, v1 = (f32x2){bf_lo(w[u].y), bf_hi(w[u].y)}, v2 = (f32x2){bf_lo(w[u].z), bf_hi(w[u].z)}, v3 = (f32x2){bf_lo(w[u].w), bf_hi(w[u].w)};
#pragma unroll
            for (int hq = 0; hq < 4; ++hq) { const float ph = p4[u][hq]; o[hq][0] += ph * v0; o[hq][1] += ph * v1; o[hq][2] += ph * v2; o[hq][3] += ph * v3; } }
    }
    v4u st = (v4u){0u, 0u, 0u, 0u};
#pragma unroll
    for (int hq = 0; hq < 4; ++hq) { unsigned pk[4];
#pragma unroll
        for (int i = 0; i < 4; ++i) { float x = o[hq][i].x, y = o[hq][i].y; x += __shfl_xor(x, 16); x += __shfl_xor(x, 32); y += __shfl_xor(y, 16); y += __shfl_xor(y, 32); pk[i] = pk2(x, y); }
        if (ks == hq) st = (v4u){pk[0], pk[1], pk[2], pk[3]}; }
    *(v4u*)(OB + (size_t)row * DM + (4 * g + ks) * HD + 8 * dc) = st;
    LDS_WAIT();
}
__device__ __forceinline__ void sattn_phase(const Ctx& C, const float* rel_bias, const bf16* QB, const bf16* KAP, const bf16* VAP, const bf16* KAS, const bf16* VAS, const int* IDX, const int* CNT, bf16* OB) {
    LAS float* biasl = (LAS float*)C.lds;
    LAS int* idxl = (LAS int*)(C.lds + 2048 + C.wave * 5120); LAS float* lg = (LAS float*)(C.lds + 2048 + C.wave * 5120 + 1024);
    if (C.tid < 512) biasl[C.tid] = rel_bias[C.tid];
    __syncthreads();
    const int x8 = C.bx & 7, g = x8 & 3, par = x8 >> 2, wi = (C.bx >> 3) * NWAVES + C.wave, nw = (C.G >> 3) * NWAVES;
    for (int k = wi; k < SEQ + 512; k += nw) {
        if (k < SEQ) { const int row = par * SEQ + k;
            sattn_task(row, g, k, KAP + (size_t)par * SEQ * KVW + g * HD, VAP + (size_t)par * SEQ * KVW + g * HD, CNT[row], IDX + (size_t)row * TOPK, QB, OB, idxl, lg, biasl, C.lane); }
        else { const int j = k - SEQ, b = 2 * (j >> 6) + par, i = j & 63, row = MP + b * DECS + i;
            sattn_task(row, g, PAST + i, KAS + (size_t)b * SALL * KVW + g * HD, VAS + (size_t)b * SALL * KVW + g * HD, CNT[row], IDX + (size_t)row * TOPK, QB, OB, idxl, lg, biasl, C.lane); }
    }
}

constexpr int VT_PITCH = 72;
__device__ __forceinline__ bf16x8 pack8(const f32x4& a, const f32x4& b) { v4u w; w.x = pk2(a.x, a.y); w.y = pk2(a.z, a.w); w.z = pk2(b.x, b.y); w.w = pk2(b.z, b.w); return __builtin_bit_cast(bf16x8, w); }
__device__ __forceinline__ const float* sb_rowp(bool samp, int b, int s, int h, const float* newp, const float* cache) {
    if (!samp) return newp + (size_t)(b * SEQ + s) * DM + h * HD;
    if (s < PAST) return cache + ((size_t)(b * PAST + s) * 16 + h) * HD;
    return newp + (size_t)(b * DECS + (s - PAST)) * DM + h * HD;
}
__device__ __forceinline__ void sb_task(bool samp, int b, int h, int qpos0, int r0, const bf16* QB, const float* knew, const float* vnew, const float* kcache, const float* vcache, bf16* OB, LAS unsigned char* vt, int lane) {
    const int q = lane & 31, hh = lane >> 5;
    bf16x8 qf[8];
    { const bf16* qp = QB + (size_t)(r0 + q) * DM + h * HD + 8 * hh;
#pragma unroll
      for (int kk = 0; kk < 8; ++kk) qf[kk] = *(const bf16x8*)(qp + 16 * kk); }
    f32x16 O[4];
#pragma unroll
    for (int db = 0; db < 4; ++db)
#pragma unroll
        for (int r = 0; r < 16; ++r) O[db][r] = 0.f;
    float R = 1.f; const int t = qpos0 + q;
    for (int kt = qpos0 >> 5; kt >= 0; --kt) {
        const float* kb = sb_rowp(samp, b, 32 * kt, h, knew, kcache); const float* vb = sb_rowp(samp, b, 32 * kt, h, vnew, vcache);
        f32x16 c;
#pragma unroll
        for (int r = 0; r < 16; ++r) c[r] = 0.f;
        { const float* kl = kb + (size_t)q * DM + 8 * hh;
#pragma unroll
          for (int kk = 0; kk < 8; ++kk) { const f32x4 a = *(const f32x4*)(kl + 16 * kk), bq = *(const f32x4*)(kl + 16 * kk + 4); c = MFMA32(pack8(a, bq), qf[kk], c); } }
        { const int d4 = lane & 31, kq = lane >> 5;
#pragma unroll
          for (int i = 0; i < 8; ++i) { const int kp = kq + 2 * i; const float* v0p = vb + (size_t)(2 * kp) * DM + 4 * d4; const f32x4 va = *(const f32x4*)v0p, vb2 = *(const f32x4*)(v0p + DM);
#pragma unroll
              for (int e = 0; e < 4; ++e) *(LAS unsigned*)(vt + (4 * d4 + e) * VT_PITCH + 4 * kp) = pk2(va[e], vb2[e]); } }
        float om[16], be[16];
#pragma unroll
        for (int r = 0; r < 16; ++r) { const int s = 32 * kt + crow(r, hh); const float z = c[r] * QK_SCALE; const float a = __expf(-__builtin_fabsf(z)); const float rr = __builtin_amdgcn_rcpf(1.0f + a), ar = a * rr;
            const bool m = s < t; const float beta = z > 0.f ? rr : ar, omb = z > 0.f ? ar : rr; om[r] = m ? omb : 1.f; be[r] = m ? beta : 0.f; }
        float pg[4], pp[4], tt[4];
#pragma unroll
        for (int gi = 0; gi < 4; ++gi) { pg[gi] = (om[4 * gi] * om[4 * gi + 1]) * (om[4 * gi + 2] * om[4 * gi + 3]); pp[gi] = __shfl_xor(pg[gi], 32); tt[gi] = pg[gi] * pp[gi]; }
        float SB[4]; SB[3] = 1.f; SB[2] = tt[3]; SB[1] = tt[3] * tt[2]; SB[0] = SB[1] * tt[1];
        float A[16];
#pragma unroll
        for (int gi = 0; gi < 4; ++gi) { const float s3 = R * SB[gi] * (hh == 0 ? pp[gi] : 1.f), s2 = s3 * om[4 * gi + 3], s1 = s2 * om[4 * gi + 2], s0 = s1 * om[4 * gi + 1];
            A[4 * gi + 3] = be[4 * gi + 3] * s3; A[4 * gi + 2] = be[4 * gi + 2] * s2; A[4 * gi + 1] = be[4 * gi + 1] * s1; A[4 * gi] = be[4 * gi] * s0; }
        R = R * (SB[0] * tt[0]);
        bf16x8 pf[2];
#pragma unroll
        for (int s = 0; s < 2; ++s) { v4u w; w.x = pk2(A[8 * s], A[8 * s + 1]); w.y = pk2(A[8 * s + 2], A[8 * s + 3]); w.z = pk2(A[8 * s + 4], A[8 * s + 5]); w.w = pk2(A[8 * s + 6], A[8 * s + 7]); pf[s] = __builtin_bit_cast(bf16x8, w); }
        LDS_WAIT();
#pragma unroll
        for (int db = 0; db < 4; ++db)
#pragma unroll
            for (int s = 0; s < 2; ++s) { const LAS unsigned char* ap = vt + (32 * db + q) * VT_PITCH + (16 * s + 4 * hh) * 2; const v2u lo = *(const LAS v2u*)ap, hi2 = *(const LAS v2u*)(ap + 16);
                v4u w; w.x = lo.x; w.y = lo.y; w.z = hi2.x; w.w = hi2.y; O[db] = MFMA32(__builtin_bit_cast(bf16x8, w), pf[s], O[db]); }
        LDS_WAIT();
        if (__all(R == 0.f)) break;
    }
#pragma unroll
    for (int db = 0; db < 4; ++db)
#pragma unroll
        for (int rg = 0; rg < 4; ++rg) { v2u w; w.x = pk2(O[db][4 * rg], O[db][4 * rg + 1]); w.y = pk2(O[db][4 * rg + 2], O[db][4 * rg + 3]);
            *(v2u*)(OB + (size_t)(r0 + q) * DM + h * HD + 32 * db + 8 * rg + 4 * hh) = w; }
}
__device__ __forceinline__ void sbattn_phase(const Ctx& C, const bf16* QB, float* out, const float* kcache, const float* vcache, bf16* OB) {
    LAS unsigned char* vt = C.lds + C.wave * 9216;
    for (int id = C.gw; id < 8192 + 512; id += C.NGW) {
        if (id < 8192) { const int b = id >> 12, h = (id >> 8) & 15, qt = id & 255; sb_task(false, b, h, qt * 32, b * SEQ + qt * 32, QB, out + O_KBP, out + O_VBP, kcache, vcache, OB, vt, C.lane); }
        else { const int j = id - 8192, b = j >> 5, h = (j >> 1) & 15, hf = j & 1; sb_task(true, b, h, PAST + 32 * hf, MP + b * DECS + 32 * hf, QB, out + O_KBS, out + O_VBS, kcache, vcache, OB, vt, C.lane); }
    }
}

struct Args { const float* in[22]; float* out; unsigned char* ws; int ph_lo, ph_hi; };
__global__ void __launch_bounds__(NTHREADS, 2) mk_fwd(Args args) {
    extern __shared__ __attribute__((aligned(16))) unsigned char lds_raw[];
    Ctx C;
    C.lds = (LAS unsigned char*)lds_raw; C.MISC = (volatile LAS unsigned*)(C.lds + MISC_OFF);
    C.tid = threadIdx.x; C.lane = C.tid & 63; C.wave = __builtin_amdgcn_readfirstlane(C.tid >> 6);
    C.G = gridDim.x; C.bx = blockIdx.x; C.gw = C.bx * NWAVES + C.wave; C.NGW = C.G * NWAVES;
    unsigned char* ws = args.ws; unsigned* ctl = (unsigned*)(ws + WS_CTL); float* out = args.out;
    for (int u = C.tid; u < (LDS_BYTES - LDSCTL_OFF) / 4; u += NTHREADS) ((LAS unsigned*)(C.lds + LDSCTL_OFF))[u] = 0u;
    __syncthreads();
    XcdBarrier bar; bar.bar = ctl + CW_BAR; bar.x = 0; bar.st = nullptr;
    if (!MK_PER_PHASE) bar = xcd_barrier_post(ctl + CW_BAR, C.MISC + 8);
    const int lo = args.ph_lo, hi = args.ph_hi;
#define IN(k) (lo <= (k) && (k) < hi)
#define PH_ON(k) ((MK_PH_MASK >> (k)) & 1u)
#define SEAM(k) do { if (!MK_PER_PHASE && IN(k) && IN((k) + 1)) xcd_barrier(bar); } while (0)
    const float *x_prompt = args.in[0], *x_sample = args.in[1], *cache_k_a = args.in[2], *cache_v_a = args.in[3], *cache_kidx_a = args.in[4], *cache_k_b = args.in[5], *cache_v_b = args.in[6];
    const float *p_prompt = args.in[7], *p_sample = args.in[8], *rel_bias = args.in[9], *w_in_a = args.in[10], *w_out_a = args.in[11], *w_in_b = args.in[12], *w_out_b = args.in[13];
    const float *ln1_g = args.in[14], *ln1_b = args.in[15], *ln2_g = args.in[16], *ln2_b = args.in[17], *w_up = args.in[18], *w_down = args.in[19], *w_ple = args.in[20], *w_ple_gate = args.in[21];
    bf16 *WINA = (bf16*)(ws + WS_WINA), *WOUTA = (bf16*)(ws + WS_WOUTA), *WINB = (bf16*)(ws + WS_WINB), *WOUTB = (bf16*)(ws + WS_WOUTB), *WUP = (bf16*)(ws + WS_WUP), *WDOWN = (bf16*)(ws + WS_WDOWN), *WG = (bf16*)(ws + WS_WG), *WP = (bf16*)(ws + WS_WP);
    bf16 *PB = (bf16*)(ws + WS_PB), *XB = (bf16*)(ws + WS_XB), *X1B = (bf16*)(ws + WS_X1B), *X2B = (bf16*)(ws + WS_X2B), *QB = (bf16*)(ws + WS_QB), *OB = (bf16*)(ws + WS_OB), *QIB = (bf16*)(ws + WS_QIB);
    bf16 *KAP = (bf16*)(ws + WS_KAP), *VAP = (bf16*)(ws + WS_VAP), *KAS = (bf16*)(ws + WS_KAS), *VAS = (bf16*)(ws + WS_VAS), *KIP = (bf16*)(ws + WS_KIP), *KIS = (bf16*)(ws + WS_KIS), *HB = (bf16*)(ws + WS_H);
    float *WI = (float*)(ws + WS_WI), *RES = (float*)(ws + WS_RES), *Y0 = (float*)(ws + WS_Y0), *PW = (float*)(ws + WS_PW), *SCP = (float*)(ws + WS_SCP), *SCS = (float*)(ws + WS_SCS), *PART = (float*)(ws + WS_PART);
    int *IDX = (int*)(ws + WS_IDX), *CNT = (int*)(ws + WS_CNT);

    if (IN(0)) for (int rep_ = 0; rep_ < NREP(2); ++rep_) {
        transpose_job(C, w_in_a, DM, NINA, NINA_PAD, WINA); transpose_job(C, w_out_a, DM, DM, DM, WOUTA); transpose_job(C, w_in_b, DM, NINB, NINB, WINB); transpose_job(C, w_out_b, DM, DM, DM, WOUTB);
        for (int l = 0; l < 2; ++l) { transpose_job(C, w_up + (size_t)l * DM * DFF, DM, DFF, DFF, WUP + (size_t)l * DFF * DM); transpose_job(C, w_down + (size_t)l * DFF * DM, DFF, DM, DM, WDOWN + (size_t)l * DM * DFF);
            transpose_job(C, w_ple_gate + (size_t)l * DM * DM, DM, DM, DM, WG + (size_t)l * DM * DM); transpose_job(C, w_ple + (size_t)l * PLE * DM, PLE, DM, DM, WP + (size_t)l * DM * PLE); }
        cvt_job(C, x_prompt, XB, 1, MP * DM, 0, 0); cvt_job(C, x_sample, XB + (size_t)MP * DM, 1, MS * DM, 0, 0);
        for (int l = 0; l < 2; ++l) { cvt_job(C, p_prompt + (size_t)l * MP * PLE, PB + (size_t)l * MT * PLE, 1, MP * PLE, 0, 0); cvt_job(C, p_sample + (size_t)l * MS * PLE, PB + (size_t)l * MT * PLE + (size_t)MP * PLE, 1, MS * PLE, 0, 0); }
        cvt_job(C, cache_k_a, KAS, DECB, PAST * KVW, (size_t)PAST * KVW, (size_t)SALL * KVW); cvt_job(C, cache_v_a, VAS, DECB, PAST * KVW, (size_t)PAST * KVW, (size_t)SALL * KVW);
        cvt_job(C, cache_kidx_a, KIS, DECB, PAST * HD, (size_t)PAST * HD, (size_t)SALL * HD);
    }
    SEAM(0);
#define LAYER_BODY(l) do { \
        const int pb = (l == 0) ? 5 : 13; \
        if (l == 0) { \
            if (IN(1) && PH_ON(1)) { pg8::Gemm g{XB, WINA, MT, NINA_PAD, DM, DM}; pg8::StaticOrder S; S.init(MT, NINA_PAD, C.G, C.bx); \
                pg8::EpiInA E{QB, QIB, KAP, KIP, WI, out}; \
                pg8::gemm_phase<pg8::EpiInA, pg8::StaticOrder, true, true>(C.lds, g, S, E); if (NREP(0) > 1) { pg8::gemm_phase<pg8::EpiInA, pg8::StaticOrder, true, true>(C.lds, g, S, E); } } \
            SEAM(1); \
            if (IN(2) && PH_ON(2)) for (int rep_ = 0; rep_ < NREP2(1, 4); ++rep_) scores_phase(C, ctl + CW_QSC + 64 * rep_, QIB, KIP, KIS, WI, SCP, SCS); \
            SEAM(2); \
            if (IN(3) && PH_ON(3)) for (int rep_ = 0; rep_ < NREP2(1, 5); ++rep_) select_phase(C, SCP, SCS, IDX, CNT); \
            SEAM(3); \
            if (IN(4) && PH_ON(4)) for (int rep_ = 0; rep_ < NREP2(1, 6); ++rep_) sattn_phase(C, rel_bias, QB, KAP, VAP, KAS, VAS, IDX, CNT, OB); \
            SEAM(4); \
        } else { \
            if (IN(11) && PH_ON(11)) { pg8::Gemm g{XB, WINB, MT, NINB, DM, DM}; pg8::StaticOrder S; S.init(MT, NINB, C.G, C.bx); \
                pg8::EpiInB E{QB, out}; \
                pg8::gemm_phase<pg8::EpiInB, pg8::StaticOrder, true, true>(C.lds, g, S, E); if (NREP(0) > 1) { pg8::gemm_phase<pg8::EpiInB, pg8::StaticOrder, true, true>(C.lds, g, S, E); } } \
            SEAM(11); \
            if (IN(12) && PH_ON(12)) for (int rep_ = 0; rep_ < NREP(3); ++rep_) sbattn_phase(C, QB, out, cache_k_b, cache_v_b, OB); \
            SEAM(12); \
        } \
        if (IN(pb) && PH_ON(pb)) { \
            { pg8::Gemm g{OB, l == 0 ? WOUTA : WOUTB, MP, DM, DM, DM}; pg8::StaticOrder S; S.init(MP, DM, C.G, C.bx); pg8::EpiResid E{l == 0 ? x_prompt : Y0, RES}; \
              GEMM2X((pg8::gemm_phase<pg8::EpiResid, pg8::StaticOrder, true, true>(C.lds, g, S, E))); } \
            { int ksl = 256; asm volatile("" : "+s"(ksl)); pg8::Gemm g{OB, l == 0 ? WOUTA : WOUTB, MT, DM, ksl, DM}; pg8::SplitOrder S{C.G, C.bx}; pg8::EpiPart E{PART}; \
              GEMM2X((pg8::gemm_phase<pg8::EpiPart, pg8::SplitOrder, true, true>(C.lds, g, S, E))); } } \
        SEAM(pb); \
        if (IN(pb + 1) && PH_ON(pb + 1)) ln_phase(C, RES, X1B, ln1_g + l * DM, ln1_b + l * DM, l == 0 ? x_sample - (size_t)MP * DM : Y0, PART); \
        SEAM(pb + 1); \
        if (IN(pb + 2) && PH_ON(pb + 2)) { pg8::Gemm g{X1B, WUP + (size_t)l * DFF * DM, MT, DFF, DM, DM}; pg8::StaticOrder S; S.init(MT, DFF, C.G, C.bx); \
            pg8::EpiSqRelu E{HB}; \
            GEMM2X((pg8::gemm_phase<pg8::EpiSqRelu, pg8::StaticOrder, true, true>(C.lds, g, S, E))); } \
        SEAM(pb + 2); \
        if (IN(pb + 3) && PH_ON(pb + 3)) { \
            { pg8::Gemm g{HB, WDOWN + (size_t)l * DM * DFF, MP, DM, DFF, DFF}; pg8::StaticOrder S; S.init(MP, DM, C.G, C.bx); pg8::EpiResid E{RES, RES}; \
              if (NREP(0) > 1) { pg8::EpiResid E2{RES, PW}; pg8::gemm_phase<pg8::EpiResid, pg8::StaticOrder, true, true>(C.lds, g, S, E2); } \
              pg8::gemm_phase<pg8::EpiResid, pg8::StaticOrder, true, true>(C.lds, g, S, E); } \
            { int ksl = 1024; asm volatile("" : "+s"(ksl)); pg8::Gemm g{HB, WDOWN + (size_t)l * DM * DFF, MT, DM, ksl, DFF}; pg8::SplitOrder S{C.G, C.bx}; pg8::EpiPart E{PART}; \
              GEMM2X((pg8::gemm_phase<pg8::EpiPart, pg8::SplitOrder, true, true>(C.lds, g, S, E))); } } \
        SEAM(pb + 3); \
        if (IN(pb + 4) && PH_ON(pb + 4)) ln_phase(C, RES, X2B, ln2_g + l * DM, ln2_b + l * DM, RES, PART); \
        SEAM(pb + 4); \
        if (IN(pb + 5) && PH_ON(pb + 5)) { \
            if (MK_GATE_PART & 1) { int kple = PLE; asm volatile("" : "+s"(kple)); pg8::Gemm g{PB + (size_t)l * MT * PLE, WP + (size_t)l * DM * PLE, MT, DM, kple, PLE}; pg8::StaticOrder S; S.init(MT, DM, C.G, C.bx); \
              pg8::EpiStoreF32 E{PW}; \
              pg8::gemm_phase<pg8::EpiStoreF32, pg8::StaticOrder, true, true>(C.lds, g, S, E); if (NREP(0) > 1) { pg8::gemm_phase<pg8::EpiStoreF32, pg8::StaticOrder, true, true>(C.lds, g, S, E); } } \
            VM_WAIT(); __syncthreads(); \
            if (MK_GATE_PART & 2) { pg8::Gemm g{X2B, WG + (size_t)l * DM * DM, MT, DM, DM, DM}; pg8::StaticOrder S; S.init(MT, DM, C.G, C.bx); \
              pg8::EpiGate E{RES, PW, l == 0 ? Y0 : out + O_Y, l == 0 ? XB : (bf16*)nullptr}; \
              pg8::gemm_phase<pg8::EpiGate, pg8::StaticOrder, true, true>(C.lds, g, S, E); if (NREP(0) > 1) { pg8::gemm_phase<pg8::EpiGate, pg8::StaticOrder, true, true>(C.lds, g, S, E); } } \
        } \
        SEAM(pb + 5); \
    } while (0)
    LAYER_BODY(0);
    LAYER_BODY(1);
#undef LAYER_BODY
#undef IN
#undef SEAM
}

extern "C" void kernel_launch(void* const* d_in, const int* in_sizes, int n_in, void* d_out, int out_size, void* d_ws, size_t ws_size, hipStream_t stream) {
    static int grid = 0;
    if (grid == 0) {
        if (n_in != 22 || out_size != (int)O_END || ws_size < WS_END) { fprintf(stderr, "kernel_launch: unexpected shapes (n_in %d, out %d, ws %zu)\n", n_in, out_size, ws_size); grid = -1; return; }
        int dev = 0, cus = 0;
        if (hipGetDevice(&dev) != hipSuccess || hipDeviceGetAttribute(&cus, hipDeviceAttributeMultiprocessorCount, dev) != hipSuccess) { grid = -1; return; }
        if (hipFuncSetAttribute((const void*)mk_fwd, hipFuncAttributeMaxDynamicSharedMemorySize, LDS_BYTES) != hipSuccess) { fprintf(stderr, "kernel_launch: hipFuncSetAttribute failed\n"); grid = -1; return; }
        int per_cu = 0;
        if (hipOccupancyMaxActiveBlocksPerMultiprocessor(&per_cu, (const void*)mk_fwd, NTHREADS, LDS_BYTES) != hipSuccess || per_cu < 1) fprintf(stderr, "kernel_launch: occupancy query reports %d\n", per_cu);
        (void)hipGetLastError();
        grid = cus - (cus % 8);
        if (grid < 8) grid = 8;
    }
    if (grid < 0) return;
    if (hipMemsetAsync((char*)d_ws + WS_CTL, 0, CTL_ZERO_BYTES, stream) != hipSuccess) return;
    Args a{};
    for (int i = 0; i < 22; ++i) a.in[i] = (const float*)d_in[i];
    a.out = (float*)d_out; a.ws = (unsigned char*)d_ws;
#if MK_PER_PHASE
    for (int p = 0; p < NPH; ++p) { a.ph_lo = p; a.ph_hi = p + 1; hipLaunchKernelGGL(mk_fwd, dim3(grid), dim3(NTHREADS), LDS_BYTES, stream, a); }
#else
    a.ph_lo = 0; a.ph_hi = NPH;
    hipLaunchKernelGGL(mk_fwd, dim3(grid), dim3(NTHREADS), LDS_BYTES, stream, a);
#endif
}
```

```cpp
#include <hip/hip_runtime.h>
#include <cstdio>
#include <cstdint>
#ifndef MK_PER_PHASE
#define MK_PER_PHASE 0
#endif
#ifndef MK_PH_MASK
#define MK_PH_MASK 0xffffffffu
#endif
constexpr int NWAVES = 8, NTHREADS = 512;
constexpr int DM = 2048, SEQ = 8192, MP = 16384, DECB = 16, DECS = 64, MS = 1024, MT = 17408, PAST = 4096, SALL = 4160;
constexpr int NINA = 5264, NINA_PAD = 5376, NINB = 6144, DFF = 8192, PLE = 256, HD = 128, KVW = 512, TOPK = 256;
constexpr float LN_EPS = 1e-5f, ALPHA = 1.41421356237309515f;
constexpr float QK_SCALE = 0.08838834764831845f;
constexpr float WI_SCALE = 0.25f * 0.08838834764831845f;
constexpr int NPH = 19;

constexpr size_t O_Y = 0;
constexpr size_t O_KAP = (size_t)MT * DM, O_VAP = O_KAP + (size_t)MP * KVW, O_KIP = O_VAP + (size_t)MP * KVW;
constexpr size_t O_KBP = O_KIP + (size_t)MP * HD, O_VBP = O_KBP + (size_t)MP * DM;
constexpr size_t O_KAS = O_VBP + (size_t)MP * DM, O_VAS = O_KAS + (size_t)MS * KVW, O_KIS = O_VAS + (size_t)MS * KVW;
constexpr size_t O_KBS = O_KIS + (size_t)MS * HD, O_VBS = O_KBS + (size_t)MS * DM, O_END = O_VBS + (size_t)MS * DM;
static_assert(O_END == 127008768, "d_out layout");

constexpr size_t MiB = 1u << 20;
constexpr size_t WS_CTL = 0, CTL_ZERO_BYTES = 1 * MiB;
constexpr size_t WS_WINA = 2 * MiB, WS_WOUTA = 23 * MiB, WS_WINB = 31 * MiB, WS_WOUTB = 55 * MiB, WS_WUP = 63 * MiB, WS_WDOWN = 127 * MiB, WS_WG = 191 * MiB, WS_WP = 207 * MiB;
constexpr size_t WS_PB = 210 * MiB, WS_XB = 228 * MiB, WS_X1B = 296 * MiB, WS_X2B = 364 * MiB, WS_QB = 432 * MiB, WS_OB = 500 * MiB, WS_QIB = 568 * MiB;
constexpr size_t WS_KAP = 636 * MiB, WS_VAP = 652 * MiB, WS_KAS = 668 * MiB, WS_VAS = 733 * MiB, WS_KIP = 798 * MiB, WS_KIS = 802 * MiB, WS_WI = 819 * MiB;
constexpr size_t WS_IDX = 821 * MiB, WS_CNT = 838 * MiB, WS_RES = 840 * MiB, WS_Y0 = 976 * MiB, WS_PW = 1112 * MiB, WS_H = 1248 * MiB;
constexpr size_t WS_SCP = 1248 * MiB  , WS_SCS = 1760 * MiB, WS_PART = 1778 * MiB  , WS_END = 1842 * MiB;
static_assert(WS_WINA + (size_t)NINA_PAD * DM * 2 <= WS_WOUTA && WS_PB + (size_t)2 * MT * PLE * 2 <= WS_XB && WS_XB + (size_t)MT * DM * 2 <= WS_X1B && WS_KAS + (size_t)DECB * SALL * KVW * 2 <= WS_VAS
              && WS_KIS + (size_t)DECB * SALL * HD * 2 <= WS_WI && WS_WI + (size_t)MT * 16 * 4 <= WS_IDX && WS_IDX + (size_t)MT * TOPK * 4 <= WS_CNT && WS_RES + (size_t)MT * DM * 4 <= WS_Y0
              && WS_H + (size_t)MT * DFF * 2 <= WS_SCS && WS_SCP + (size_t)MP * SEQ * 4 <= WS_SCS && WS_SCS + (size_t)MS * SALL * 4 <= WS_PART && WS_PART + (size_t)8 * MS * DM * 4 <= WS_END, "d_ws map");
constexpr size_t WS_KBB = WS_QIB, WS_VBB = WS_KAP;
static_assert(WS_VBB + (size_t)MT * DM * 2 <= WS_KIP, "VBB overlay");
constexpr size_t D_VBB = (WS_VBB - WS_KBB) / 2;
constexpr size_t D_VAP = (WS_VAP - WS_KAP) / 2, D_KAS = (WS_KAS - WS_KAP) / 2, D_VAS = (WS_VAS - WS_KAP) / 2, D_KIS = (WS_KIS - WS_KIP) / 2;
constexpr int CW_BAR = 4096;
constexpr int CW_QSB = 8448;
constexpr int CW_QSC = 8192;

constexpr int RING_BYTES = 135168;
constexpr int LDSCTL_OFF = RING_BYTES, MISC_OFF = LDSCTL_OFF + 320;
constexpr int LDS_BYTES = 147456;
static_assert(MISC_OFF + 128 <= LDS_BYTES, "LDS map");

#define GAS __attribute__((address_space(1)))
#define LAS __attribute__((address_space(3)))
typedef unsigned short bf16;
typedef unsigned v4u __attribute__((ext_vector_type(4)));
typedef unsigned v2u __attribute__((ext_vector_type(2)));
typedef float f32x4 __attribute__((ext_vector_type(4)));
typedef float f32x2 __attribute__((ext_vector_type(2)));
typedef float f32x16 __attribute__((ext_vector_type(16)));
typedef short bf16x8 __attribute__((ext_vector_type(8)));
typedef __bf16 bf16x2_t __attribute__((ext_vector_type(2)));
#define LDS_WAIT() asm volatile("s_waitcnt lgkmcnt(0)" ::: "memory")
#define VM_WAIT() asm volatile("s_waitcnt vmcnt(0)" ::: "memory")
__device__ __forceinline__ unsigned pk2(float lo, float hi) { f32x2 v = {lo, hi}; bf16x2_t b = __builtin_convertvector(v, bf16x2_t); return __builtin_bit_cast(unsigned, b); }
__device__ __forceinline__ float bf_lo(unsigned w) { return __uint_as_float(w << 16); }
__device__ __forceinline__ float bf_hi(unsigned w) { return __uint_as_float(w & 0xffff0000u); }
__device__ __forceinline__ float dot2bf(unsigned a, unsigned b, float c) { return __builtin_amdgcn_fdot2_f32_bf16(__builtin_bit_cast(bf16x2_t, a), __builtin_bit_cast(bf16x2_t, b), c, false); }
namespace pg8 {
#define PG8_LAS __attribute__((address_space(3)))
typedef unsigned short bf16_t;
typedef short bf16x8 __attribute__((ext_vector_type(8)));
typedef float f32x4 __attribute__((ext_vector_type(4)));
typedef unsigned u32x4 __attribute__((ext_vector_type(4)));
constexpr int BM = 256, BK = 64, HALF = 128, HTB = HALF * BK * 2  , STAGE_BYTES = 8 * HTB, NXCD = 8, WGM = 8;

__host__ __device__ __forceinline__ int lds_byte(int r, int c) { const int st = (r >> 4) * 2 + (c >> 5), rr = r & 15, cc = c & 31, ob = rr * 64 + cc * 2; return st * 1024 + (ob ^ (((ob >> 9) & 1) << 5)); }
__host__ __device__ __forceinline__ void stage_rc(int b, int& R, int& C) { const int st = b / 1024, sb = b % 1024, swz = sb ^ (((sb >> 9) & 1) << 5); R = (st >> 1) * 16 + swz / 64; C = (st & 1) * 32 + (swz % 64) / 2; }
__host__ __device__ __forceinline__ int perm32(int rho) { const int n = rho >> 4, i = rho & 15; return 8 * (i >> 2) + 4 * n + (i & 3); }

struct Unit { int pm, pn, ks; };
struct Gemm { const bf16_t* A; const bf16_t* Bt; int M, N, K, ld; };

struct StaticOrder {
    int nM, nN, nwg, G, c;
    __host__ __device__ void init(int M, int N, int G_, int c_) { nM = M / BM; nN = N / BM; nwg = nM * nN; G = G_; c = c_; }
    __host__ __device__ bool next(int i, Unit& u) const {
        const long L = (long)i * G + c; if (L >= nwg) return false;
        int wgid = (int)L; { const int q = nwg / NXCD, r = nwg % NXCD, xcd = wgid % NXCD, off = wgid / NXCD; wgid = (xcd < r ? xcd * (q + 1) : r * (q + 1) + (xcd - r) * q) + off; }
        const int nig = WGM * nN, gid = wgid / nig, fm = gid * WGM, gsz = (nM - fm) < WGM ? (nM - fm) : WGM;
        u.pm = fm + ((wgid % nig) % gsz); u.pn = (wgid % nig) / gsz; u.ks = 0; return true;
    }
    __device__ __forceinline__ void a_ready(const Unit&) const {}
    __device__ __forceinline__ void done(const Unit&) const {}
};

__device__ __forceinline__ unsigned cvt_pk_bf16(float lo, float hi) { unsigned r; asm volatile("v_cvt_pk_bf16_f32 %0, %1, %2" : "=v"(r) : "v"(lo), "v"(hi)); return r; }
typedef float f32x2 __attribute__((ext_vector_type(2)));
__device__ __forceinline__ void st_bf16x8(bf16_t* p, const f32x4& a, const f32x4& b) { u32x4 w; w.x = ::pk2(a[0], a[1]); w.y = ::pk2(a[2], a[3]); w.z = ::pk2(b[0], b[1]); w.w = ::pk2(b[2], b[3]); *(u32x4*)p = w; }
__device__ __forceinline__ void st_f32x8(float* p, const f32x4& a, const f32x4& b) { *(f32x4*)p = a; *(f32x4*)(p + 4) = b; }
#define PG8_EPI_LOOP(...) \
    _Pragma("unroll") for (int ai = 0; ai < 2; ++ai) _Pragma("unroll") for (int m = 0; m < 4; ++m) { const int row = u.pm * BM + ai * HALF + wr * 64 + m * 16 + fr; \
        _Pragma("unroll") for (int bj = 0; bj < 2; ++bj) { const int cl = bj * HALF + wc * 32 + 8 * fq; const f32x4 v0 = acc[ai][bj][m][0], v1 = acc[ai][bj][m][1]; __VA_ARGS__ } }
#define PG8_EPI_LOOP_F(...) \
    _Pragma("unroll") for (int ai = 0; ai < 2; ++ai) _Pragma("unroll") for (int m = 0; m < 4; ++m) { const int row = u.pm * BM + ai * HALF + wr * 64 + m * 16 + fr; \
        _Pragma("unroll") for (int bj = 0; bj < 2; ++bj) { const int cl = bj * HALF + wc * 32 + 8 * fq; const f32x4 v0 = acc[ai][bj][m][0], v1 = acc[ai][bj][m][1]; __VA_ARGS__ } asm volatile("" ::: "memory"); }

struct EpiInA {
    static constexpr bool PERM = true, AFTER_DRAIN = false;
    bf16_t *Q, *QI, *KAP, *KIP; float* WI; float* out;
    __device__ __forceinline__ void operator()(const f32x4 (&acc)[2][2][4][2], const Unit& u, int wr, int wc, int fr, int fq) const {
        const int pn = u.pn; const bool samp = u.pm >= 64;
        float* fb = nullptr; bf16_t* bb; int ld; bool remap = false;
        if (pn < 8) { bb = Q + pn * BM; ld = ::DM; }
        else if (pn < 12) { const bool isv = pn >= 10; const int c0 = (pn & 1) * BM; ld = ::KVW; remap = samp;
            fb = out + (samp ? (isv ? ::O_VAS : ::O_KAS) - (size_t)::MP * ::KVW : (isv ? ::O_VAP : ::O_KAP)) + c0;
            bb = KAP + (samp ? (isv ? ::D_VAS : ::D_KAS) : (isv ? ::D_VAP : (size_t)0)) + c0; }
        else if (pn < 20) { bb = QI + (pn - 12) * BM; ld = ::DM; }
        else { ld = ::HD; remap = samp; fb = out + (samp ? ::O_KIS - (size_t)::MP * ::HD : ::O_KIP); bb = KIP + (samp ? ::D_KIS : (size_t)0); }
        PG8_EPI_LOOP(
            const int rs = row - ::MP; const size_t brow = remap ? ((size_t)(rs >> 6) * ::SALL + ::PAST + (rs & 63)) : (size_t)row;
            if (pn == 20 && cl >= 128) { if (cl < 144) st_f32x8(WI + (size_t)row * 16 + (cl - 128), v0 * ::WI_SCALE, v1 * ::WI_SCALE); }
            else { if (fb) st_f32x8(fb + (size_t)row * ld + cl, v0, v1); st_bf16x8(bb + brow * ld + cl, v0, v1); }
        )
    }
};
struct EpiInB {
    static constexpr bool PERM = true, AFTER_DRAIN = false;
    bf16_t* Q; bf16_t* KBB; float* out;
    __device__ __forceinline__ void operator()(const f32x4 (&acc)[2][2][4][2], const Unit& u, int wr, int wc, int fr, int fq) const {
        const int pn = u.pn; const bool samp = u.pm >= 64; const bool isv = pn >= 16;
        float* fb = nullptr; bf16_t* bb;
        if (pn < 8) bb = Q + pn * BM;
        else { const int c0 = (pn & 7) * BM; bb = KBB + (isv ? ::D_VBB : (size_t)0) + c0; fb = out + (samp ? (isv ? ::O_VBS : ::O_KBS) - (size_t)::MP * ::DM : (isv ? ::O_VBP : ::O_KBP)) + c0; }
        PG8_EPI_LOOP(
            if (fb) st_f32x8(fb + (size_t)row * ::DM + cl, v0, v1);
            st_bf16x8(bb + (size_t)row * ::DM + cl, v0, v1);
        )
    }
};
struct EpiResid {
    static constexpr bool PERM = true, AFTER_DRAIN = false;
    const float* x; float* RES;
    __device__ __forceinline__ void operator()(const f32x4 (&acc)[2][2][4][2], const Unit& u, int wr, int wc, int fr, int fq) const {
        const int pn = u.pn;
        PG8_EPI_LOOP_F(
            const size_t off = (size_t)row * ::DM + pn * BM + cl; const f32x4 x0 = *(const f32x4*)(x + off), x1 = *(const f32x4*)(x + off + 4);
            st_f32x8(RES + off, x0 * ::ALPHA + v0, x1 * ::ALPHA + v1);
        )
    }
};
struct EpiPart {
    static constexpr bool PERM = true, AFTER_DRAIN = false;
    float* PART;
    __device__ __forceinline__ void operator()(const f32x4 (&acc)[2][2][4][2], const Unit& u, int wr, int wc, int fr, int fq) const {
        const int pn = u.pn; float* base = PART + (size_t)u.ks * ::MS * ::DM;
        PG8_EPI_LOOP( st_f32x8(base + (size_t)(row - ::MP) * ::DM + pn * BM + cl, v0, v1); )
    }
};
struct SplitOrder {
    int G, c;
    __device__ __forceinline__ bool next(int i, Unit& u) const { const int L = i * G + c; if (L >= 256) return false; u.pm = 64 + (L & 3); u.pn = (L >> 2) & 7; u.ks = L >> 5; return true; }
    __device__ __forceinline__ void a_ready(const Unit&) const {}
    __device__ __forceinline__ void done(const Unit&) const {}
};
struct EpiSqRelu {
    static constexpr bool PERM = true, AFTER_DRAIN = false;
    bf16_t* H;
    __device__ __forceinline__ void operator()(const f32x4 (&acc)[2][2][4][2], const Unit& u, int wr, int wc, int fr, int fq) const {
        const int pn = u.pn;
        PG8_EPI_LOOP(
            f32x4 a = __builtin_elementwise_max(v0, (f32x4){0.f, 0.f, 0.f, 0.f}), b = __builtin_elementwise_max(v1, (f32x4){0.f, 0.f, 0.f, 0.f});
            st_bf16x8(H + (size_t)row * ::DFF + pn * BM + cl, a * a, b * b);
        )
    }
};
struct EpiStoreF32 {
    static constexpr bool PERM = true, AFTER_DRAIN = false;
    float* C;
    __device__ __forceinline__ void operator()(const f32x4 (&acc)[2][2][4][2], const Unit& u, int wr, int wc, int fr, int fq) const {
        const int pn = u.pn;
        PG8_EPI_LOOP( st_f32x8(C + (size_t)row * ::DM + pn * BM + cl, v0, v1); )
    }
};
struct EpiGate {
    static constexpr bool PERM = true, AFTER_DRAIN = false;
    const float* X2; const float* PW; float* Y; bf16_t* YB;
    __device__ __forceinline__ f32x4 sig(const f32x4& v) const { f32x4 r;
#pragma unroll
        for (int i = 0; i < 4; ++i) r[i] = __builtin_amdgcn_rcpf(1.0f + __expf(-v[i])); return r; }
    __device__ __forceinline__ void operator()(const f32x4 (&acc)[2][2][4][2], const Unit& u, int wr, int wc, int fr, int fq) const {
        const int pn = u.pn;
        PG8_EPI_LOOP_F(
            const size_t off = (size_t)row * ::DM + pn * BM + cl;
            const f32x4 y0 = *(const f32x4*)(X2 + off) + sig(v0) * *(const f32x4*)(PW + off), y1 = *(const f32x4*)(X2 + off + 4) + sig(v1) * *(const f32x4*)(PW + off + 4);
            st_f32x8(Y + off, y0, y1); if (YB) st_bf16x8(YB + off, y0, y1);
        )
    }
};
template <class Epi, class Sched, bool ALIGN_EPI = false, bool SP2 = false>
__device__ __forceinline__ void gemm_phase(PG8_LAS unsigned char* lds, const Gemm g, const Sched& S, const Epi& E) {
    const int tid = threadIdx.x, wid = __builtin_amdgcn_readfirstlane(tid >> 6), lane = tid & 63, wr = wid >> 2, wc = wid & 3, fr = lane & 15, fq = lane >> 4;
    const int K = g.ld, nt = g.K / BK;
    const size_t kslice = (size_t)g.K * 2;
    unsigned voffA[2], voffB[2];
#pragma unroll
    for (int i = 0; i < 2; ++i) { int R, C; stage_rc(tid * 16 + i * 8192, R, C); const int Rb = Epi::PERM ? ((R & ~31) + perm32(R & 31)) : R;
        voffA[i] = (unsigned)(R * K + C) * 2u; voffB[i] = (unsigned)(Rb * K + C) * 2u; }
    const size_t kstep = (size_t)(BK * 2);
    const size_t hstep = (size_t)HALF * K * 2;
    const size_t tstep = 2 * hstep;
    const unsigned ldsw = (unsigned)wid * 1024u;
    const int aoff = lds_byte(wr * 64 + fr, fq * 8), boff = lds_byte(wc * 32 + fr, fq * 8);
#define PG8_SA(b, h) (((b) * 2 + (h)) * HTB)
#define PG8_SB(b, h) ((4 + (b) * 2 + (h)) * HTB)
#define PG8_STAGE(bufoff, gbase, voff) do { _Pragma("unroll") for (int _i = 0; _i < 2; ++_i) \
        __builtin_amdgcn_global_load_lds((const unsigned*)((const char*)(gbase) + (voff)[_i]), (PG8_LAS unsigned*)(lds + (bufoff) + ldsw + _i * 8192), 16, 0, 0); } while (0)
#define PG8_LDA(dst, b, h) do { _Pragma("unroll") for (int m = 0; m < 4; ++m) _Pragma("unroll") for (int k = 0; k < 2; ++k) dst[m][k] = *(const PG8_LAS bf16x8*)(lds + PG8_SA(b, h) + aoff + m * 2048 + k * 1024); } while (0)
#define PG8_LDB(dst, b, h) do { _Pragma("unroll") for (int n = 0; n < 2; ++n) _Pragma("unroll") for (int k = 0; k < 2; ++k) dst[n][k] = *(const PG8_LAS bf16x8*)(lds + PG8_SB(b, h) + boff + n * 2048 + k * 1024); } while (0)
#define PG8_MMA(ai, bj, At, Bt) do { __builtin_amdgcn_s_setprio(1); _Pragma("unroll") for (int m = 0; m < 4; ++m) _Pragma("unroll") for (int n = 0; n < 2; ++n) _Pragma("unroll") for (int k = 0; k < 2; ++k) \
        acc[ai][bj][m][n] = __builtin_amdgcn_mfma_f32_16x16x32_bf16(Bt[n][k], At[m][k], acc[ai][bj][m][n], 0, 0, 0); __builtin_amdgcn_s_setprio(0); } while (0)
#define PG8_WAIT_V(n) asm volatile("s_waitcnt vmcnt(" #n ")" ::: "memory")
#define PG8_WAIT_L(n) asm volatile("s_waitcnt lgkmcnt(" #n ")" ::: "memory")
#define PG8_BAR __builtin_amdgcn_s_barrier()
#define PG8_SCHED __builtin_amdgcn_sched_barrier(0)
    Unit cur, nxt; int ui = 0;
    if (!S.next(0, cur)) return;
    f32x4 acc[2][2][4][2];
#pragma unroll
    for (int a = 0; a < 2; ++a)
#pragma unroll
        for (int b = 0; b < 2; ++b)
#pragma unroll
            for (int m = 0; m < 4; ++m)
#pragma unroll
                for (int n = 0; n < 2; ++n) acc[a][b][m][n] = (f32x4){0.f, 0.f, 0.f, 0.f};
    bf16x8 At[4][2], B0[2][2], B1[2][2];
    const char* cA = (const char*)g.A + (size_t)cur.pm * tstep + cur.ks * kslice; const char* cB = (const char*)g.Bt + (size_t)cur.pn * tstep + cur.ks * kslice;
    S.a_ready(cur);
    if constexpr (SP2) {
        PG8_STAGE(PG8_SB(0, 0), cB, voffB); PG8_STAGE(PG8_SB(0, 1), cB + hstep, voffB); PG8_STAGE(PG8_SA(0, 0), cA, voffA); PG8_STAGE(PG8_SA(0, 1), cA + hstep, voffA);
        if (wr == 1) PG8_BAR;
        PG8_WAIT_V(2); PG8_BAR;
        PG8_STAGE(PG8_SB(1, 0), cB + kstep, voffB); PG8_STAGE(PG8_SA(1, 0), cA + kstep, voffA); PG8_STAGE(PG8_SB(1, 1), cB + hstep + kstep, voffB);
        PG8_WAIT_V(6); PG8_BAR;
    } else {
        PG8_STAGE(PG8_SB(0, 0), cB, voffB); PG8_STAGE(PG8_SA(0, 0), cA, voffA); PG8_STAGE(PG8_SB(0, 1), cB + hstep, voffB); PG8_STAGE(PG8_SA(0, 1), cA + hstep, voffA);
        if (wr == 1) PG8_BAR;
        PG8_WAIT_V(4); PG8_BAR;
        PG8_STAGE(PG8_SB(1, 0), cB + kstep, voffB); PG8_STAGE(PG8_SA(1, 0), cA + kstep, voffA); PG8_STAGE(PG8_SB(1, 1), cB + hstep + kstep, voffB);
        PG8_WAIT_V(6); PG8_BAR;
    }
    for (;;) {
        const bool has_next = S.next(ui + 1, nxt);
        const char* nA = has_next ? (const char*)g.A + (size_t)nxt.pm * tstep + nxt.ks * kslice : cA; const char* nB = has_next ? (const char*)g.Bt + (size_t)nxt.pn * tstep + nxt.ks * kslice : cB;
        for (int t = 0; t < nt; t += 2) {
            const bool last = (t == nt - 2);
            const char* a1 = cA + (size_t)(t + 1) * kstep;
            const char* a2 = last ? nA : cA + (size_t)(t + 2) * kstep; const char* b2 = last ? nB : cB + (size_t)(t + 2) * kstep;
            const char* a3 = a2 + kstep; const char* b3 = b2 + kstep;
            if (last && has_next) S.a_ready(nxt);
            if constexpr (SP2) {
            PG8_LDB(B0, 0, 0); PG8_LDB(B1, 0, 1); PG8_SCHED; PG8_LDA(At, 0, 0); PG8_STAGE(PG8_SA(1, 1), a1 + hstep, voffA);
            PG8_WAIT_V(8); PG8_WAIT_L(0); PG8_BAR; PG8_MMA(0, 0, At, B0); PG8_MMA(0, 1, At, B1); PG8_BAR; PG8_SCHED;
            PG8_LDA(At, 0, 1); PG8_STAGE(PG8_SB(0, 0), b2, voffB); PG8_STAGE(PG8_SB(0, 1), b2 + hstep, voffB); PG8_STAGE(PG8_SA(0, 0), a2, voffA);
            PG8_WAIT_V(8); PG8_WAIT_L(0); PG8_BAR; PG8_MMA(1, 0, At, B0); PG8_MMA(1, 1, At, B1); PG8_BAR; PG8_SCHED;
            PG8_LDB(B0, 1, 0); PG8_LDB(B1, 1, 1); PG8_SCHED; PG8_LDA(At, 1, 0); PG8_STAGE(PG8_SA(0, 1), a2 + hstep, voffA);
            PG8_WAIT_V(8); PG8_WAIT_L(0); PG8_BAR; PG8_MMA(0, 0, At, B0); PG8_MMA(0, 1, At, B1); PG8_BAR; PG8_SCHED;
            PG8_LDA(At, 1, 1); PG8_STAGE(PG8_SB(1, 0), b3, voffB); PG8_STAGE(PG8_SB(1, 1), b3 + hstep, voffB); PG8_STAGE(PG8_SA(1, 0), a3, voffA);
            PG8_WAIT_V(8); PG8_WAIT_L(0); PG8_BAR; PG8_MMA(1, 0, At, B0); PG8_MMA(1, 1, At, B1); PG8_BAR; PG8_SCHED;
            } else {
            PG8_LDB(B0, 0, 0); PG8_SCHED; PG8_LDA(At, 0, 0); PG8_STAGE(PG8_SA(1, 1), a1 + hstep, voffA);
            PG8_WAIT_L(8); PG8_BAR; PG8_WAIT_L(0); PG8_MMA(0, 0, At, B0); PG8_BAR; PG8_SCHED;
            PG8_LDB(B1, 0, 1); PG8_STAGE(PG8_SB(0, 0), b2, voffB);
            PG8_BAR; PG8_WAIT_L(0); PG8_MMA(0, 1, At, B1); PG8_BAR;
            PG8_LDA(At, 0, 1); PG8_STAGE(PG8_SA(0, 0), a2, voffA);
            PG8_BAR; PG8_WAIT_L(0); PG8_MMA(1, 0, At, B0); PG8_BAR; PG8_SCHED;
            PG8_STAGE(PG8_SB(0, 1), b2 + hstep, voffB);
            PG8_WAIT_V(6); PG8_BAR; PG8_MMA(1, 1, At, B1); PG8_BAR;
            PG8_LDB(B0, 1, 0); PG8_SCHED; PG8_LDA(At, 1, 0); PG8_STAGE(PG8_SA(0, 1), a2 + hstep, voffA);
            PG8_WAIT_L(8); PG8_BAR; PG8_WAIT_L(0); PG8_MMA(0, 0, At, B0); PG8_BAR; PG8_SCHED;
            PG8_LDB(B1, 1, 1); PG8_STAGE(PG8_SB(1, 0), b3, voffB);
            PG8_BAR; PG8_WAIT_L(0); PG8_MMA(0, 1, At, B1); PG8_BAR;
            PG8_LDA(At, 1, 1); PG8_STAGE(PG8_SA(1, 0), a3, voffA);
            PG8_BAR; PG8_WAIT_L(0); PG8_MMA(1, 0, At, B0); PG8_BAR; PG8_SCHED;
            PG8_STAGE(PG8_SB(1, 1), b3 + hstep, voffB);
            PG8_WAIT_V(6); PG8_BAR; PG8_MMA(1, 1, At, B1); PG8_BAR;
            }
        }
        if constexpr (ALIGN_EPI) { if (wr == 0) PG8_BAR; }
        if constexpr (!Epi::AFTER_DRAIN) { E(acc, cur, wr, wc, fr, fq); S.done(cur); }
        if (!has_next) break;
#pragma unroll
        for (int a = 0; a < 2; ++a)
#pragma unroll
            for (int b = 0; b < 2; ++b)
#pragma unroll
                for (int m = 0; m < 4; ++m)
#pragma unroll
                    for (int n = 0; n < 2; ++n) acc[a][b][m][n] = (f32x4){0.f, 0.f, 0.f, 0.f};
        cur = nxt; cA = nA; cB = nB; ++ui;
        if constexpr (ALIGN_EPI) { if (wr == 1) PG8_BAR; }
    }
    PG8_WAIT_V(0);
    if constexpr (!ALIGN_EPI) { if (wr == 0) PG8_BAR; }
    PG8_BAR;
    if constexpr (Epi::AFTER_DRAIN) { E.fused(acc, cur, wr, wc, fr, fq, lds, wid, lane); S.done(cur); }
#undef PG8_SA
#undef PG8_SB
#undef PG8_STAGE
#undef PG8_LDA
#undef PG8_LDB
#undef PG8_MMA
#undef PG8_WAIT_V
#undef PG8_WAIT_L
#undef PG8_BAR
#undef PG8_SCHED
}
}
#define XB_TMO      128
#define XB_XCNT(j)  (256  + 64 * (j))
#define XB_XSUB(j)  (1280 + 64 * (j))
#define XB_XGEN(j)  (2304 + 64 * (j))
#define XB_TOP      3328
#define XB_TOPGEN   3392
#define XCD_BAR_WORDS 3456
#define XB_SPIN_CAP (1u << 18)

__device__ __forceinline__ unsigned xb_ld(unsigned* p)              { return __hip_atomic_load(p, __ATOMIC_RELAXED, __HIP_MEMORY_SCOPE_AGENT); }
__device__ __forceinline__ unsigned xb_add(unsigned* p, unsigned v) { return __hip_atomic_fetch_add(p, v, __ATOMIC_RELAXED, __HIP_MEMORY_SCOPE_AGENT); }
__device__ __forceinline__ unsigned xb_xcc_id() { return (unsigned)__builtin_amdgcn_s_getreg((3 << 11) | 20) & 0xFu; }
#define XB_SPIN(cond, bar) do { unsigned _sp = 0; while (cond) { __builtin_amdgcn_s_sleep(1); \
    if ((++_sp & 255u) == 0u) { if (xb_ld(&(bar)[XB_TMO])) break; if (_sp > XB_SPIN_CAP) { atomicAdd(&(bar)[XB_TMO], 1u); break; } } } } while (0)

struct XcdBarrier {
    unsigned* bar; unsigned x;
    volatile LAS unsigned* st;
};

__device__ __forceinline__ XcdBarrier xcd_barrier_post(unsigned* bar, volatile LAS unsigned* st) {
    XcdBarrier b; b.bar = bar; b.x = xb_xcc_id(); b.st = st;
    if (threadIdx.x == 0) (void)xb_add(&bar[XB_XCNT(b.x)], 1u);
    return b;
}
__device__ __forceinline__ void xcd_barrier_complete(unsigned* bar, unsigned x, unsigned& nloc, unsigned& nx) {
    const unsigned G = gridDim.x * gridDim.y * gridDim.z;
    unsigned sum, cnt, mine, sp = 0u;
    for (;;) {
        sum = 0u; cnt = 0u; mine = 0u;
#pragma unroll
        for (unsigned j = 0; j < 16; ++j) { const unsigned c = xb_ld(&bar[XB_XCNT(j)]); sum += c; cnt += (c > 0u) ? 1u : 0u; mine = (j == x) ? c : mine; }
        if (sum == G) break;
        __builtin_amdgcn_s_sleep(1);
        if ((++sp & 255u) == 0u) { if (xb_ld(&bar[XB_TMO])) break; if (sp > XB_SPIN_CAP) { atomicAdd(&bar[XB_TMO], 1u); break; } }
    }
    nloc = mine > 0u ? mine : 1u; nx = cnt > 0u ? cnt : 1u;
}

__device__ __forceinline__ void xcd_barrier(const XcdBarrier& b) {
    asm volatile("s_waitcnt vmcnt(0)" ::: "memory");
    __syncthreads();
    if (threadIdx.x == 0) {
        unsigned* bar = b.bar;
        __builtin_amdgcn_s_waitcnt(0);
        unsigned nloc = b.st[0], nx = b.st[1];
        if (nloc == 0u) { xcd_barrier_complete(bar, b.x, nloc, nx); b.st[0] = nloc; b.st[1] = nx; }
        const unsigned old = xb_add(&bar[XB_XSUB(b.x)], 1u);
        const unsigned gen = old / nloc;
        if (old + 1u == (gen + 1u) * nloc) {
            __builtin_amdgcn_fence(__ATOMIC_RELEASE, "agent");
            asm volatile("s_waitcnt vmcnt(0)" ::: "memory");
            const unsigned og = xb_add(&bar[XB_TOP], 1u);
            const unsigned tg = og / nx;
            if (og + 1u == (tg + 1u) * nx) xb_add(&bar[XB_TOPGEN], 1u);
            else XB_SPIN(xb_ld(&bar[XB_TOPGEN]) == tg, bar);
            __builtin_amdgcn_fence(__ATOMIC_ACQUIRE, "agent");
            xb_add(&bar[XB_XGEN(b.x)], 1u);
            asm volatile("s_waitcnt vmcnt(0)" ::: "memory");
        } else {
            XB_SPIN(xb_ld(&bar[XB_XGEN(b.x)]) == gen, bar);
            __builtin_amdgcn_fence(__ATOMIC_ACQUIRE, "agent");
            asm volatile("s_waitcnt vmcnt(0)" ::: "memory");
        }
    }
    __syncthreads();
}
#ifndef MK_PROBE
#define MK_PROBE 0
#endif
#define NREP(bit) (((MK_PROBE >> (bit)) & 1) ? 2 : 1)
#define GEMM2X(call) do { call; if (NREP(0) > 1) { call; } } while (0)
#define NREP2(b1, b2) ((((MK_PROBE >> (b1)) | (MK_PROBE >> (b2))) & 1) ? 2 : 1)
#ifndef MK_GATE_PART
#define MK_GATE_PART 3
#endif
typedef GAS unsigned gu32;
#define RLX_AGENT __ATOMIC_RELAXED, __HIP_MEMORY_SCOPE_AGENT
#define MFMA32(a, b, c) __builtin_amdgcn_mfma_f32_32x32x16_bf16((a), (b), (c), 0, 0, 0)

struct Ctx { LAS unsigned char* lds; volatile LAS unsigned* MISC; int tid, lane, wave, G, bx, gw, NGW; };
__device__ __forceinline__ int crow(int r, int hi) { return (r & 3) + 8 * (r >> 2) + 4 * hi; }

__device__ __forceinline__ void p0_transpose_item(const float* W, int K, int N, int NP, bf16* WT, LAS float* scr, int item, int lane) {
    const int nblk = NP / 32, kb = item / nblk, nb = item % nblk, k0 = 64 * kb, n0 = 32 * nb;
    const int nn = n0 + (lane & 31);
#pragma unroll 8
    for (int i = 0; i < 32; ++i) { const int kk = 2 * i + (lane >> 5); scr[kk * 33 + (lane & 31)] = (nn < N) ? W[(size_t)(k0 + kk) * N + nn] : 0.f; }
    LDS_WAIT();
    const int c = lane & 7;
#pragma unroll
    for (int j = 0; j < 4; ++j) { const int n = (lane >> 3) + 8 * j; const LAS float* s = scr + (8 * c) * 33 + n;
        v4u o; o.x = pk2(s[0 * 33], s[1 * 33]); o.y = pk2(s[2 * 33], s[3 * 33]); o.z = pk2(s[4 * 33], s[5 * 33]); o.w = pk2(s[6 * 33], s[7 * 33]);
        *(v4u*)(WT + (size_t)(n0 + n) * K + k0 + 8 * c) = o; }
    LDS_WAIT();
}
__device__ __forceinline__ void transpose_job(const Ctx& C, const float* W, int K, int N, int NP, bf16* WT) {
    LAS float* scr = (LAS float*)(C.lds + C.wave * 16384);
    const int nitems = (K / 64) * (NP / 32);
    for (int it = C.gw; it < nitems; it += C.NGW) p0_transpose_item(W, K, N, NP, WT, scr, it, C.lane);
}
__device__ __forceinline__ void cvt_job(const Ctx& C, const float* src, bf16* dst, int nseg, int seglen, size_t sstride, size_t dstride) {
    const int vps = seglen / 8; const long total = (long)nseg * vps; const long NGT = (long)C.G * NTHREADS;
    for (long i = (long)C.bx * NTHREADS + C.tid; i < total; i += NGT) { const int seg = (int)(i / vps), off = (int)(i % vps) * 8;
        const f32x4 a = *(const f32x4*)(src + seg * sstride + off), b = *(const f32x4*)(src + seg * sstride + off + 4);
        v4u o; o.x = pk2(a.x, a.y); o.y = pk2(a.z, a.w); o.z = pk2(b.x, b.y); o.w = pk2(b.z, b.w); *(v4u*)(dst + seg * dstride + off) = o; }
}

__device__ __forceinline__ float wave_sum(float v) {
#pragma unroll
    for (int o = 1; o < 64; o <<= 1) v += __shfl_xor(v, o);
    return v;
}
__device__ __forceinline__ void ln_phase(const Ctx& C, float* RES, bf16* XO, const float* g, const float* b, const float* xs, const float* PART) {
    for (int row = C.gw; row < MT; row += C.NGW) {
        f32x4* xr = (f32x4*)(RES + (size_t)row * DM) + C.lane;
        f32x4 v[8]; float s = 0.f;
        if (row < MP) {
#pragma unroll
            for (int j = 0; j < 8; ++j) v[j] = xr[64 * j];
        } else {
            const f32x4* xp = (const f32x4*)(xs + (size_t)row * DM) + C.lane;
#pragma unroll
            for (int j = 0; j < 8; ++j) v[j] = xp[64 * j] * ALPHA;
#pragma unroll 2
            for (int ks = 0; ks < 8; ++ks) { const f32x4* pp = (const f32x4*)(PART + ((size_t)ks * MS + (row - MP)) * DM) + C.lane;
#pragma unroll
                for (int j = 0; j < 8; ++j) v[j] += pp[64 * j]; }
        }
#pragma unroll
        for (int j = 0; j < 8; ++j) s += (v[j].x + v[j].y) + (v[j].z + v[j].w);
        const float mean = wave_sum(s) * (1.f / DM); float s2 = 0.f;
#pragma unroll
        for (int j = 0; j < 8; ++j) { v[j] = v[j] - mean; s2 += (v[j].x * v[j].x + v[j].y * v[j].y) + (v[j].z * v[j].z + v[j].w * v[j].w); }
        const float rstd = 1.f / sqrtf(wave_sum(s2) * (1.f / DM) + LN_EPS);
        v2u* o8 = (v2u*)(XO + (size_t)row * DM) + C.lane;
#pragma unroll
        for (int j = 0; j < 8; ++j) { const f32x4 gg = ((const f32x4*)g)[C.lane + 64 * j], bb = ((const f32x4*)b)[C.lane + 64 * j]; const f32x4 y = v[j] * rstd * gg + bb;
            xr[64 * j] = y; v2u w; w.x = pk2(y.x, y.y); w.y = pk2(y.z, y.w); o8[64 * j] = w; }
    }
}

constexpr int SC_QPITCH = 4112, SC_NITEMS = 160 + 2304;
__device__ __forceinline__ void scores_phase(const Ctx& C, unsigned* qhead, const bf16* QIB, const bf16* KIP, const bf16* KIS, const float* WI, float* SCP, float* SCS) {
    const int q = C.lane & 31, hh = C.lane >> 5;
    for (;;) {
        if (C.tid == 0) C.MISC[0] = __hip_atomic_fetch_add(qhead, 1u, RLX_AGENT);
        __syncthreads();
        int id = (int)C.MISC[0];
        __syncthreads();
        if (id >= SC_NITEMS) break;
        int row0, nk, ch, stride; const bf16* KI; float* SC;
        if (id < 160) { const int qt = id / 5; ch = id % 5; const int rs0 = qt * 32, b = rs0 >> 6; row0 = MP + rs0; KI = KIS + (size_t)b * SALL * HD; nk = SALL; SC = SCS + (size_t)rs0 * SALL; stride = SALL; }
        else { id -= 160; int k = 7; while (id >= 64 * (k + 1)) { id -= 64 * (k + 1); --k; }
            const int per = 4 * (k + 1), ci = id / per, rem = id % per, c = 16 * k + 15 - ci, tile4 = rem / (k + 1); ch = rem % (k + 1);
            const int b = tile4 >> 1, t0 = c * 64 + (tile4 & 1) * 32; row0 = b * SEQ + t0; KI = KIP + (size_t)b * SEQ * HD; nk = 64 * (c + 1); SC = SCP + (size_t)row0 * SEQ; stride = SEQ; }
        const int s_begin = ch * 1024, nkc = (nk - s_begin) < 1024 ? (nk - s_begin) : 1024, ntiles = nkc >> 5;
#pragma unroll 4
        for (int i = 0; i < 16; ++i) { const int p = C.tid + NTHREADS * i, qq = p >> 8, off = (p & 255) * 16;
            const v4u v = *(const v4u*)((const char*)QIB + (size_t)(row0 + qq) * (DM * 2) + off); *(LAS v4u*)(C.lds + qq * SC_QPITCH + off) = v; }
        LAS float* wl = (LAS float*)(C.lds + 32 * SC_QPITCH);
        { const int qq = C.tid >> 4, h2 = C.tid & 15; wl[qq * 17 + h2] = WI[(size_t)(row0 + qq) * 16 + h2]; }
        __syncthreads();
        const LAS unsigned char* qb = C.lds + q * SC_QPITCH + hh * 16;
        for (int ti = C.wave; ti < ntiles; ti += NWAVES) {
            const int s0 = s_begin + ti * 32;
            const bf16* kp = KI + (size_t)(s0 + q) * HD + 8 * hh;
            bf16x8 kf[8];
#pragma unroll
            for (int kk = 0; kk < 8; ++kk) kf[kk] = *(const bf16x8*)(kp + 16 * kk);
            f32x16 acc;
#pragma unroll
            for (int r = 0; r < 16; ++r) acc[r] = 0.f;
#pragma unroll 2
            for (int h = 0; h < 16; ++h) {
                f32x16 c; const float wh = wl[q * 17 + h];
#pragma unroll
                for (int r = 0; r < 16; ++r) c[r] = 0.f;
#pragma unroll
                for (int kk = 0; kk < 8; ++kk) { const bf16x8 bq = *(const LAS bf16x8*)(qb + h * 256 + kk * 32); c = MFMA32(kf[kk], bq, c); }
#pragma unroll
                for (int r = 0; r < 16; ++r) acc[r] += wh * __builtin_fmaxf(c[r], 0.f);
            }
            float* sp = SC + (size_t)q * stride + s0 + 4 * hh;
#pragma unroll
            for (int g = 0; g < 4; ++g) *(f32x4*)(sp + 8 * g) = (f32x4){acc[4 * g], acc[4 * g + 1], acc[4 * g + 2], acc[4 * g + 3]};
        }
        __syncthreads();
    }
}

__device__ __forceinline__ unsigned tokey(float f) { const unsigned u = __float_as_uint(f); return (u & 0x80000000u) ? ~u : (u | 0x80000000u); }
__device__ __forceinline__ void select_phase(const Ctx& C, const float* SCP, const float* SCS, int* IDX, int* CNT) {
    LAS unsigned* hist = (LAS unsigned*)(C.lds + C.wave * 1024);
    const int lane = C.lane; const unsigned long long ltm = (1ull << lane) - 1ull;
    for (int row = C.gw; row < MT; row += C.NGW) {
        int n; const float* sc;
        if (row < MP) { const int t = row & (SEQ - 1); n = 64 * ((t >> 6) + 1); sc = SCP + (size_t)row * SEQ; } else { n = SALL; sc = SCS + (size_t)(row - MP) * SALL; }
        int* ip = IDX + (size_t)row * TOPK;
        if (n <= TOPK) {
#pragma unroll
            for (int k = 0; k < 4; ++k) { const int i = lane + 64 * k; ip[i] = (i < n) ? i : 0; }
            if (lane == 0) CNT[row] = n;
            continue;
        }
        v4u kreg[32];
#pragma unroll
        for (int it = 0; it < 32; ++it) { kreg[it] = (v4u){0u, 0u, 0u, 0u};
            if ((it >> 2) * 1024 < n) { if (it * 256 + lane * 4 < n) { const f32x4 v = *(const f32x4*)(sc + it * 256 + lane * 4); kreg[it] = (v4u){tokey(v.x), tokey(v.y), tokey(v.z), tokey(v.w)}; } } }
        unsigned prefix = 0u, mask = 0u, krem = TOPK;
        for (int pass = 0; pass < 4; ++pass) {
            const int shift = 24 - 8 * pass;
            *(LAS v4u*)(hist + 4 * lane) = (v4u){0u, 0u, 0u, 0u};
            LDS_WAIT();
#pragma unroll
            for (int it = 0; it < 32; ++it) if ((it >> 2) * 1024 < n) {
#pragma unroll
                for (int e = 0; e < 4; ++e) { const unsigned key = kreg[it][e]; if ((key & mask) == prefix) __hip_atomic_fetch_add(hist + ((key >> shift) & 255u), 1u, __ATOMIC_RELAXED, __HIP_MEMORY_SCOPE_WORKGROUP); } }
            LDS_WAIT();
            const v4u hc = *(const LAS v4u*)(hist + 4 * lane);
            const unsigned tot = hc.x + hc.y + hc.z + hc.w; unsigned x = tot;
#pragma unroll
            for (int o = 1; o < 64; o <<= 1) { const unsigned y = __shfl_down(x, o); if (lane + o < 64) x += y; }
            const unsigned a3 = x - tot, a2 = a3 + hc.w, a1 = a2 + hc.z, a0 = a1 + hc.y;
            int fe = -1; unsigned fa = 0u;
            if (a3 < krem && krem <= a3 + hc.w) { fe = 3; fa = a3; } else if (a2 < krem && krem <= a2 + hc.z) { fe = 2; fa = a2; }
            else if (a1 < krem && krem <= a1 + hc.y) { fe = 1; fa = a1; } else if (a0 < krem && krem <= a0 + hc.x) { fe = 0; fa = a0; }
            const unsigned long long bal = __ballot(fe >= 0); const int src = bal ? (__ffsll((long long)bal) - 1) : 0;
            const unsigned d = (unsigned)__shfl(4 * lane + fe, src), above = (unsigned)__shfl((int)fa, src);
            krem -= above; prefix |= d << shift; mask |= 0xffu << shift;
        }
        int outc = 0, eqs = 0;
#pragma unroll
        for (int it = 0; it < 32; ++it) if ((it >> 2) * 1024 < n) {
            bool eq[4], sel[4];
#pragma unroll
            for (int e = 0; e < 4; ++e) { eq[e] = kreg[it][e] == prefix; sel[e] = kreg[it][e] > prefix; }
            const unsigned long long anyeq = __ballot(eq[0] || eq[1] || eq[2] || eq[3]);
            if (anyeq) {
                const int mine = (int)eq[0] + (int)eq[1] + (int)eq[2] + (int)eq[3];
                int below = 0, total = 0;
#pragma unroll
                for (int e = 0; e < 4; ++e) { const unsigned long long bb = __ballot(eq[e]); below += __popcll(bb & ltm); total += __popcll(bb); }
                int r = eqs + below;
#pragma unroll
                for (int e = 0; e < 4; ++e) { if (eq[e]) { if ((unsigned)r < krem) sel[e] = true; ++r; } }
                eqs += total; (void)mine;
            }
#pragma unroll
            for (int e = 0; e < 4; ++e) { const unsigned long long sb = __ballot(sel[e]); const int pos = outc + __popcll(sb & ltm); if (sel[e] && pos < TOPK) ip[pos] = it * 256 + lane * 4 + e; outc += __popcll(sb); }
        }
        if (lane == 0) CNT[row] = outc < TOPK ? outc : TOPK;
    }
}

__device__ __forceinline__ int t5_bucket(int n  ) {
    const int ret = (n < 0) ? 16 : 0; n = n < 0 ? -n : n;
    if (n < 8) return ret + n;
    const int lg = 31 - __builtin_clz((unsigned)(n * n));
    const int large = 2 + lg; return ret + (large < 15 ? large : 15);
}
__device__ __forceinline__ float dpp_quad_sum(float t) {
    t += __builtin_bit_cast(float, __builtin_amdgcn_mov_dpp(__builtin_bit_cast(int, t), 0xB1, 0xF, 0xF, true));
    t += __builtin_bit_cast(float, __builtin_amdgcn_mov_dpp(__builtin_bit_cast(int, t), 0x4E, 0xF, 0xF, true));
    return t;
}
__device__ __forceinline__ void sattn_task(int row, int g, int qpos, const bf16* Kb, const bf16* Vb, int cnt, const int* ip, const bf16* QB, bf16* OB,
                                           LAS int* idxl, LAS float* lg, const LAS float* biasl, int lane) {
#pragma unroll
    for (int k = 0; k < 4; ++k) { const int j = lane + 64 * k; const int v = ip[j]; idxl[j] = (j < cnt) ? v : 0; }
    const int kq = lane >> 2, c4 = lane & 3;
    unsigned qreg[4][16];
    { const bf16* qp = QB + (size_t)row * DM + (4 * g) * HD + 32 * c4;
#pragma unroll
      for (int hq = 0; hq < 4; ++hq)
#pragma unroll
          for (int i = 0; i < 4; ++i) { const v4u a = *(const v4u*)(qp + hq * HD + 8 * i); qreg[hq][4 * i] = a.x; qreg[hq][4 * i + 1] = a.y; qreg[hq][4 * i + 2] = a.z; qreg[hq][4 * i + 3] = a.w; } }
    LDS_WAIT();
    for (int r0 = 0; r0 < 16; r0 += 2) {
        v4u kd[2][4];
#pragma unroll
        for (int rr = 0; rr < 2; ++rr) { const int key = idxl[16 * (r0 + rr) + kq]; const bf16* kp = Kb + (size_t)key * KVW + 32 * c4;
#pragma unroll
            for (int i = 0; i < 4; ++i) kd[rr][i] = *(const v4u*)(kp + 8 * i); }
#pragma unroll
        for (int rr = 0; rr < 2; ++rr) { float s[4];
#pragma unroll
            for (int hq = 0; hq < 4; ++hq) { float t = 0.f;
#pragma unroll
                for (int i = 0; i < 4; ++i) { t = dot2bf(kd[rr][i].x, qreg[hq][4 * i], t); t = dot2bf(kd[rr][i].y, qreg[hq][4 * i + 1], t); t = dot2bf(kd[rr][i].z, qreg[hq][4 * i + 2], t); t = dot2bf(kd[rr][i].w, qreg[hq][4 * i + 3], t); }
                s[hq] = dpp_quad_sum(t); }
            const float sv = c4 == 0 ? s[0] : c4 == 1 ? s[1] : c4 == 2 ? s[2] : s[3];
            lg[(16 * (r0 + rr) + kq) * 4 + c4] = sv; }
    }
    LDS_WAIT();
    float l[4][4];
#pragma unroll
    for (int k = 0; k < 4; ++k) { const int j = lane + 64 * k; const f32x4 l4 = *(const LAS f32x4*)(lg + 4 * j); const int key = idxl[j]; const int bk = t5_bucket(qpos - key);
        const f32x4 b4 = *(const LAS f32x4*)(biasl + bk * 16 + 4 * g); const bool valid = j < cnt;
#pragma unroll
        for (int hq = 0; hq < 4; ++hq) l[k][hq] = valid ? l4[hq] * QK_SCALE + b4[hq] : -INFINITY; }
    LDS_WAIT();
#pragma unroll
    for (int hq = 0; hq < 4; ++hq) { float m = __builtin_fmaxf(__builtin_fmaxf(l[0][hq], l[1][hq]), __builtin_fmaxf(l[2][hq], l[3][hq]));
#pragma unroll
        for (int o = 1; o < 64; o <<= 1) m = __builtin_fmaxf(m, __shfl_xor(m, o));
        float sum = 0.f;
#pragma unroll
        for (int k = 0; k < 4; ++k) { l[k][hq] = __expf(l[k][hq] - m); sum += l[k][hq]; }
        sum = wave_sum(sum); const float inv = 1.0f / sum;
#pragma unroll
        for (int k = 0; k < 4; ++k) l[k][hq] *= inv; }
#pragma unroll
    for (int k = 0; k < 4; ++k) { const int j = lane + 64 * k; *(LAS f32x4*)(lg + 4 * j) = (f32x4){l[k][0], l[k][1], l[k][2], l[k][3]}; }
    LDS_WAIT();
    const int ks = lane >> 4, dc = lane & 15;
    f32x2 o[4][4];
#pragma unroll
    for (int hq = 0; hq < 4; ++hq)
#pragma unroll
        for (int i = 0; i < 4; ++i) o[hq][i] = (f32x2){0.f, 0.f};
    const bf16* vp = Vb + 8 * dc;
    for (int jb = 0; jb < TOPK; jb += 32) {
        v4u w[8]; f32x4 p4[8];
#pragma unroll
        for (int u = 0; u < 8; ++u) { const int j = jb + 4 * u + ks; const int key = idxl[j]; w[u] = *(const v4u*)(vp + (size_t)key * KVW); p4[u] = *(const LAS f32x4*)(lg + 4 * j); }
#pragma unroll
        for (int u = 0; u < 8; ++u) { const f32x2 v0 = (f32x2){bf_lo(w[u].x), bf_hi(w[u].x)}, v1 = (f32x2){bf_lo(w[u].y), bf_hi(w[u].y)}, v2 = (f32x2){bf_lo(w[u].z), bf_hi(w[u].z)}, v3 = (f32x2){bf_lo(w[u].w), bf_hi(w[u].w)};
#pragma unroll
            for (int hq = 0; hq < 4; ++hq) { const float ph = p4[u][hq]; o[hq][0] += ph * v0; o[hq][1] += ph * v1; o[hq][2] += ph * v2; o[hq][3] += ph * v3; } }
    }
    v4u st = (v4u){0u, 0u, 0u, 0u};
#pragma unroll
    for (int hq = 0; hq < 4; ++hq) { unsigned pk[4];
#pragma unroll
        for (int i = 0; i < 4; ++i) { float x = o[hq][i].x, y = o[hq][i].y; x += __shfl_xor(x, 16); x += __shfl_xor(x, 32); y += __shfl_xor(y, 16); y += __shfl_xor(y, 32); pk[i] = pk2(x, y); }
        if (ks == hq) st = (v4u){pk[0], pk[1], pk[2], pk[3]}; }
    *(v4u*)(OB + (size_t)row * DM + (4 * g + ks) * HD + 8 * dc) = st;
    LDS_WAIT();
}
__device__ __forceinline__ void sattn_phase(const Ctx& C, const float* rel_bias, const bf16* QB, const bf16* KAP, const bf16* VAP, const bf16* KAS, const bf16* VAS, const int* IDX, const int* CNT, bf16* OB) {
    LAS float* biasl = (LAS float*)C.lds;
    LAS int* idxl = (LAS int*)(C.lds + 2048 + C.wave * 5120); LAS float* lg = (LAS float*)(C.lds + 2048 + C.wave * 5120 + 1024);
    if (C.tid < 512) biasl[C.tid] = rel_bias[C.tid];
    __syncthreads();
    const int x8 = C.bx & 7, g = x8 & 3, par = x8 >> 2, wi = (C.bx >> 3) * NWAVES + C.wave, nw = (C.G >> 3) * NWAVES;
    for (int k = wi; k < SEQ + 512; k += nw) {
        if (k < SEQ) { const int row = par * SEQ + k;
            sattn_task(row, g, k, KAP + (size_t)par * SEQ * KVW + g * HD, VAP + (size_t)par * SEQ * KVW + g * HD, CNT[row], IDX + (size_t)row * TOPK, QB, OB, idxl, lg, biasl, C.lane); }
        else { const int j = k - SEQ, b = 2 * (j >> 6) + par, i = j & 63, row = MP + b * DECS + i;
            sattn_task(row, g, PAST + i, KAS + (size_t)b * SALL * KVW + g * HD, VAS + (size_t)b * SALL * KVW + g * HD, CNT[row], IDX + (size_t)row * TOPK, QB, OB, idxl, lg, biasl, C.lane); }
    }
}

constexpr int VT_PITCH = 320, SB_NTASK = 8192 + 512;
typedef short v4i16_t __attribute__((ext_vector_type(4)));
__device__ __forceinline__ bf16x8 pack8(const f32x4& a, const f32x4& b) { v4u w; w.x = pk2(a.x, a.y); w.y = pk2(a.z, a.w); w.z = pk2(b.x, b.y); w.w = pk2(b.z, b.w); return __builtin_bit_cast(bf16x8, w); }
__device__ __forceinline__ void sb_task(bool samp, int b, int h, int qpos0, int r0, const bf16* QB, const bf16* KBB, const bf16* VBB, const float* kcache, const float* vcache, bf16* OB, LAS unsigned char* vt, int lane) {
    const int q = lane & 31, hh = lane >> 5;
    bf16x8 qf[8];
    { const bf16* qp = QB + (size_t)(r0 + q) * DM + h * HD + 8 * hh;
#pragma unroll
      for (int kk = 0; kk < 8; ++kk) qf[kk] = *(const bf16x8*)(qp + 16 * kk); }
    f32x16 O[4];
#pragma unroll
    for (int db = 0; db < 4; ++db)
#pragma unroll
        for (int r = 0; r < 16; ++r) O[db][r] = 0.f;
    float R = 1.f; const int t = qpos0 + q;
    const int vkey = lane >> 1, vch0 = (lane & 1) * 8;
    const int rowbase = samp ? (MP + b * DECS - PAST) : b * SEQ;
    bf16x8 kf[8]; v4u vr[8]; bool have = false;
    for (int kt = qpos0 >> 5; kt >= 0; --kt) {
        const bool f32t = samp && (32 * kt < PAST);
        if (f32t) {
            const float* kl = kcache + ((size_t)(b * PAST + 32 * kt + q) * 16 + h) * HD + 8 * hh;
#pragma unroll
            for (int kk = 0; kk < 8; ++kk) { const f32x4 a = *(const f32x4*)(kl + 16 * kk), bq = *(const f32x4*)(kl + 16 * kk + 4); kf[kk] = pack8(a, bq); }
#pragma unroll
            for (int i = 0; i < 8; ++i) { const float* vl = vcache + ((size_t)(b * PAST + 32 * kt + vkey) * 16 + h) * HD + 8 * (vch0 + i); const f32x4 a = *(const f32x4*)vl, bq = *(const f32x4*)(vl + 4); vr[i] = __builtin_bit_cast(v4u, pack8(a, bq)); }
        } else if (!have) {
            const bf16* kl = KBB + (size_t)(rowbase + 32 * kt + q) * DM + h * HD + 8 * hh;
#pragma unroll
            for (int kk = 0; kk < 8; ++kk) kf[kk] = *(const bf16x8*)(kl + 16 * kk);
#pragma unroll
            for (int i = 0; i < 8; ++i) vr[i] = *(const v4u*)(VBB + (size_t)(rowbase + 32 * kt + vkey) * DM + h * HD + 8 * (vch0 + i));
        }
#pragma unroll
        for (int i = 0; i < 8; ++i) *(LAS v4u*)(vt + vkey * VT_PITCH + 16 * (vch0 + i)) = vr[i];
        f32x16 c;
#pragma unroll
        for (int r = 0; r < 16; ++r) c[r] = 0.f;
#pragma unroll
        for (int kk = 0; kk < 8; ++kk) c = MFMA32(kf[kk], qf[kk], c);
        have = false;
        if (kt > 0 && !(samp && (32 * (kt - 1) < PAST))) { have = true;
            const bf16* kl = KBB + (size_t)(rowbase + 32 * (kt - 1) + q) * DM + h * HD + 8 * hh;
#pragma unroll
            for (int kk = 0; kk < 8; ++kk) kf[kk] = *(const bf16x8*)(kl + 16 * kk);
#pragma unroll
            for (int i = 0; i < 8; ++i) vr[i] = *(const v4u*)(VBB + (size_t)(rowbase + 32 * (kt - 1) + vkey) * DM + h * HD + 8 * (vch0 + i));
        }
        float om[16], be[16];
#pragma unroll
        for (int r = 0; r < 16; ++r) { const int s = 32 * kt + crow(r, hh); const float z = c[r] * QK_SCALE; const float a = __expf(-__builtin_fabsf(z)); const float rr = __builtin_amdgcn_rcpf(1.0f + a), ar = a * rr;
            const bool m = s < t; const float beta = z > 0.f ? rr : ar, omb = z > 0.f ? ar : rr; om[r] = m ? omb : 1.f; be[r] = m ? beta : 0.f; }
        float pg[4], pp[4], tt[4];
#pragma unroll
        for (int gi = 0; gi < 4; ++gi) { pg[gi] = (om[4 * gi] * om[4 * gi + 1]) * (om[4 * gi + 2] * om[4 * gi + 3]); pp[gi] = __shfl_xor(pg[gi], 32); tt[gi] = pg[gi] * pp[gi]; }
        float SB[4]; SB[3] = 1.f; SB[2] = tt[3]; SB[1] = tt[3] * tt[2]; SB[0] = SB[1] * tt[1];
        float A[16];
#pragma unroll
        for (int gi = 0; gi < 4; ++gi) { const float s3 = R * SB[gi] * (hh == 0 ? pp[gi] : 1.f), s2 = s3 * om[4 * gi + 3], s1 = s2 * om[4 * gi + 2], s0 = s1 * om[4 * gi + 1];
            A[4 * gi + 3] = be[4 * gi + 3] * s3; A[4 * gi + 2] = be[4 * gi + 2] * s2; A[4 * gi + 1] = be[4 * gi + 1] * s1; A[4 * gi] = be[4 * gi] * s0; }
        R = R * (SB[0] * tt[0]);
        bf16x8 pf[2];
#pragma unroll
        for (int s = 0; s < 2; ++s) { v4u w; w.x = pk2(A[8 * s], A[8 * s + 1]); w.y = pk2(A[8 * s + 2], A[8 * s + 3]); w.z = pk2(A[8 * s + 4], A[8 * s + 5]); w.w = pk2(A[8 * s + 6], A[8 * s + 7]); pf[s] = __builtin_bit_cast(bf16x8, w); }
        { const int i16 = lane & 15, qq = i16 >> 2, pq = i16 & 3, blk = (lane >> 4) & 1;
          LAS unsigned char* vb0 = vt + (4 * hh + qq) * VT_PITCH + (16 * blk + 4 * pq) * 2;
#pragma unroll
          for (int db = 0; db < 4; ++db)
#pragma unroll
              for (int s = 0; s < 2; ++s) { LAS unsigned char* ap = vb0 + (16 * s) * VT_PITCH + 64 * db;
                  const v4i16_t lo = __builtin_amdgcn_ds_read_tr16_b64_v4i16((LAS v4i16_t*)ap), hi2 = __builtin_amdgcn_ds_read_tr16_b64_v4i16((LAS v4i16_t*)(ap + 8 * VT_PITCH));
                  const bf16x8 af = __builtin_shufflevector(lo, hi2, 0, 1, 2, 3, 4, 5, 6, 7); O[db] = MFMA32(af, pf[s], O[db]); } }
        LDS_WAIT();
        if (__all(R == 0.f)) break;
    }
#pragma unroll
    for (int db = 0; db < 4; ++db)
#pragma unroll
        for (int rg = 0; rg < 4; ++rg) { v2u w; w.x = pk2(O[db][4 * rg], O[db][4 * rg + 1]); w.y = pk2(O[db][4 * rg + 2], O[db][4 * rg + 3]);
            *(v2u*)(OB + (size_t)(r0 + q) * DM + h * HD + 32 * db + 8 * rg + 4 * hh) = w; }
}
__device__ __forceinline__ void sbattn_phase(const Ctx& C, unsigned* qhead, const bf16* QB, const bf16* KBB, const bf16* VBB, const float* kcache, const float* vcache, bf16* OB) {
    LAS unsigned char* vt = C.lds + C.wave * (32 * VT_PITCH);
    int id = 0; if (C.lane == 0) id = (int)__hip_atomic_fetch_add(qhead, 1u, RLX_AGENT); id = __builtin_amdgcn_readfirstlane(id);
    while (id < SB_NTASK) {
        int nid = 0; if (C.lane == 0) nid = (int)__hip_atomic_fetch_add(qhead, 1u, RLX_AGENT);
        if (id < 512) { const int b = id >> 5, h = (id >> 1) & 15, hf = id & 1; sb_task(true, b, h, PAST + 32 * hf, MP + b * DECS + 32 * hf, QB, KBB, VBB, kcache, vcache, OB, vt, C.lane); }
        else { const int j = id - 512, b = j >> 12, h = (j >> 8) & 15, qt = j & 255; sb_task(false, b, h, qt * 32, b * SEQ + qt * 32, QB, KBB, VBB, kcache, vcache, OB, vt, C.lane); }
        id = __builtin_amdgcn_readfirstlane(nid);
    }
}

struct Args { const float* in[22]; float* out; unsigned char* ws; int ph_lo, ph_hi; };
__global__ void __launch_bounds__(NTHREADS, 2) mk_fwd(Args args) {
    extern __shared__ __attribute__((aligned(16))) unsigned char lds_raw[];
    Ctx C;
    C.lds = (LAS unsigned char*)lds_raw; C.MISC = (volatile LAS unsigned*)(C.lds + MISC_OFF);
    C.tid = threadIdx.x; C.lane = C.tid & 63; C.wave = __builtin_amdgcn_readfirstlane(C.tid >> 6);
    C.G = gridDim.x; C.bx = blockIdx.x; C.gw = C.bx * NWAVES + C.wave; C.NGW = C.G * NWAVES;
    unsigned char* ws = args.ws; unsigned* ctl = (unsigned*)(ws + WS_CTL); float* out = args.out;
    for (int u = C.tid; u < (LDS_BYTES - LDSCTL_OFF) / 4; u += NTHREADS) ((LAS unsigned*)(C.lds + LDSCTL_OFF))[u] = 0u;
    __syncthreads();
    XcdBarrier bar; bar.bar = ctl + CW_BAR; bar.x = 0; bar.st = nullptr;
    if (!MK_PER_PHASE) bar = xcd_barrier_post(ctl + CW_BAR, C.MISC + 8);
    const int lo = args.ph_lo, hi = args.ph_hi;
#define IN(k) (lo <= (k) && (k) < hi)
#define PH_ON(k) ((MK_PH_MASK >> (k)) & 1u)
#define SEAM(k) do { if (!MK_PER_PHASE && IN(k) && IN((k) + 1)) xcd_barrier(bar); } while (0)
    const float *x_prompt = args.in[0], *x_sample = args.in[1], *cache_k_a = args.in[2], *cache_v_a = args.in[3], *cache_kidx_a = args.in[4], *cache_k_b = args.in[5], *cache_v_b = args.in[6];
    const float *p_prompt = args.in[7], *p_sample = args.in[8], *rel_bias = args.in[9], *w_in_a = args.in[10], *w_out_a = args.in[11], *w_in_b = args.in[12], *w_out_b = args.in[13];
    const float *ln1_g = args.in[14], *ln1_b = args.in[15], *ln2_g = args.in[16], *ln2_b = args.in[17], *w_up = args.in[18], *w_down = args.in[19], *w_ple = args.in[20], *w_ple_gate = args.in[21];
    bf16 *WINA = (bf16*)(ws + WS_WINA), *WOUTA = (bf16*)(ws + WS_WOUTA), *WINB = (bf16*)(ws + WS_WINB), *WOUTB = (bf16*)(ws + WS_WOUTB), *WUP = (bf16*)(ws + WS_WUP), *WDOWN = (bf16*)(ws + WS_WDOWN), *WG = (bf16*)(ws + WS_WG), *WP = (bf16*)(ws + WS_WP);
    bf16 *PB = (bf16*)(ws + WS_PB), *XB = (bf16*)(ws + WS_XB), *X1B = (bf16*)(ws + WS_X1B), *X2B = (bf16*)(ws + WS_X2B), *QB = (bf16*)(ws + WS_QB), *OB = (bf16*)(ws + WS_OB), *QIB = (bf16*)(ws + WS_QIB);
    bf16 *KAP = (bf16*)(ws + WS_KAP), *VAP = (bf16*)(ws + WS_VAP), *KAS = (bf16*)(ws + WS_KAS), *VAS = (bf16*)(ws + WS_VAS), *KIP = (bf16*)(ws + WS_KIP), *KIS = (bf16*)(ws + WS_KIS), *HB = (bf16*)(ws + WS_H), *KBB = (bf16*)(ws + WS_KBB), *VBB = (bf16*)(ws + WS_VBB);
    float *WI = (float*)(ws + WS_WI), *RES = (float*)(ws + WS_RES), *Y0 = (float*)(ws + WS_Y0), *PW = (float*)(ws + WS_PW), *SCP = (float*)(ws + WS_SCP), *SCS = (float*)(ws + WS_SCS), *PART = (float*)(ws + WS_PART);
    int *IDX = (int*)(ws + WS_IDX), *CNT = (int*)(ws + WS_CNT);

    if (IN(0)) for (int rep_ = 0; rep_ < NREP(2); ++rep_) {
        transpose_job(C, w_in_a, DM, NINA, NINA_PAD, WINA); transpose_job(C, w_out_a, DM, DM, DM, WOUTA); transpose_job(C, w_in_b, DM, NINB, NINB, WINB); transpose_job(C, w_out_b, DM, DM, DM, WOUTB);
        for (int l = 0; l < 2; ++l) { transpose_job(C, w_up + (size_t)l * DM * DFF, DM, DFF, DFF, WUP + (size_t)l * DFF * DM); transpose_job(C, w_down + (size_t)l * DFF * DM, DFF, DM, DM, WDOWN + (size_t)l * DM * DFF);
            transpose_job(C, w_ple_gate + (size_t)l * DM * DM, DM, DM, DM, WG + (size_t)l * DM * DM); transpose_job(C, w_ple + (size_t)l * PLE * DM, PLE, DM, DM, WP + (size_t)l * DM * PLE); }
        cvt_job(C, x_prompt, XB, 1, MP * DM, 0, 0); cvt_job(C, x_sample, XB + (size_t)MP * DM, 1, MS * DM, 0, 0);
        for (int l = 0; l < 2; ++l) { cvt_job(C, p_prompt + (size_t)l * MP * PLE, PB + (size_t)l * MT * PLE, 1, MP * PLE, 0, 0); cvt_job(C, p_sample + (size_t)l * MS * PLE, PB + (size_t)l * MT * PLE + (size_t)MP * PLE, 1, MS * PLE, 0, 0); }
        cvt_job(C, cache_k_a, KAS, DECB, PAST * KVW, (size_t)PAST * KVW, (size_t)SALL * KVW); cvt_job(C, cache_v_a, VAS, DECB, PAST * KVW, (size_t)PAST * KVW, (size_t)SALL * KVW);
        cvt_job(C, cache_kidx_a, KIS, DECB, PAST * HD, (size_t)PAST * HD, (size_t)SALL * HD);
    }
    SEAM(0);
#define LAYER_BODY(l) do { \
        const int pb = (l == 0) ? 5 : 13; \
        if (l == 0) { \
            if (IN(1) && PH_ON(1)) { pg8::Gemm g{XB, WINA, MT, NINA_PAD, DM, DM}; pg8::StaticOrder S; S.init(MT, NINA_PAD, C.G, C.bx); \
                pg8::EpiInA E{QB, QIB, KAP, KIP, WI, out}; \
                pg8::gemm_phase<pg8::EpiInA, pg8::StaticOrder, true, true>(C.lds, g, S, E); if (NREP(0) > 1) { pg8::gemm_phase<pg8::EpiInA, pg8::StaticOrder, true, true>(C.lds, g, S, E); } } \
            SEAM(1); \
            if (IN(2) && PH_ON(2)) for (int rep_ = 0; rep_ < NREP2(1, 4); ++rep_) scores_phase(C, ctl + CW_QSC + 64 * rep_, QIB, KIP, KIS, WI, SCP, SCS); \
            SEAM(2); \
            if (IN(3) && PH_ON(3)) for (int rep_ = 0; rep_ < NREP2(1, 5); ++rep_) select_phase(C, SCP, SCS, IDX, CNT); \
            SEAM(3); \
            if (IN(4) && PH_ON(4)) for (int rep_ = 0; rep_ < NREP2(1, 6); ++rep_) sattn_phase(C, rel_bias, QB, KAP, VAP, KAS, VAS, IDX, CNT, OB); \
            SEAM(4); \
        } else { \
            if (IN(11) && PH_ON(11)) { pg8::Gemm g{XB, WINB, MT, NINB, DM, DM}; pg8::StaticOrder S; S.init(MT, NINB, C.G, C.bx); \
                pg8::EpiInB E{QB, KBB, out}; \
                pg8::gemm_phase<pg8::EpiInB, pg8::StaticOrder, true, true>(C.lds, g, S, E); if (NREP(0) > 1) { pg8::gemm_phase<pg8::EpiInB, pg8::StaticOrder, true, true>(C.lds, g, S, E); } } \
            SEAM(11); \
            if (IN(12) && PH_ON(12)) for (int rep_ = 0; rep_ < NREP(3); ++rep_) sbattn_phase(C, ctl + CW_QSB + 64 * rep_, QB, KBB, VBB, cache_k_b, cache_v_b, OB); \
            SEAM(12); \
        } \
        if (IN(pb) && PH_ON(pb)) { \
            { pg8::Gemm g{OB, l == 0 ? WOUTA : WOUTB, MP, DM, DM, DM}; pg8::StaticOrder S; S.init(MP, DM, C.G, C.bx); pg8::EpiResid E{l == 0 ? x_prompt : Y0, RES}; \
              GEMM2X((pg8::gemm_phase<pg8::EpiResid, pg8::StaticOrder, true, true>(C.lds, g, S, E))); } \
            { int ksl = 256; asm volatile("" : "+s"(ksl)); pg8::Gemm g{OB, l == 0 ? WOUTA : WOUTB, MT, DM, ksl, DM}; pg8::SplitOrder S{C.G, C.bx}; pg8::EpiPart E{PART}; \
              GEMM2X((pg8::gemm_phase<pg8::EpiPart, pg8::SplitOrder, true, true>(C.lds, g, S, E))); } } \
        SEAM(pb); \
        if (IN(pb + 1) && PH_ON(pb + 1)) ln_phase(C, RES, X1B, ln1_g + l * DM, ln1_b + l * DM, l == 0 ? x_sample - (size_t)MP * DM : Y0, PART); \
        SEAM(pb + 1); \
        if (IN(pb + 2) && PH_ON(pb + 2)) { pg8::Gemm g{X1B, WUP + (size_t)l * DFF * DM, MT, DFF, DM, DM}; pg8::StaticOrder S; S.init(MT, DFF, C.G, C.bx); \
            pg8::EpiSqRelu E{HB}; \
            GEMM2X((pg8::gemm_phase<pg8::EpiSqRelu, pg8::StaticOrder, true, true>(C.lds, g, S, E))); } \
        SEAM(pb + 2); \
        if (IN(pb + 3) && PH_ON(pb + 3)) { \
            { pg8::Gemm g{HB, WDOWN + (size_t)l * DM * DFF, MP, DM, DFF, DFF}; pg8::StaticOrder S; S.init(MP, DM, C.G, C.bx); pg8::EpiResid E{RES, RES}; \
              if (NREP(0) > 1) { pg8::EpiResid E2{RES, PW}; pg8::gemm_phase<pg8::EpiResid, pg8::StaticOrder, true, true>(C.lds, g, S, E2); } \
              pg8::gemm_phase<pg8::EpiResid, pg8::StaticOrder, true, true>(C.lds, g, S, E); } \
            { int ksl = 1024; asm volatile("" : "+s"(ksl)); pg8::Gemm g{HB, WDOWN + (size_t)l * DM * DFF, MT, DM, ksl, DFF}; pg8::SplitOrder S{C.G, C.bx}; pg8::EpiPart E{PART}; \
              GEMM2X((pg8::gemm_phase<pg8::EpiPart, pg8::SplitOrder, true, true>(C.lds, g, S, E))); } } \
        SEAM(pb + 3); \
        if (IN(pb + 4) && PH_ON(pb + 4)) ln_phase(C, RES, X2B, ln2_g + l * DM, ln2_b + l * DM, RES, PART); \
        SEAM(pb + 4); \
        if (IN(pb + 5) && PH_ON(pb + 5)) { \
            if (MK_GATE_PART & 1) { int kple = PLE; asm volatile("" : "+s"(kple)); pg8::Gemm g{PB + (size_t)l * MT * PLE, WP + (size_t)l * DM * PLE, MT, DM, kple, PLE}; pg8::StaticOrder S; S.init(MT, DM, C.G, C.bx); \
              pg8::EpiStoreF32 E{PW}; \
              pg8::gemm_phase<pg8::EpiStoreF32, pg8::StaticOrder, true, true>(C.lds, g, S, E); if (NREP(0) > 1) { pg8::gemm_phase<pg8::EpiStoreF32, pg8::StaticOrder, true, true>(C.lds, g, S, E); } } \
            VM_WAIT(); __syncthreads(); \
            if (MK_GATE_PART & 2) { pg8::Gemm g{X2B, WG + (size_t)l * DM * DM, MT, DM, DM, DM}; pg8::StaticOrder S; S.init(MT, DM, C.G, C.bx); \
              pg8::EpiGate E{RES, PW, l == 0 ? Y0 : out + O_Y, l == 0 ? XB : (bf16*)nullptr}; \
              pg8::gemm_phase<pg8::EpiGate, pg8::StaticOrder, true, true>(C.lds, g, S, E); if (NREP(0) > 1) { pg8::gemm_phase<pg8::EpiGate, pg8::StaticOrder, true, true>(C.lds, g, S, E); } } \
        } \
        SEAM(pb + 5); \
    } while (0)
    LAYER_BODY(0);
    LAYER_BODY(1);
#undef LAYER_BODY
#undef IN
#undef SEAM
}

extern "C" void kernel_launch(void* const* d_in, const int* in_sizes, int n_in, void* d_out, int out_size, void* d_ws, size_t ws_size, hipStream_t stream) {
    static int grid = 0;
    if (grid == 0) {
        if (n_in != 22 || out_size != (int)O_END || ws_size < WS_END) { fprintf(stderr, "kernel_launch: unexpected shapes (n_in %d, out %d, ws %zu)\n", n_in, out_size, ws_size); grid = -1; return; }
        int dev = 0, cus = 0;
        if (hipGetDevice(&dev) != hipSuccess || hipDeviceGetAttribute(&cus, hipDeviceAttributeMultiprocessorCount, dev) != hipSuccess) { grid = -1; return; }
        if (hipFuncSetAttribute((const void*)mk_fwd, hipFuncAttributeMaxDynamicSharedMemorySize, LDS_BYTES) != hipSuccess) { fprintf(stderr, "kernel_launch: hipFuncSetAttribute failed\n"); grid = -1; return; }
        int per_cu = 0;
        if (hipOccupancyMaxActiveBlocksPerMultiprocessor(&per_cu, (const void*)mk_fwd, NTHREADS, LDS_BYTES) != hipSuccess || per_cu < 1) fprintf(stderr, "kernel_launch: occupancy query reports %d\n", per_cu);
        (void)hipGetLastError();
        grid = cus - (cus % 8);
        if (grid < 8) grid = 8;
    }
    if (grid < 0) return;
    if (hipMemsetAsync((char*)d_ws + WS_CTL, 0, CTL_ZERO_BYTES, stream) != hipSuccess) return;
    Args a{};
    for (int i = 0; i < 22; ++i) a.in[i] = (const float*)d_in[i];
    a.out = (float*)d_out; a.ws = (unsigned char*)d_ws;
#if MK_PER_PHASE
    for (int p = 0; p < NPH; ++p) { a.ph_lo = p; a.ph_hi = p + 1; hipLaunchKernelGGL(mk_fwd, dim3(grid), dim3(NTHREADS), LDS_BYTES, stream, a); }
#else
    a.ph_lo = 0; a.ph_hi = NPH;
    hipLaunchKernelGGL(mk_fwd, dim3(grid), dim3(NTHREADS), LDS_BYTES, stream, a);
#endif
}
```

```cpp
#include <hip/hip_runtime.h>
#include <cstdio>
#include <cstdint>
#ifndef MK_PER_PHASE
#define MK_PER_PHASE 0
#endif
#ifndef MK_PH_MASK
#define MK_PH_MASK 0xffffffffu
#endif
constexpr int NWAVES = 8, NTHREADS = 512;
constexpr int DM = 2048, SEQ = 8192, MP = 16384, DECB = 16, DECS = 64, MS = 1024, MT = 17408, PAST = 4096, SALL = 4160;
constexpr int NINA = 5264, NINA_PAD = 5376, NINB = 6144, DFF = 8192, PLE = 256, HD = 128, KVW = 512, TOPK = 256;
constexpr float LN_EPS = 1e-5f, ALPHA = 1.41421356237309515f;
constexpr float QK_SCALE = 0.08838834764831845f;
constexpr float WI_SCALE = 0.25f * 0.08838834764831845f;
constexpr int NPH = 19;

constexpr size_t O_Y = 0;
constexpr size_t O_KAP = (size_t)MT * DM, O_VAP = O_KAP + (size_t)MP * KVW, O_KIP = O_VAP + (size_t)MP * KVW;
constexpr size_t O_KBP = O_KIP + (size_t)MP * HD, O_VBP = O_KBP + (size_t)MP * DM;
constexpr size_t O_KAS = O_VBP + (size_t)MP * DM, O_VAS = O_KAS + (size_t)MS * KVW, O_KIS = O_VAS + (size_t)MS * KVW;
constexpr size_t O_KBS = O_KIS + (size_t)MS * HD, O_VBS = O_KBS + (size_t)MS * DM, O_END = O_VBS + (size_t)MS * DM;
static_assert(O_END == 127008768, "d_out layout");

constexpr size_t MiB = 1u << 20;
constexpr size_t WS_CTL = 0, CTL_ZERO_BYTES = 1 * MiB;
constexpr size_t WS_WINA = 2 * MiB, WS_WOUTA = 23 * MiB, WS_WINB = 31 * MiB, WS_WOUTB = 55 * MiB, WS_WUP = 63 * MiB, WS_WDOWN = 127 * MiB, WS_WG = 191 * MiB, WS_WP = 207 * MiB;
constexpr size_t WS_PB = 210 * MiB, WS_XB = 228 * MiB, WS_X1B = 296 * MiB, WS_X2B = 364 * MiB, WS_QB = 432 * MiB, WS_OB = 500 * MiB, WS_QIB = 568 * MiB;
constexpr size_t WS_KAP = 636 * MiB, WS_VAP = 652 * MiB, WS_KAS = 668 * MiB, WS_VAS = 733 * MiB, WS_KIP = 798 * MiB, WS_KIS = 802 * MiB, WS_WI = 819 * MiB;
constexpr size_t WS_IDX = 821 * MiB, WS_CNT = 838 * MiB, WS_RES = 840 * MiB, WS_Y0 = 976 * MiB, WS_PW = 1112 * MiB, WS_H = 1248 * MiB;
constexpr size_t WS_SCP = 1248 * MiB  , WS_SCS = 1760 * MiB, WS_PART = 1778 * MiB  , WS_END = 1842 * MiB;
static_assert(WS_WINA + (size_t)NINA_PAD * DM * 2 <= WS_WOUTA && WS_PB + (size_t)2 * MT * PLE * 2 <= WS_XB && WS_XB + (size_t)MT * DM * 2 <= WS_X1B && WS_KAS + (size_t)DECB * SALL * KVW * 2 <= WS_VAS
              && WS_KIS + (size_t)DECB * SALL * HD * 2 <= WS_WI && WS_WI + (size_t)MT * 16 * 4 <= WS_IDX && WS_IDX + (size_t)MT * TOPK * 4 <= WS_CNT && WS_RES + (size_t)MT * DM * 4 <= WS_Y0
              && WS_H + (size_t)MT * DFF * 2 <= WS_SCS && WS_SCP + (size_t)MP * SEQ * 4 <= WS_SCS && WS_SCS + (size_t)MS * SALL * 4 <= WS_PART && WS_PART + (size_t)8 * MS * DM * 4 <= WS_END, "d_ws map");
constexpr size_t WS_KBB = WS_QIB, WS_VBB = WS_KAP;
static_assert(WS_VBB + (size_t)MT * DM * 2 <= WS_KIP, "VBB overlay");
constexpr size_t D_VBB = (WS_VBB - WS_KBB) / 2;
constexpr size_t D_VAP = (WS_VAP - WS_KAP) / 2, D_KAS = (WS_KAS - WS_KAP) / 2, D_VAS = (WS_VAS - WS_KAP) / 2, D_KIS = (WS_KIS - WS_KIP) / 2;
constexpr int CW_BAR = 4096;
constexpr int CW_QSB = 8448;
constexpr int CW_QSC = 8192;

constexpr int RING_BYTES = 135168;
constexpr int LDSCTL_OFF = RING_BYTES, MISC_OFF = LDSCTL_OFF + 320;
constexpr int LDS_BYTES = 147456;
static_assert(MISC_OFF + 128 <= LDS_BYTES, "LDS map");

#define GAS __attribute__((address_space(1)))
#define LAS __attribute__((address_space(3)))
typedef unsigned short bf16;
typedef unsigned v4u __attribute__((ext_vector_type(4)));
typedef unsigned v2u __attribute__((ext_vector_type(2)));
typedef float f32x4 __attribute__((ext_vector_type(4)));
typedef float f32x2 __attribute__((ext_vector_type(2)));
typedef float f32x16 __attribute__((ext_vector_type(16)));
typedef short bf16x8 __attribute__((ext_vector_type(8)));
typedef __bf16 bf16x2_t __attribute__((ext_vector_type(2)));
#define LDS_WAIT() asm volatile("s_waitcnt lgkmcnt(0)" ::: "memory")
#define VM_WAIT() asm volatile("s_waitcnt vmcnt(0)" ::: "memory")
__device__ __forceinline__ unsigned pk2(float lo, float hi) { f32x2 v = {lo, hi}; bf16x2_t b = __builtin_convertvector(v, bf16x2_t); return __builtin_bit_cast(unsigned, b); }
__device__ __forceinline__ float bf_lo(unsigned w) { return __uint_as_float(w << 16); }
__device__ __forceinline__ float bf_hi(unsigned w) { return __uint_as_float(w & 0xffff0000u); }
__device__ __forceinline__ float dot2bf(unsigned a, unsigned b, float c) { return __builtin_amdgcn_fdot2_f32_bf16(__builtin_bit_cast(bf16x2_t, a), __builtin_bit_cast(bf16x2_t, b), c, false); }
namespace pg8 {
#define PG8_LAS __attribute__((address_space(3)))
typedef unsigned short bf16_t;
typedef short bf16x8 __attribute__((ext_vector_type(8)));
typedef float f32x4 __attribute__((ext_vector_type(4)));
typedef unsigned u32x4 __attribute__((ext_vector_type(4)));
constexpr int BM = 256, BK = 64, HALF = 128, HTB = HALF * BK * 2  , STAGE_BYTES = 8 * HTB, NXCD = 8, WGM = 8;

__host__ __device__ __forceinline__ int lds_byte(int r, int c) { const int st = (r >> 4) * 2 + (c >> 5), rr = r & 15, cc = c & 31, ob = rr * 64 + cc * 2; return st * 1024 + (ob ^ (((ob >> 9) & 1) << 5)); }
__host__ __device__ __forceinline__ void stage_rc(int b, int& R, int& C) { const int st = b / 1024, sb = b % 1024, swz = sb ^ (((sb >> 9) & 1) << 5); R = (st >> 1) * 16 + swz / 64; C = (st & 1) * 32 + (swz % 64) / 2; }
__host__ __device__ __forceinline__ int perm32(int rho) { const int n = rho >> 4, i = rho & 15; return 8 * (i >> 2) + 4 * n + (i & 3); }

struct Unit { int pm, pn, ks; };
struct Gemm { const bf16_t* A; const bf16_t* Bt; int M, N, K, ld; };

struct StaticOrder {
    int nM, nN, nwg, G, c;
    __host__ __device__ void init(int M, int N, int G_, int c_) { nM = M / BM; nN = N / BM; nwg = nM * nN; G = G_; c = c_; }
    __host__ __device__ bool next(int i, Unit& u) const {
        const long L = (long)i * G + c; if (L >= nwg) return false;
        int wgid = (int)L; { const int q = nwg / NXCD, r = nwg % NXCD, xcd = wgid % NXCD, off = wgid / NXCD; wgid = (xcd < r ? xcd * (q + 1) : r * (q + 1) + (xcd - r) * q) + off; }
        const int nig = WGM * nN, gid = wgid / nig, fm = gid * WGM, gsz = (nM - fm) < WGM ? (nM - fm) : WGM;
        u.pm = fm + ((wgid % nig) % gsz); u.pn = (wgid % nig) / gsz; u.ks = 0; return true;
    }
    __device__ __forceinline__ void a_ready(const Unit&) const {}
    __device__ __forceinline__ void done(const Unit&) const {}
};

__device__ __forceinline__ unsigned cvt_pk_bf16(float lo, float hi) { unsigned r; asm volatile("v_cvt_pk_bf16_f32 %0, %1, %2" : "=v"(r) : "v"(lo), "v"(hi)); return r; }
typedef float f32x2 __attribute__((ext_vector_type(2)));
__device__ __forceinline__ void st_bf16x8(bf16_t* p, const f32x4& a, const f32x4& b) { u32x4 w; w.x = ::pk2(a[0], a[1]); w.y = ::pk2(a[2], a[3]); w.z = ::pk2(b[0], b[1]); w.w = ::pk2(b[2], b[3]); *(u32x4*)p = w; }
__device__ __forceinline__ void st_f32x8(float* p, const f32x4& a, const f32x4& b) { *(f32x4*)p = a; *(f32x4*)(p + 4) = b; }
#define PG8_EPI_LOOP(...) \
    _Pragma("unroll") for (int ai = 0; ai < 2; ++ai) _Pragma("unroll") for (int m = 0; m < 4; ++m) { const int row = u.pm * BM + ai * HALF + wr * 64 + m * 16 + fr; \
        _Pragma("unroll") for (int bj = 0; bj < 2; ++bj) { const int cl = bj * HALF + wc * 32 + 8 * fq; const f32x4 v0 = acc[ai][bj][m][0], v1 = acc[ai][bj][m][1]; __VA_ARGS__ } }
#define PG8_EPI_LOOP_F(...) \
    _Pragma("unroll") for (int ai = 0; ai < 2; ++ai) _Pragma("unroll") for (int m = 0; m < 4; ++m) { const int row = u.pm * BM + ai * HALF + wr * 64 + m * 16 + fr; \
        _Pragma("unroll") for (int bj = 0; bj < 2; ++bj) { const int cl = bj * HALF + wc * 32 + 8 * fq; const f32x4 v0 = acc[ai][bj][m][0], v1 = acc[ai][bj][m][1]; __VA_ARGS__ } asm volatile("" ::: "memory"); }

struct EpiInA {
    static constexpr bool PERM = true, AFTER_DRAIN = false;
    bf16_t *Q, *QI, *KAP, *KIP; float* WI; float* out;
    __device__ __forceinline__ void operator()(const f32x4 (&acc)[2][2][4][2], const Unit& u, int wr, int wc, int fr, int fq) const {
        const int pn = u.pn; const bool samp = u.pm >= 64;
        float* fb = nullptr; bf16_t* bb; int ld; bool remap = false;
        if (pn < 8) { bb = Q + pn * BM; ld = ::DM; }
        else if (pn < 12) { const bool isv = pn >= 10; const int c0 = (pn & 1) * BM; ld = ::KVW; remap = samp;
            fb = out + (samp ? (isv ? ::O_VAS : ::O_KAS) - (size_t)::MP * ::KVW : (isv ? ::O_VAP : ::O_KAP)) + c0;
            bb = KAP + (samp ? (isv ? ::D_VAS : ::D_KAS) : (isv ? ::D_VAP : (size_t)0)) + c0; }
        else if (pn < 20) { bb = QI + (pn - 12) * BM; ld = ::DM; }
        else { ld = ::HD; remap = samp; fb = out + (samp ? ::O_KIS - (size_t)::MP * ::HD : ::O_KIP); bb = KIP + (samp ? ::D_KIS : (size_t)0); }
        PG8_EPI_LOOP(
            const int rs = row - ::MP; const size_t brow = remap ? ((size_t)(rs >> 6) * ::SALL + ::PAST + (rs & 63)) : (size_t)row;
            if (pn == 20 && cl >= 128) { if (cl < 144) st_f32x8(WI + (size_t)row * 16 + (cl - 128), v0 * ::WI_SCALE, v1 * ::WI_SCALE); }
            else { if (fb) st_f32x8(fb + (size_t)row * ld + cl, v0, v1); st_bf16x8(bb + brow * ld + cl, v0, v1); }
        )
    }
};
struct EpiInB {
    static constexpr bool PERM = true, AFTER_DRAIN = false;
    bf16_t* Q; bf16_t* KBB; float* out;
    __device__ __forceinline__ void operator()(const f32x4 (&acc)[2][2][4][2], const Unit& u, int wr, int wc, int fr, int fq) const {
        const int pn = u.pn; const bool samp = u.pm >= 64; const bool isv = pn >= 16;
        float* fb = nullptr; bf16_t* bb;
        if (pn < 8) bb = Q + pn * BM;
        else { const int c0 = (pn & 7) * BM; bb = KBB + (isv ? ::D_VBB : (size_t)0) + c0; fb = out + (samp ? (isv ? ::O_VBS : ::O_KBS) - (size_t)::MP * ::DM : (isv ? ::O_VBP : ::O_KBP)) + c0; }
        PG8_EPI_LOOP(
            if (fb) st_f32x8(fb + (size_t)row * ::DM + cl, v0, v1);
            st_bf16x8(bb + (size_t)row * ::DM + cl, v0, v1);
        )
    }
};
struct EpiResid {
    static constexpr bool PERM = true, AFTER_DRAIN = false;
    const float* x; float* RES;
    __device__ __forceinline__ void operator()(const f32x4 (&acc)[2][2][4][2], const Unit& u, int wr, int wc, int fr, int fq) const {
        const int pn = u.pn;
        PG8_EPI_LOOP_F(
            const size_t off = (size_t)row * ::DM + pn * BM + cl; const f32x4 x0 = *(const f32x4*)(x + off), x1 = *(const f32x4*)(x + off + 4);
            st_f32x8(RES + off, x0 * ::ALPHA + v0, x1 * ::ALPHA + v1);
        )
    }
};
struct EpiPart {
    static constexpr bool PERM = true, AFTER_DRAIN = false;
    float* PART;
    __device__ __forceinline__ void operator()(const f32x4 (&acc)[2][2][4][2], const Unit& u, int wr, int wc, int fr, int fq) const {
        const int pn = u.pn; float* base = PART + (size_t)u.ks * ::MS * ::DM;
        PG8_EPI_LOOP( st_f32x8(base + (size_t)(row - ::MP) * ::DM + pn * BM + cl, v0, v1); )
    }
};
struct SplitOrder {
    int G, c;
    __device__ __forceinline__ bool next(int i, Unit& u) const { const int L = i * G + c; if (L >= 256) return false; u.pm = 64 + (L & 3); u.pn = (L >> 2) & 7; u.ks = L >> 5; return true; }
    __device__ __forceinline__ void a_ready(const Unit&) const {}
    __device__ __forceinline__ void done(const Unit&) const {}
};
struct EpiSqRelu {
    static constexpr bool PERM = true, AFTER_DRAIN = false;
    bf16_t* H;
    __device__ __forceinline__ void operator()(const f32x4 (&acc)[2][2][4][2], const Unit& u, int wr, int wc, int fr, int fq) const {
        const int pn = u.pn;
        PG8_EPI_LOOP(
            f32x4 a = __builtin_elementwise_max(v0, (f32x4){0.f, 0.f, 0.f, 0.f}), b = __builtin_elementwise_max(v1, (f32x4){0.f, 0.f, 0.f, 0.f});
            st_bf16x8(H + (size_t)row * ::DFF + pn * BM + cl, a * a, b * b);
        )
    }
};
struct EpiStoreF32 {
    static constexpr bool PERM = true, AFTER_DRAIN = false;
    float* C;
    __device__ __forceinline__ void operator()(const f32x4 (&acc)[2][2][4][2], const Unit& u, int wr, int wc, int fr, int fq) const {
        const int pn = u.pn;
        PG8_EPI_LOOP( st_f32x8(C + (size_t)row * ::DM + pn * BM + cl, v0, v1); )
    }
};
struct EpiGate {
    static constexpr bool PERM = true, AFTER_DRAIN = false;
    const float* X2; const float* PW; float* Y; bf16_t* YB;
    __device__ __forceinline__ f32x4 sig(const f32x4& v) const { f32x4 r;
#pragma unroll
        for (int i = 0; i < 4; ++i) r[i] = __builtin_amdgcn_rcpf(1.0f + __expf(-v[i])); return r; }
    __device__ __forceinline__ void operator()(const f32x4 (&acc)[2][2][4][2], const Unit& u, int wr, int wc, int fr, int fq) const {
        const int pn = u.pn;
        PG8_EPI_LOOP_F(
            const size_t off = (size_t)row * ::DM + pn * BM + cl;
            const f32x4 y0 = *(const f32x4*)(X2 + off) + sig(v0) * *(const f32x4*)(PW + off), y1 = *(const f32x4*)(X2 + off + 4) + sig(v1) * *(const f32x4*)(PW + off + 4);
            st_f32x8(Y + off, y0, y1); if (YB) st_bf16x8(YB + off, y0, y1);
        )
    }
};
template <class Epi, class Sched, bool ALIGN_EPI = false, bool SP2 = false>
__device__ __forceinline__ void gemm_phase(PG8_LAS unsigned char* lds, const Gemm g, const Sched& S, const Epi& E) {
    const int tid = threadIdx.x, wid = __builtin_amdgcn_readfirstlane(tid >> 6), lane = tid & 63, wr = wid >> 2, wc = wid & 3, fr = lane & 15, fq = lane >> 4;
    const int K = g.ld, nt = g.K / BK;
    const size_t kslice = (size_t)g.K * 2;
    unsigned voffA[2], voffB[2];
#pragma unroll
    for (int i = 0; i < 2; ++i) { int R, C; stage_rc(tid * 16 + i * 8192, R, C); const int Rb = Epi::PERM ? ((R & ~31) + perm32(R & 31)) : R;
        voffA[i] = (unsigned)(R * K + C) * 2u; voffB[i] = (unsigned)(Rb * K + C) * 2u; }
    const size_t kstep = (size_t)(BK * 2);
    const size_t hstep = (size_t)HALF * K * 2;
    const size_t tstep = 2 * hstep;
    const unsigned ldsw = (unsigned)wid * 1024u;
    const int aoff = lds_byte(wr * 64 + fr, fq * 8), boff = lds_byte(wc * 32 + fr, fq * 8);
#define PG8_SA(b, h) (((b) * 2 + (h)) * HTB)
#define PG8_SB(b, h) ((4 + (b) * 2 + (h)) * HTB)
#define PG8_STAGE(bufoff, gbase, voff) do { _Pragma("unroll") for (int _i = 0; _i < 2; ++_i) \
        __builtin_amdgcn_global_load_lds((const unsigned*)((const char*)(gbase) + (voff)[_i]), (PG8_LAS unsigned*)(lds + (bufoff) + ldsw + _i * 8192), 16, 0, 0); } while (0)
#define PG8_LDA(dst, b, h) do { _Pragma("unroll") for (int m = 0; m < 4; ++m) _Pragma("unroll") for (int k = 0; k < 2; ++k) dst[m][k] = *(const PG8_LAS bf16x8*)(lds + PG8_SA(b, h) + aoff + m * 2048 + k * 1024); } while (0)
#define PG8_LDB(dst, b, h) do { _Pragma("unroll") for (int n = 0; n < 2; ++n) _Pragma("unroll") for (int k = 0; k < 2; ++k) dst[n][k] = *(const PG8_LAS bf16x8*)(lds + PG8_SB(b, h) + boff + n * 2048 + k * 1024); } while (0)
#define PG8_MMA(ai, bj, At, Bt) do { __builtin_amdgcn_s_setprio(1); _Pragma("unroll") for (int m = 0; m < 4; ++m) _Pragma("unroll") for (int n = 0; n < 2; ++n) _Pragma("unroll") for (int k = 0; k < 2; ++k) \
        acc[ai][bj][m][n] = __builtin_amdgcn_mfma_f32_16x16x32_bf16(Bt[n][k], At[m][k], acc[ai][bj][m][n], 0, 0, 0); __builtin_amdgcn_s_setprio(0); } while (0)
#define PG8_WAIT_V(n) asm volatile("s_waitcnt vmcnt(" #n ")" ::: "memory")
#define PG8_WAIT_L(n) asm volatile("s_waitcnt lgkmcnt(" #n ")" ::: "memory")
#define PG8_BAR __builtin_amdgcn_s_barrier()
#define PG8_SCHED __builtin_amdgcn_sched_barrier(0)
    Unit cur, nxt; int ui = 0;
    if (!S.next(0, cur)) return;
    f32x4 acc[2][2][4][2];
#pragma unroll
    for (int a = 0; a < 2; ++a)
#pragma unroll
        for (int b = 0; b < 2; ++b)
#pragma unroll
            for (int m = 0; m < 4; ++m)
#pragma unroll
                for (int n = 0; n < 2; ++n) acc[a][b][m][n] = (f32x4){0.f, 0.f, 0.f, 0.f};
    bf16x8 At[4][2], B0[2][2], B1[2][2];
    const char* cA = (const char*)g.A + (size_t)cur.pm * tstep + cur.ks * kslice; const char* cB = (const char*)g.Bt + (size_t)cur.pn * tstep + cur.ks * kslice;
    S.a_ready(cur);
    if constexpr (SP2) {
        PG8_STAGE(PG8_SB(0, 0), cB, voffB); PG8_STAGE(PG8_SB(0, 1), cB + hstep, voffB); PG8_STAGE(PG8_SA(0, 0), cA, voffA); PG8_STAGE(PG8_SA(0, 1), cA + hstep, voffA);
        if (wr == 1) PG8_BAR;
        PG8_WAIT_V(2); PG8_BAR;
        PG8_STAGE(PG8_SB(1, 0), cB + kstep, voffB); PG8_STAGE(PG8_SA(1, 0), cA + kstep, voffA); PG8_STAGE(PG8_SB(1, 1), cB + hstep + kstep, voffB);
        PG8_WAIT_V(6); PG8_BAR;
    } else {
        PG8_STAGE(PG8_SB(0, 0), cB, voffB); PG8_STAGE(PG8_SA(0, 0), cA, voffA); PG8_STAGE(PG8_SB(0, 1), cB + hstep, voffB); PG8_STAGE(PG8_SA(0, 1), cA + hstep, voffA);
        if (wr == 1) PG8_BAR;
        PG8_WAIT_V(4); PG8_BAR;
        PG8_STAGE(PG8_SB(1, 0), cB + kstep, voffB); PG8_STAGE(PG8_SA(1, 0), cA + kstep, voffA); PG8_STAGE(PG8_SB(1, 1), cB + hstep + kstep, voffB);
        PG8_WAIT_V(6); PG8_BAR;
    }
    for (;;) {
        const bool has_next = S.next(ui + 1, nxt);
        const char* nA = has_next ? (const char*)g.A + (size_t)nxt.pm * tstep + nxt.ks * kslice : cA; const char* nB = has_next ? (const char*)g.Bt + (size_t)nxt.pn * tstep + nxt.ks * kslice : cB;
        for (int t = 0; t < nt; t += 2) {
            const bool last = (t == nt - 2);
            const char* a1 = cA + (size_t)(t + 1) * kstep;
            const char* a2 = last ? nA : cA + (size_t)(t + 2) * kstep; const char* b2 = last ? nB : cB + (size_t)(t + 2) * kstep;
            const char* a3 = a2 + kstep; const char* b3 = b2 + kstep;
            if (last && has_next) S.a_ready(nxt);
            if constexpr (SP2) {
            PG8_LDB(B0, 0, 0); PG8_LDB(B1, 0, 1); PG8_SCHED; PG8_LDA(At, 0, 0); PG8_STAGE(PG8_SA(1, 1), a1 + hstep, voffA);
            PG8_WAIT_V(8); PG8_WAIT_L(0); PG8_BAR; PG8_MMA(0, 0, At, B0); PG8_MMA(0, 1, At, B1); PG8_BAR; PG8_SCHED;
            PG8_LDA(At, 0, 1); PG8_STAGE(PG8_SB(0, 0), b2, voffB); PG8_STAGE(PG8_SB(0, 1), b2 + hstep, voffB); PG8_STAGE(PG8_SA(0, 0), a2, voffA);
            PG8_WAIT_V(8); PG8_WAIT_L(0); PG8_BAR; PG8_MMA(1, 0, At, B0); PG8_MMA(1, 1, At, B1); PG8_BAR; PG8_SCHED;
            PG8_LDB(B0, 1, 0); PG8_LDB(B1, 1, 1); PG8_SCHED; PG8_LDA(At, 1, 0); PG8_STAGE(PG8_SA(0, 1), a2 + hstep, voffA);
            PG8_WAIT_V(8); PG8_WAIT_L(0); PG8_BAR; PG8_MMA(0, 0, At, B0); PG8_MMA(0, 1, At, B1); PG8_BAR; PG8_SCHED;
            PG8_LDA(At, 1, 1); PG8_STAGE(PG8_SB(1, 0), b3, voffB); PG8_STAGE(PG8_SB(1, 1), b3 + hstep, voffB); PG8_STAGE(PG8_SA(1, 0), a3, voffA);
            PG8_WAIT_V(8); PG8_WAIT_L(0); PG8_BAR; PG8_MMA(1, 0, At, B0); PG8_MMA(1, 1, At, B1); PG8_BAR; PG8_SCHED;
            } else {
            PG8_LDB(B0, 0, 0); PG8_SCHED; PG8_LDA(At, 0, 0); PG8_STAGE(PG8_SA(1, 1), a1 + hstep, voffA);
            PG8_WAIT_L(8); PG8_BAR; PG8_WAIT_L(0); PG8_MMA(0, 0, At, B0); PG8_BAR; PG8_SCHED;
            PG8_LDB(B1, 0, 1); PG8_STAGE(PG8_SB(0, 0), b2, voffB);
            PG8_BAR; PG8_WAIT_L(0); PG8_MMA(0, 1, At, B1); PG8_BAR;
            PG8_LDA(At, 0, 1); PG8_STAGE(PG8_SA(0, 0), a2, voffA);
            PG8_BAR; PG8_WAIT_L(0); PG8_MMA(1, 0, At, B0); PG8_BAR; PG8_SCHED;
            PG8_STAGE(PG8_SB(0, 1), b2 + hstep, voffB);
            PG8_WAIT_V(6); PG8_BAR; PG8_MMA(1, 1, At, B1); PG8_BAR;
            PG8_LDB(B0, 1, 0); PG8_SCHED; PG8_LDA(At, 1, 0); PG8_STAGE(PG8_SA(0, 1), a2 + hstep, voffA);
            PG8_WAIT_L(8); PG8_BAR; PG8_WAIT_L(0); PG8_MMA(0, 0, At, B0); PG8_BAR; PG8_SCHED;
            PG8_LDB(B1, 1, 1); PG8_STAGE(PG8_SB(1, 0), b3, voffB);
            PG8_BAR; PG8_WAIT_L(0); PG8_MMA(0, 1, At, B1); PG8_BAR;
            PG8_LDA(At, 1, 1); PG8_STAGE(PG8_SA(1, 0), a3, voffA);
            PG8_BAR; PG8_WAIT_L(0); PG8_MMA(1, 0, At, B0); PG8_BAR; PG8_SCHED;
            PG8_STAGE(PG8_SB(1, 1), b3 + hstep, voffB);
            PG8_WAIT_V(6); PG8_BAR; PG8_MMA(1, 1, At, B1); PG8_BAR;
            }
        }
        if constexpr (ALIGN_EPI) { if (wr == 0) PG8_BAR; }
        if constexpr (!Epi::AFTER_DRAIN) { E(acc, cur, wr, wc, fr, fq); S.done(cur); }
        if (!has_next) break;
#pragma unroll
        for (int a = 0; a < 2; ++a)
#pragma unroll
            for (int b = 0; b < 2; ++b)
#pragma unroll
                for (int m = 0; m < 4; ++m)
#pragma unroll
                    for (int n = 0; n < 2; ++n) acc[a][b][m][n] = (f32x4){0.f, 0.f, 0.f, 0.f};
        cur = nxt; cA = nA; cB = nB; ++ui;
        if constexpr (ALIGN_EPI) { if (wr == 1) PG8_BAR; }
    }
    PG8_WAIT_V(0);
    if constexpr (!ALIGN_EPI) { if (wr == 0) PG8_BAR; }
    PG8_BAR;
    if constexpr (Epi::AFTER_DRAIN) { E.fused(acc, cur, wr, wc, fr, fq, lds, wid, lane); S.done(cur); }
#undef PG8_SA
#undef PG8_SB
#undef PG8_STAGE
#undef PG8_LDA
#undef PG8_LDB
#undef PG8_MMA
#undef PG8_WAIT_V
#undef PG8_WAIT_L
#undef PG8_BAR
#undef PG8_SCHED
}
}
#define XB_TMO      128
#define XB_XCNT(j)  (256  + 64 * (j))
#define XB_XSUB(j)  (1280 + 64 * (j))
#define XB_XGEN(j)  (2304 + 64 * (j))
#define XB_TOP      3328
#define XB_TOPGEN   3392
#define XCD_BAR_WORDS 3456
#define XB_SPIN_CAP (1u << 18)

__device__ __forceinline__ unsigned xb_ld(unsigned* p)              { return __hip_atomic_load(p, __ATOMIC_RELAXED, __HIP_MEMORY_SCOPE_AGENT); }
__device__ __forceinline__ unsigned xb_add(unsigned* p, unsigned v) { return __hip_atomic_fetch_add(p, v, __ATOMIC_RELAXED, __HIP_MEMORY_SCOPE_AGENT); }
__device__ __forceinline__ unsigned xb_xcc_id() { return (unsigned)__builtin_amdgcn_s_getreg((3 << 11) | 20) & 0xFu; }
#define XB_SPIN(cond, bar) do { unsigned _sp = 0; while (cond) { __builtin_amdgcn_s_sleep(1); \
    if ((++_sp & 255u) == 0u) { if (xb_ld(&(bar)[XB_TMO])) break; if (_sp > XB_SPIN_CAP) { atomicAdd(&(bar)[XB_TMO], 1u); break; } } } } while (0)

struct XcdBarrier {
    unsigned* bar; unsigned x;
    volatile LAS unsigned* st;
};

__device__ __forceinline__ XcdBarrier xcd_barrier_post(unsigned* bar, volatile LAS unsigned* st) {
    XcdBarrier b; b.bar = bar; b.x = xb_xcc_id(); b.st = st;
    if (threadIdx.x == 0) (void)xb_add(&bar[XB_XCNT(b.x)], 1u);
    return b;
}
__device__ __forceinline__ void xcd_barrier_complete(unsigned* bar, unsigned x, unsigned& nloc, unsigned& nx) {
    const unsigned G = gridDim.x * gridDim.y * gridDim.z;
    unsigned sum, cnt, mine, sp = 0u;
    for (;;) {
        sum = 0u; cnt = 0u; mine = 0u;
#pragma unroll
        for (unsigned j = 0; j < 16; ++j) { const unsigned c = xb_ld(&bar[XB_XCNT(j)]); sum += c; cnt += (c > 0u) ? 1u : 0u; mine = (j == x) ? c : mine; }
        if (sum == G) break;
        __builtin_amdgcn_s_sleep(1);
        if ((++sp & 255u) == 0u) { if (xb_ld(&bar[XB_TMO])) break; if (sp > XB_SPIN_CAP) { atomicAdd(&bar[XB_TMO], 1u); break; } }
    }
    nloc = mine > 0u ? mine : 1u; nx = cnt > 0u ? cnt : 1u;
}

__device__ __forceinline__ void xcd_barrier(const XcdBarrier& b) {
    asm volatile("s_waitcnt vmcnt(0)" ::: "memory");
    __syncthreads();
    if (threadIdx.x == 0) {
        unsigned* bar = b.bar;
        __builtin_amdgcn_s_waitcnt(0);
        unsigned nloc = b.st[0], nx = b.st[1];
        if (nloc == 0u) { xcd_barrier_complete(bar, b.x, nloc, nx); b.st[0] = nloc; b.st[1] = nx; }
        const unsigned old = xb_add(&bar[XB_XSUB(b.x)], 1u);
        const unsigned gen = old / nloc;
        if (old + 1u == (gen + 1u) * nloc) {
            __builtin_amdgcn_fence(__ATOMIC_RELEASE, "agent");
            asm volatile("s_waitcnt vmcnt(0)" ::: "memory");
            const unsigned og = xb_add(&bar[XB_TOP], 1u);
            const unsigned tg = og / nx;
            if (og + 1u == (tg + 1u) * nx) xb_add(&bar[XB_TOPGEN], 1u);
            else XB_SPIN(xb_ld(&bar[XB_TOPGEN]) == tg, bar);
            __builtin_amdgcn_fence(__ATOMIC_ACQUIRE, "agent");
            xb_add(&bar[XB_XGEN(b.x)], 1u);
            asm volatile("s_waitcnt vmcnt(0)" ::: "memory");
        } else {
            XB_SPIN(xb_ld(&bar[XB_XGEN(b.x)]) == gen, bar);
            __builtin_amdgcn_fence(__ATOMIC_ACQUIRE, "agent");
            asm volatile("s_waitcnt vmcnt(0)" ::: "memory");
        }
    }
    __syncthreads();
}
#ifndef MK_PROBE
#define MK_PROBE 0
#endif
#define NREP(bit) (((MK_PROBE >> (bit)) & 1) ? 2 : 1)
#define GEMM2X(call) do { call; if (NREP(0) > 1) { call; } } while (0)
#define NREP2(b1, b2) ((((MK_PROBE >> (b1)) | (MK_PROBE >> (b2))) & 1) ? 2 : 1)
#ifndef MK_GATE_PART
#define MK_GATE_PART 3
#endif
typedef GAS unsigned gu32;
#define RLX_AGENT __ATOMIC_RELAXED, __HIP_MEMORY_SCOPE_AGENT
#define MFMA32(a, b, c) __builtin_amdgcn_mfma_f32_32x32x16_bf16((a), (b), (c), 0, 0, 0)

struct Ctx { LAS unsigned char* lds; volatile LAS unsigned* MISC; int tid, lane, wave, G, bx, gw, NGW; };
__device__ __forceinline__ int crow(int r, int hi) { return (r & 3) + 8 * (r >> 2) + 4 * hi; }

constexpr int TR_PITCH = 132;
__device__ __forceinline__ void p0_transpose_item(const float* W, int K, int N, int NP, bf16* WT, LAS unsigned char* scr, int item, int lane) {
    const int nblk = NP / 64, kb = item / nblk, nb = item % nblk, k0 = 64 * kb, n0 = 64 * nb;
    const int kp = lane >> 4, n4 = lane & 15; const bool inn = n0 + 4 * n4 < N;
    f32x4 va[8], vb[8];
    const float* src = W + (size_t)(k0 + 2 * kp) * N + n0 + 4 * n4;
#pragma unroll
    for (int i = 0; i < 8; ++i) { va[i] = inn ? *(const f32x4*)(src + (size_t)(8 * i) * N) : (f32x4){0.f, 0.f, 0.f, 0.f}; vb[i] = inn ? *(const f32x4*)(src + (size_t)(8 * i + 1) * N) : (f32x4){0.f, 0.f, 0.f, 0.f}; }
#pragma unroll
    for (int i = 0; i < 8; ++i)
#pragma unroll
        for (int e = 0; e < 4; ++e) *(LAS unsigned*)(scr + (4 * n4 + e) * TR_PITCH + (8 * i + 2 * kp) * 2) = pk2(va[i][e], vb[i][e]);
    LDS_WAIT();
    const int nr = lane >> 3, c = lane & 7;
#pragma unroll
    for (int j = 0; j < 8; ++j) { const int n = 8 * j + nr; const LAS unsigned* s = (const LAS unsigned*)(scr + n * TR_PITCH + 16 * c);
        v4u o; o.x = s[0]; o.y = s[1]; o.z = s[2]; o.w = s[3];
        *(v4u*)(WT + (size_t)(n0 + n) * K + k0 + 8 * c) = o; }
    LDS_WAIT();
}
__device__ __forceinline__ void transpose_job(const Ctx& C, const float* W, int K, int N, int NP, bf16* WT) {
    LAS unsigned char* scr = C.lds + C.wave * 16384;
    const int nitems = (K / 64) * (NP / 64);
    for (int it = C.gw; it < nitems; it += C.NGW) p0_transpose_item(W, K, N, NP, WT, scr, it, C.lane);
}
__device__ __forceinline__ void cvt_job(const Ctx& C, const float* src, bf16* dst, int nseg, int seglen, size_t sstride, size_t dstride) {
    const int vps = seglen / 8; const long total = (long)nseg * vps; const long NGT = (long)C.G * NTHREADS;
    for (long i0 = (long)C.bx * NTHREADS + C.tid; i0 < total; i0 += 4 * NGT) {
        f32x4 a[4], b[4]; size_t doff[4]; bool ok[4];
#pragma unroll
        for (int u = 0; u < 4; ++u) { const long i = i0 + u * NGT; ok[u] = i < total; const long ii = ok[u] ? i : i0; const int seg = (int)(ii / vps), off = (int)(ii % vps) * 8;
            a[u] = *(const f32x4*)(src + seg * sstride + off); b[u] = *(const f32x4*)(src + seg * sstride + off + 4); doff[u] = seg * dstride + off; }
#pragma unroll
        for (int u = 0; u < 4; ++u) if (ok[u]) { v4u o; o.x = pk2(a[u].x, a[u].y); o.y = pk2(a[u].z, a[u].w); o.z = pk2(b[u].x, b[u].y); o.w = pk2(b[u].z, b[u].w); *(v4u*)(dst + doff[u]) = o; }
    }
}

__device__ __forceinline__ float wave_sum(float v) {
#pragma unroll
    for (int o = 1; o < 64; o <<= 1) v += __shfl_xor(v, o);
    return v;
}
__device__ __forceinline__ void ln_phase(const Ctx& C, float* RES, bf16* XO, const float* g, const float* b, const float* xs, const float* PART) {
    for (int row = C.gw; row < MT; row += C.NGW) {
        f32x4* xr = (f32x4*)(RES + (size_t)row * DM) + C.lane;
        f32x4 v[8]; float s = 0.f;
        if (row < MP) {
#pragma unroll
            for (int j = 0; j < 8; ++j) v[j] = xr[64 * j];
        } else {
            const f32x4* xp = (const f32x4*)(xs + (size_t)row * DM) + C.lane;
#pragma unroll
            for (int j = 0; j < 8; ++j) v[j] = xp[64 * j] * ALPHA;
#pragma unroll 2
            for (int ks = 0; ks < 8; ++ks) { const f32x4* pp = (const f32x4*)(PART + ((size_t)ks * MS + (row - MP)) * DM) + C.lane;
#pragma unroll
                for (int j = 0; j < 8; ++j) v[j] += pp[64 * j]; }
        }
#pragma unroll
        for (int j = 0; j < 8; ++j) s += (v[j].x + v[j].y) + (v[j].z + v[j].w);
        const float mean = wave_sum(s) * (1.f / DM); float s2 = 0.f;
#pragma unroll
        for (int j = 0; j < 8; ++j) { v[j] = v[j] - mean; s2 += (v[j].x * v[j].x + v[j].y * v[j].y) + (v[j].z * v[j].z + v[j].w * v[j].w); }
        const float rstd = 1.f / sqrtf(wave_sum(s2) * (1.f / DM) + LN_EPS);
        v2u* o8 = (v2u*)(XO + (size_t)row * DM) + C.lane;
#pragma unroll
        for (int j = 0; j < 8; ++j) { const f32x4 gg = ((const f32x4*)g)[C.lane + 64 * j], bb = ((const f32x4*)b)[C.lane + 64 * j]; const f32x4 y = v[j] * rstd * gg + bb;
            xr[64 * j] = y; v2u w; w.x = pk2(y.x, y.y); w.y = pk2(y.z, y.w); o8[64 * j] = w; }
    }
}

constexpr int SC_QPITCH = 4112, SC_NITEMS = 160 + 2304;
__device__ __forceinline__ void scores_phase(const Ctx& C, unsigned* qhead, const bf16* QIB, const bf16* KIP, const bf16* KIS, const float* WI, float* SCP, float* SCS) {
    const int q = C.lane & 31, hh = C.lane >> 5;
    for (;;) {
        if (C.tid == 0) C.MISC[0] = __hip_atomic_fetch_add(qhead, 1u, RLX_AGENT);
        __syncthreads();
        int id = (int)C.MISC[0];
        __syncthreads();
        if (id >= SC_NITEMS) break;
        int row0, nk, ch, stride; const bf16* KI; float* SC;
        if (id < 160) { const int qt = id / 5; ch = id % 5; const int rs0 = qt * 32, b = rs0 >> 6; row0 = MP + rs0; KI = KIS + (size_t)b * SALL * HD; nk = SALL; SC = SCS + (size_t)rs0 * SALL; stride = SALL; }
        else { id -= 160; int k = 7; while (id >= 64 * (k + 1)) { id -= 64 * (k + 1); --k; }
            const int per = 4 * (k + 1), ci = id / per, rem = id % per, c = 16 * k + 15 - ci, tile4 = rem / (k + 1); ch = rem % (k + 1);
            const int b = tile4 >> 1, t0 = c * 64 + (tile4 & 1) * 32; row0 = b * SEQ + t0; KI = KIP + (size_t)b * SEQ * HD; nk = 64 * (c + 1); SC = SCP + (size_t)row0 * SEQ; stride = SEQ; }
        const int s_begin = ch * 1024, nkc = (nk - s_begin) < 1024 ? (nk - s_begin) : 1024, ntiles = nkc >> 5;
#pragma unroll 4
        for (int i = 0; i < 16; ++i) { const int p = C.tid + NTHREADS * i, qq = p >> 8, off = (p & 255) * 16;
            const v4u v = *(const v4u*)((const char*)QIB + (size_t)(row0 + qq) * (DM * 2) + off); *(LAS v4u*)(C.lds + qq * SC_QPITCH + off) = v; }
        LAS float* wl = (LAS float*)(C.lds + 32 * SC_QPITCH);
        { const int qq = C.tid >> 4, h2 = C.tid & 15; wl[qq * 17 + h2] = WI[(size_t)(row0 + qq) * 16 + h2]; }
        __syncthreads();
        const LAS unsigned char* qb = C.lds + q * SC_QPITCH + hh * 16;
        for (int ti = C.wave; ti < ntiles; ti += NWAVES) {
            const int s0 = s_begin + ti * 32;
            const bf16* kp = KI + (size_t)(s0 + q) * HD + 8 * hh;
            bf16x8 kf[8];
#pragma unroll
            for (int kk = 0; kk < 8; ++kk) kf[kk] = *(const bf16x8*)(kp + 16 * kk);
            f32x16 acc;
#pragma unroll
            for (int r = 0; r < 16; ++r) acc[r] = 0.f;
#pragma unroll 2
            for (int h = 0; h < 16; ++h) {
                f32x16 c; const float wh = wl[q * 17 + h];
#pragma unroll
                for (int r = 0; r < 16; ++r) c[r] = 0.f;
#pragma unroll
                for (int kk = 0; kk < 8; ++kk) { const bf16x8 bq = *(const LAS bf16x8*)(qb + h * 256 + kk * 32); c = MFMA32(kf[kk], bq, c); }
#pragma unroll
                for (int r = 0; r < 16; ++r) acc[r] += wh * __builtin_fmaxf(c[r], 0.f);
            }
            float* sp = SC + (size_t)q * stride + s0 + 4 * hh;
#pragma unroll
            for (int g = 0; g < 4; ++g) *(f32x4*)(sp + 8 * g) = (f32x4){acc[4 * g], acc[4 * g + 1], acc[4 * g + 2], acc[4 * g + 3]};
        }
        __syncthreads();
    }
}

__device__ __forceinline__ unsigned tokey(float f) { const unsigned u = __float_as_uint(f); return (u & 0x80000000u) ? ~u : (u | 0x80000000u); }
__device__ __forceinline__ void select_phase(const Ctx& C, const float* SCP, const float* SCS, int* IDX, int* CNT) {
    LAS unsigned* hist = (LAS unsigned*)(C.lds + C.wave * 1024);
    const int lane = C.lane; const unsigned long long ltm = (1ull << lane) - 1ull;
    for (int row = C.gw; row < MT; row += C.NGW) {
        int n; const float* sc;
        if (row < MP) { const int t = row & (SEQ - 1); n = 64 * ((t >> 6) + 1); sc = SCP + (size_t)row * SEQ; } else { n = SALL; sc = SCS + (size_t)(row - MP) * SALL; }
        int* ip = IDX + (size_t)row * TOPK;
        if (n <= TOPK) {
#pragma unroll
            for (int k = 0; k < 4; ++k) { const int i = lane + 64 * k; ip[i] = (i < n) ? i : 0; }
            if (lane == 0) CNT[row] = n;
            continue;
        }
        v4u kreg[32];
#pragma unroll
        for (int it = 0; it < 32; ++it) { kreg[it] = (v4u){0u, 0u, 0u, 0u};
            if ((it >> 2) * 1024 < n) { if (it * 256 + lane * 4 < n) { const f32x4 v = *(const f32x4*)(sc + it * 256 + lane * 4); kreg[it] = (v4u){tokey(v.x), tokey(v.y), tokey(v.z), tokey(v.w)}; } } }
        unsigned prefix = 0u, mask = 0u, krem = TOPK;
        for (int pass = 0; pass < 4; ++pass) {
            const int shift = 24 - 8 * pass;
            *(LAS v4u*)(hist + 4 * lane) = (v4u){0u, 0u, 0u, 0u};
            LDS_WAIT();
#pragma unroll
            for (int it = 0; it < 32; ++it) if ((it >> 2) * 1024 < n) {
#pragma unroll
                for (int e = 0; e < 4; ++e) { const unsigned key = kreg[it][e]; if ((key & mask) == prefix) __hip_atomic_fetch_add(hist + ((key >> shift) & 255u), 1u, __ATOMIC_RELAXED, __HIP_MEMORY_SCOPE_WORKGROUP); } }
            LDS_WAIT();
            const v4u hc = *(const LAS v4u*)(hist + 4 * lane);
            const unsigned tot = hc.x + hc.y + hc.z + hc.w; unsigned x = tot;
#pragma unroll
            for (int o = 1; o < 64; o <<= 1) { const unsigned y = __shfl_down(x, o); if (lane + o < 64) x += y; }
            const unsigned a3 = x - tot, a2 = a3 + hc.w, a1 = a2 + hc.z, a0 = a1 + hc.y;
            int fe = -1; unsigned fa = 0u;
            if (a3 < krem && krem <= a3 + hc.w) { fe = 3; fa = a3; } else if (a2 < krem && krem <= a2 + hc.z) { fe = 2; fa = a2; }
            else if (a1 < krem && krem <= a1 + hc.y) { fe = 1; fa = a1; } else if (a0 < krem && krem <= a0 + hc.x) { fe = 0; fa = a0; }
            const unsigned long long bal = __ballot(fe >= 0); const int src = bal ? (__ffsll((long long)bal) - 1) : 0;
            const unsigned d = (unsigned)__shfl(4 * lane + fe, src), above = (unsigned)__shfl((int)fa, src);
            krem -= above; prefix |= d << shift; mask |= 0xffu << shift;
        }
        int outc = 0, eqs = 0;
#pragma unroll
        for (int it = 0; it < 32; ++it) if ((it >> 2) * 1024 < n) {
            bool eq[4], sel[4];
#pragma unroll
            for (int e = 0; e < 4; ++e) { eq[e] = kreg[it][e] == prefix; sel[e] = kreg[it][e] > prefix; }
            const unsigned long long anyeq = __ballot(eq[0] || eq[1] || eq[2] || eq[3]);
            if (anyeq) {
                const int mine = (int)eq[0] + (int)eq[1] + (int)eq[2] + (int)eq[3];
                int below = 0, total = 0;
#pragma unroll
                for (int e = 0; e < 4; ++e) { const unsigned long long bb = __ballot(eq[e]); below += __popcll(bb & ltm); total += __popcll(bb); }
                int r = eqs + below;
#pragma unroll
                for (int e = 0; e < 4; ++e) { if (eq[e]) { if ((unsigned)r < krem) sel[e] = true; ++r; } }
                eqs += total; (void)mine;
            }
#pragma unroll
            for (int e = 0; e < 4; ++e) { const unsigned long long sb = __ballot(sel[e]); const int pos = outc + __popcll(sb & ltm); if (sel[e] && pos < TOPK) ip[pos] = it * 256 + lane * 4 + e; outc += __popcll(sb); }
        }
        if (lane == 0) CNT[row] = outc < TOPK ? outc : TOPK;
    }
}

__device__ __forceinline__ int t5_bucket(int n  ) {
    const int ret = (n < 0) ? 16 : 0; n = n < 0 ? -n : n;
    if (n < 8) return ret + n;
    const int lg = 31 - __builtin_clz((unsigned)(n * n));
    const int large = 2 + lg; return ret + (large < 15 ? large : 15);
}
__device__ __forceinline__ float dpp_quad_sum(float t) {
    t += __builtin_bit_cast(float, __builtin_amdgcn_mov_dpp(__builtin_bit_cast(int, t), 0xB1, 0xF, 0xF, true));
    t += __builtin_bit_cast(float, __builtin_amdgcn_mov_dpp(__builtin_bit_cast(int, t), 0x4E, 0xF, 0xF, true));
    return t;
}
__device__ __forceinline__ void sattn_task(int row, int g, int qpos, const bf16* Kb, const bf16* Vb, int cnt, const int* ip, const bf16* QB, bf16* OB,
                                           LAS int* idxl, LAS float* lg, const LAS float* biasl, int lane) {
#pragma unroll
    for (int k = 0; k < 4; ++k) { const int j = lane + 64 * k; const int v = ip[j]; idxl[j] = (j < cnt) ? v : 0; }
    const int kq = lane >> 2, c4 = lane & 3;
    unsigned qreg[4][16];
    { const bf16* qp = QB + (size_t)row * DM + (4 * g) * HD + 32 * c4;
#pragma unroll
      for (int hq = 0; hq < 4; ++hq)
#pragma unroll
          for (int i = 0; i < 4; ++i) { const v4u a = *(const v4u*)(qp + hq * HD + 8 * i); qreg[hq][4 * i] = a.x; qreg[hq][4 * i + 1] = a.y; qreg[hq][4 * i + 2] = a.z; qreg[hq][4 * i + 3] = a.w; } }
    LDS_WAIT();
    for (int r0 = 0; r0 < 16; r0 += 2) {
        v4u kd[2][4];
#pragma unroll
        for (int rr = 0; rr < 2; ++rr) { const int key = idxl[16 * (r0 + rr) + kq]; const bf16* kp = Kb + (size_t)key * KVW + 32 * c4;
#pragma unroll
            for (int i = 0; i < 4; ++i) kd[rr][i] = *(const v4u*)(kp + 8 * i); }
#pragma unroll
        for (int rr = 0; rr < 2; ++rr) { float s[4];
#pragma unroll
            for (int hq = 0; hq < 4; ++hq) { float t = 0.f;
#pragma unroll
                for (int i = 0; i < 4; ++i) { t = dot2bf(kd[rr][i].x, qreg[hq][4 * i], t); t = dot2bf(kd[rr][i].y, qreg[hq][4 * i + 1], t); t = dot2bf(kd[rr][i].z, qreg[hq][4 * i + 2], t); t = dot2bf(kd[rr][i].w, qreg[hq][4 * i + 3], t); }
                s[hq] = dpp_quad_sum(t); }
            const float sv = c4 == 0 ? s[0] : c4 == 1 ? s[1] : c4 == 2 ? s[2] : s[3];
            lg[(16 * (r0 + rr) + kq) * 4 + c4] = sv; }
    }
    LDS_WAIT();
    float l[4][4];
#pragma unroll
    for (int k = 0; k < 4; ++k) { const int j = lane + 64 * k; const f32x4 l4 = *(const LAS f32x4*)(lg + 4 * j); const int key = idxl[j]; const int bk = t5_bucket(qpos - key);
        const f32x4 b4 = *(const LAS f32x4*)(biasl + bk * 16 + 4 * g); const bool valid = j < cnt;
#pragma unroll
        for (int hq = 0; hq < 4; ++hq) l[k][hq] = valid ? l4[hq] * QK_SCALE + b4[hq] : -INFINITY; }
    LDS_WAIT();
#pragma unroll
    for (int hq = 0; hq < 4; ++hq) { float m = __builtin_fmaxf(__builtin_fmaxf(l[0][hq], l[1][hq]), __builtin_fmaxf(l[2][hq], l[3][hq]));
#pragma unroll
        for (int o = 1; o < 64; o <<= 1) m = __builtin_fmaxf(m, __shfl_xor(m, o));
        float sum = 0.f;
#pragma unroll
        for (int k = 0; k < 4; ++k) { l[k][hq] = __expf(l[k][hq] - m); sum += l[k][hq]; }
        sum = wave_sum(sum); const float inv = 1.0f / sum;
#pragma unroll
        for (int k = 0; k < 4; ++k) l[k][hq] *= inv; }
#pragma unroll
    for (int k = 0; k < 4; ++k) { const int j = lane + 64 * k; *(LAS f32x4*)(lg + 4 * j) = (f32x4){l[k][0], l[k][1], l[k][2], l[k][3]}; }
    LDS_WAIT();
    const int ks = lane >> 4, dc = lane & 15;
    f32x2 o[4][4];
#pragma unroll
    for (int hq = 0; hq < 4; ++hq)
#pragma unroll
        for (int i = 0; i < 4; ++i) o[hq][i] = (f32x2){0.f, 0.f};
    const bf16* vp = Vb + 8 * dc;
    for (int jb = 0; jb < TOPK; jb += 32) {
        v4u w[8]; f32x4 p4[8];
#pragma unroll
        for (int u = 0; u < 8; ++u) { const int j = jb + 4 * u + ks; const int key = idxl[j]; w[u] = *(const v4u*)(vp + (size_t)key * KVW); p4[u] = *(const LAS f32x4*)(lg + 4 * j); }
#pragma unroll
        for (int u = 0; u < 8; ++u) { const f32x2 v0 = (f32x2){bf_lo(w[u].x), bf_hi(w[u].x)}, v1 = (f32x2){bf_lo(w[u].y), bf_hi(w[u].y)}, v2 = (f32x2){bf_lo(w[u].z), bf_hi(w[u].z)}, v3 = (f32x2){bf_lo(w[u].w), bf_hi(w[u].w)};
#pragma unroll
            for (int hq = 0; hq < 4; ++hq) { const float ph = p4[u][hq]; o[hq][0] += ph * v0; o[hq][1] += ph * v1; o[hq][2] += ph * v2; o[hq][3] += ph * v3; } }
    }
    v4u st = (v4u){0u, 0u, 0u, 0u};
#pragma unroll
    for (int hq = 0; hq < 4; ++hq) { unsigned pk[4];
#pragma unroll
        for (int i = 0; i < 4; ++i) { float x = o[hq][i].x, y = o[hq][i].y; x += __shfl_xor(x, 16); x += __shfl_xor(x, 32); y += __shfl_xor(y, 16); y += __shfl_xor(y, 32); pk[i] = pk2(x, y); }
        if (ks == hq) st = (v4u){pk[0], pk[1], pk[2], pk[3]}; }
    *(v4u*)(OB + (size_t)row * DM + (4 * g + ks) * HD + 8 * dc) = st;
    LDS_WAIT();
}
__device__ __forceinline__ void sattn_phase(const Ctx& C, const float* rel_bias, const bf16* QB, const bf16* KAP, const bf16* VAP, const bf16* KAS, const bf16* VAS, const int* IDX, const int* CNT, bf16* OB) {
    LAS float* biasl = (LAS float*)C.lds;
    LAS int* idxl = (LAS int*)(C.lds + 2048 + C.wave * 5120); LAS float* lg = (LAS float*)(C.lds + 2048 + C.wave * 5120 + 1024);
    if (C.tid < 512) biasl[C.tid] = rel_bias[C.tid];
    __syncthreads();
    const int x8 = C.bx & 7, g = x8 & 3, par = x8 >> 2, wi = (C.bx >> 3) * NWAVES + C.wave, nw = (C.G >> 3) * NWAVES;
    for (int k = wi; k < SEQ + 512; k += nw) {
        if (k < SEQ) { const int row = par * SEQ + k;
            sattn_task(row, g, k, KAP + (size_t)par * SEQ * KVW + g * HD, VAP + (size_t)par * SEQ * KVW + g * HD, CNT[row], IDX + (size_t)row * TOPK, QB, OB, idxl, lg, biasl, C.lane); }
        else { const int j = k - SEQ, b = 2 * (j >> 6) + par, i = j & 63, row = MP + b * DECS + i;
            sattn_task(row, g, PAST + i, KAS + (size_t)b * SALL * KVW + g * HD, VAS + (size_t)b * SALL * KVW + g * HD, CNT[row], IDX + (size_t)row * TOPK, QB, OB, idxl, lg, biasl, C.lane); }
    }
}

constexpr int VT_PITCH = 320, SB_NTASK = 8192 + 512;
typedef short v4i16_t __attribute__((ext_vector_type(4)));
__device__ __forceinline__ bf16x8 pack8(const f32x4& a, const f32x4& b) { v4u w; w.x = pk2(a.x, a.y); w.y = pk2(a.z, a.w); w.z = pk2(b.x, b.y); w.w = pk2(b.z, b.w); return __builtin_bit_cast(bf16x8, w); }
__device__ __forceinline__ void sb_task(bool samp, int b, int h, int qpos0, int r0, const bf16* QB, const bf16* KBB, const bf16* VBB, const float* kcache, const float* vcache, bf16* OB, LAS unsigned char* vt, int lane) {
    const int q = lane & 31, hh = lane >> 5;
    bf16x8 qf[8];
    { const bf16* qp = QB + (size_t)(r0 + q) * DM + h * HD + 8 * hh;
#pragma unroll
      for (int kk = 0; kk < 8; ++kk) qf[kk] = *(const bf16x8*)(qp + 16 * kk); }
    f32x16 O[4];
#pragma unroll
    for (int db = 0; db < 4; ++db)
#pragma unroll
        for (int r = 0; r < 16; ++r) O[db][r] = 0.f;
    float R = 1.f; const int t = qpos0 + q;
    const int vkey = lane >> 1, vch0 = (lane & 1) * 8;
    const int rowbase = samp ? (MP + b * DECS - PAST) : b * SEQ;
    bf16x8 kf[8]; v4u vr[8]; bool have = false;
    for (int kt = qpos0 >> 5; kt >= 0; --kt) {
        const bool f32t = samp && (32 * kt < PAST);
        if (f32t) {
            const float* kl = kcache + ((size_t)(b * PAST + 32 * kt + q) * 16 + h) * HD + 8 * hh;
#pragma unroll
            for (int kk = 0; kk < 8; ++kk) { const f32x4 a = *(const f32x4*)(kl + 16 * kk), bq = *(const f32x4*)(kl + 16 * kk + 4); kf[kk] = pack8(a, bq); }
#pragma unroll
            for (int i = 0; i < 8; ++i) { const float* vl = vcache + ((size_t)(b * PAST + 32 * kt + vkey) * 16 + h) * HD + 8 * (vch0 + i); const f32x4 a = *(const f32x4*)vl, bq = *(const f32x4*)(vl + 4); vr[i] = __builtin_bit_cast(v4u, pack8(a, bq)); }
        } else if (!have) {
            const bf16* kl = KBB + (size_t)(rowbase + 32 * kt + q) * DM + h * HD + 8 * hh;
#pragma unroll
            for (int kk = 0; kk < 8; ++kk) kf[kk] = *(const bf16x8*)(kl + 16 * kk);
#pragma unroll
            for (int i = 0; i < 8; ++i) vr[i] = *(const v4u*)(VBB + (size_t)(rowbase + 32 * kt + vkey) * DM + h * HD + 8 * (vch0 + i));
        }
#pragma unroll
        for (int i = 0; i < 8; ++i) *(LAS v4u*)(vt + vkey * VT_PITCH + 16 * (vch0 + i)) = vr[i];
        f32x16 c;
#pragma unroll
        for (int r = 0; r < 16; ++r) c[r] = 0.f;
#pragma unroll
        for (int kk = 0; kk < 8; ++kk) c = MFMA32(kf[kk], qf[kk], c);
        have = false;
        if (kt > 0 && !(samp && (32 * (kt - 1) < PAST))) { have = true;
            const bf16* kl = KBB + (size_t)(rowbase + 32 * (kt - 1) + q) * DM + h * HD + 8 * hh;
#pragma unroll
            for (int kk = 0; kk < 8; ++kk) kf[kk] = *(const bf16x8*)(kl + 16 * kk);
#pragma unroll
            for (int i = 0; i < 8; ++i) vr[i] = *(const v4u*)(VBB + (size_t)(rowbase + 32 * (kt - 1) + vkey) * DM + h * HD + 8 * (vch0 + i));
        }
        float om[16], be[16];
#pragma unroll
        for (int r = 0; r < 16; ++r) { const int s = 32 * kt + crow(r, hh); const float z = c[r] * QK_SCALE; const float a = __expf(-__builtin_fabsf(z)); const float rr = __builtin_amdgcn_rcpf(1.0f + a), ar = a * rr;
            const bool m = s < t; const float beta = z > 0.f ? rr : ar, omb = z > 0.f ? ar : rr; om[r] = m ? omb : 1.f; be[r] = m ? beta : 0.f; }
        float pg[4], pp[4], tt[4];
#pragma unroll
        for (int gi = 0; gi < 4; ++gi) { pg[gi] = (om[4 * gi] * om[4 * gi + 1]) * (om[4 * gi + 2] * om[4 * gi + 3]); pp[gi] = __shfl_xor(pg[gi], 32); tt[gi] = pg[gi] * pp[gi]; }
        float SB[4]; SB[3] = 1.f; SB[2] = tt[3]; SB[1] = tt[3] * tt[2]; SB[0] = SB[1] * tt[1];
        float A[16];
#pragma unroll
        for (int gi = 0; gi < 4; ++gi) { const float s3 = R * SB[gi] * (hh == 0 ? pp[gi] : 1.f), s2 = s3 * om[4 * gi + 3], s1 = s2 * om[4 * gi + 2], s0 = s1 * om[4 * gi + 1];
            A[4 * gi + 3] = be[4 * gi + 3] * s3; A[4 * gi + 2] = be[4 * gi + 2] * s2; A[4 * gi + 1] = be[4 * gi + 1] * s1; A[4 * gi] = be[4 * gi] * s0; }
        R = R * (SB[0] * tt[0]);
        bf16x8 pf[2];
#pragma unroll
        for (int s = 0; s < 2; ++s) { v4u w; w.x = pk2(A[8 * s], A[8 * s + 1]); w.y = pk2(A[8 * s + 2], A[8 * s + 3]); w.z = pk2(A[8 * s + 4], A[8 * s + 5]); w.w = pk2(A[8 * s + 6], A[8 * s + 7]); pf[s] = __builtin_bit_cast(bf16x8, w); }
        { const int i16 = lane & 15, qq = i16 >> 2, pq = i16 & 3, blk = (lane >> 4) & 1;
          LAS unsigned char* vb0 = vt + (4 * hh + qq) * VT_PITCH + (16 * blk + 4 * pq) * 2;
#pragma unroll
          for (int db = 0; db < 4; ++db)
#pragma unroll
              for (int s = 0; s < 2; ++s) { LAS unsigned char* ap = vb0 + (16 * s) * VT_PITCH + 64 * db;
                  const v4i16_t lo = __builtin_amdgcn_ds_read_tr16_b64_v4i16((LAS v4i16_t*)ap), hi2 = __builtin_amdgcn_ds_read_tr16_b64_v4i16((LAS v4i16_t*)(ap + 8 * VT_PITCH));
                  const bf16x8 af = __builtin_shufflevector(lo, hi2, 0, 1, 2, 3, 4, 5, 6, 7); O[db] = MFMA32(af, pf[s], O[db]); } }
        LDS_WAIT();
        if (__all(R == 0.f)) break;
    }
#pragma unroll
    for (int db = 0; db < 4; ++db)
#pragma unroll
        for (int rg = 0; rg < 4; ++rg) { v2u w; w.x = pk2(O[db][4 * rg], O[db][4 * rg + 1]); w.y = pk2(O[db][4 * rg + 2], O[db][4 * rg + 3]);
            *(v2u*)(OB + (size_t)(r0 + q) * DM + h * HD + 32 * db + 8 * rg + 4 * hh) = w; }
}
__device__ __forceinline__ void sbattn_phase(const Ctx& C, unsigned* qhead, const bf16* QB, const bf16* KBB, const bf16* VBB, const float* kcache, const float* vcache, bf16* OB) {
    LAS unsigned char* vt = C.lds + C.wave * (32 * VT_PITCH);
    int id = 0; if (C.lane == 0) id = (int)__hip_atomic_fetch_add(qhead, 1u, RLX_AGENT); id = __builtin_amdgcn_readfirstlane(id);
    while (id < SB_NTASK) {
        int nid = 0; if (C.lane == 0) nid = (int)__hip_atomic_fetch_add(qhead, 1u, RLX_AGENT);
        if (id < 512) { const int b = id >> 5, h = (id >> 1) & 15, hf = id & 1; sb_task(true, b, h, PAST + 32 * hf, MP + b * DECS + 32 * hf, QB, KBB, VBB, kcache, vcache, OB, vt, C.lane); }
        else { const int j = id - 512, b = j >> 12, h = (j >> 8) & 15, qt = j & 255; sb_task(false, b, h, qt * 32, b * SEQ + qt * 32, QB, KBB, VBB, kcache, vcache, OB, vt, C.lane); }
        id = __builtin_amdgcn_readfirstlane(nid);
    }
}

struct Args { const float* in[22]; float* out; unsigned char* ws; int ph_lo, ph_hi; };
__global__ void __launch_bounds__(NTHREADS, 2) mk_fwd(Args args) {
    extern __shared__ __attribute__((aligned(16))) unsigned char lds_raw[];
    Ctx C;
    C.lds = (LAS unsigned char*)lds_raw; C.MISC = (volatile LAS unsigned*)(C.lds + MISC_OFF);
    C.tid = threadIdx.x; C.lane = C.tid & 63; C.wave = __builtin_amdgcn_readfirstlane(C.tid >> 6);
    C.G = gridDim.x; C.bx = blockIdx.x; C.gw = C.bx * NWAVES + C.wave; C.NGW = C.G * NWAVES;
    unsigned char* ws = args.ws; unsigned* ctl = (unsigned*)(ws + WS_CTL); float* out = args.out;
    for (int u = C.tid; u < (LDS_BYTES - LDSCTL_OFF) / 4; u += NTHREADS) ((LAS unsigned*)(C.lds + LDSCTL_OFF))[u] = 0u;
    __syncthreads();
    XcdBarrier bar; bar.bar = ctl + CW_BAR; bar.x = 0; bar.st = nullptr;
    if (!MK_PER_PHASE) bar = xcd_barrier_post(ctl + CW_BAR, C.MISC + 8);
    const int lo = args.ph_lo, hi = args.ph_hi;
#define IN(k) (lo <= (k) && (k) < hi)
#define PH_ON(k) ((MK_PH_MASK >> (k)) & 1u)
#define SEAM(k) do { if (!MK_PER_PHASE && IN(k) && IN((k) + 1)) xcd_barrier(bar); } while (0)
    const float *x_prompt = args.in[0], *x_sample = args.in[1], *cache_k_a = args.in[2], *cache_v_a = args.in[3], *cache_kidx_a = args.in[4], *cache_k_b = args.in[5], *cache_v_b = args.in[6];
    const float *p_prompt = args.in[7], *p_sample = args.in[8], *rel_bias = args.in[9], *w_in_a = args.in[10], *w_out_a = args.in[11], *w_in_b = args.in[12], *w_out_b = args.in[13];
    const float *ln1_g = args.in[14], *ln1_b = args.in[15], *ln2_g = args.in[16], *ln2_b = args.in[17], *w_up = args.in[18], *w_down = args.in[19], *w_ple = args.in[20], *w_ple_gate = args.in[21];
    bf16 *WINA = (bf16*)(ws + WS_WINA), *WOUTA = (bf16*)(ws + WS_WOUTA), *WINB = (bf16*)(ws + WS_WINB), *WOUTB = (bf16*)(ws + WS_WOUTB), *WUP = (bf16*)(ws + WS_WUP), *WDOWN = (bf16*)(ws + WS_WDOWN), *WG = (bf16*)(ws + WS_WG), *WP = (bf16*)(ws + WS_WP);
    bf16 *PB = (bf16*)(ws + WS_PB), *XB = (bf16*)(ws + WS_XB), *X1B = (bf16*)(ws + WS_X1B), *X2B = (bf16*)(ws + WS_X2B), *QB = (bf16*)(ws + WS_QB), *OB = (bf16*)(ws + WS_OB), *QIB = (bf16*)(ws + WS_QIB);
    bf16 *KAP = (bf16*)(ws + WS_KAP), *VAP = (bf16*)(ws + WS_VAP), *KAS = (bf16*)(ws + WS_KAS), *VAS = (bf16*)(ws + WS_VAS), *KIP = (bf16*)(ws + WS_KIP), *KIS = (bf16*)(ws + WS_KIS), *HB = (bf16*)(ws + WS_H), *KBB = (bf16*)(ws + WS_KBB), *VBB = (bf16*)(ws + WS_VBB);
    float *WI = (float*)(ws + WS_WI), *RES = (float*)(ws + WS_RES), *Y0 = (float*)(ws + WS_Y0), *PW = (float*)(ws + WS_PW), *SCP = (float*)(ws + WS_SCP), *SCS = (float*)(ws + WS_SCS), *PART = (float*)(ws + WS_PART);
    int *IDX = (int*)(ws + WS_IDX), *CNT = (int*)(ws + WS_CNT);

    if (IN(0)) for (int rep_ = 0; rep_ < NREP(2); ++rep_) {
        transpose_job(C, w_in_a, DM, NINA, NINA_PAD, WINA); transpose_job(C, w_out_a, DM, DM, DM, WOUTA); transpose_job(C, w_in_b, DM, NINB, NINB, WINB); transpose_job(C, w_out_b, DM, DM, DM, WOUTB);
        for (int l = 0; l < 2; ++l) { transpose_job(C, w_up + (size_t)l * DM * DFF, DM, DFF, DFF, WUP + (size_t)l * DFF * DM); transpose_job(C, w_down + (size_t)l * DFF * DM, DFF, DM, DM, WDOWN + (size_t)l * DM * DFF);
            transpose_job(C, w_ple_gate + (size_t)l * DM * DM, DM, DM, DM, WG + (size_t)l * DM * DM); transpose_job(C, w_ple + (size_t)l * PLE * DM, PLE, DM, DM, WP + (size_t)l * DM * PLE); }
        cvt_job(C, x_prompt, XB, 1, MP * DM, 0, 0); cvt_job(C, x_sample, XB + (size_t)MP * DM, 1, MS * DM, 0, 0);
        for (int l = 0; l < 2; ++l) { cvt_job(C, p_prompt + (size_t)l * MP * PLE, PB + (size_t)l * MT * PLE, 1, MP * PLE, 0, 0); cvt_job(C, p_sample + (size_t)l * MS * PLE, PB + (size_t)l * MT * PLE + (size_t)MP * PLE, 1, MS * PLE, 0, 0); }
        cvt_job(C, cache_k_a, KAS, DECB, PAST * KVW, (size_t)PAST * KVW, (size_t)SALL * KVW); cvt_job(C, cache_v_a, VAS, DECB, PAST * KVW, (size_t)PAST * KVW, (size_t)SALL * KVW);
        cvt_job(C, cache_kidx_a, KIS, DECB, PAST * HD, (size_t)PAST * HD, (size_t)SALL * HD);
    }
    SEAM(0);
#define LAYER_BODY(l) do { \
        const int pb = (l == 0) ? 5 : 13; \
        if (l == 0) { \
            if (IN(1) && PH_ON(1)) { pg8::Gemm g{XB, WINA, MT, NINA_PAD, DM, DM}; pg8::StaticOrder S; S.init(MT, NINA_PAD, C.G, C.bx); \
                pg8::EpiInA E{QB, QIB, KAP, KIP, WI, out}; \
                pg8::gemm_phase<pg8::EpiInA, pg8::StaticOrder, true, true>(C.lds, g, S, E); if (NREP(0) > 1) { pg8::gemm_phase<pg8::EpiInA, pg8::StaticOrder, true, true>(C.lds, g, S, E); } } \
            SEAM(1); \
            if (IN(2) && PH_ON(2)) for (int rep_ = 0; rep_ < NREP2(1, 4); ++rep_) scores_phase(C, ctl + CW_QSC + 64 * rep_, QIB, KIP, KIS, WI, SCP, SCS); \
            SEAM(2); \
            if (IN(3) && PH_ON(3)) for (int rep_ = 0; rep_ < NREP2(1, 5); ++rep_) select_phase(C, SCP, SCS, IDX, CNT); \
            SEAM(3); \
            if (IN(4) && PH_ON(4)) for (int rep_ = 0; rep_ < NREP2(1, 6); ++rep_) sattn_phase(C, rel_bias, QB, KAP, VAP, KAS, VAS, IDX, CNT, OB); \
            SEAM(4); \
        } else { \
            if (IN(11) && PH_ON(11)) { pg8::Gemm g{XB, WINB, MT, NINB, DM, DM}; pg8::StaticOrder S; S.init(MT, NINB, C.G, C.bx); \
                pg8::EpiInB E{QB, KBB, out}; \
                pg8::gemm_phase<pg8::EpiInB, pg8::StaticOrder, true, true>(C.lds, g, S, E); if (NREP(0) > 1) { pg8::gemm_phase<pg8::EpiInB, pg8::StaticOrder, true, true>(C.lds, g, S, E); } } \
            SEAM(11); \
            if (IN(12) && PH_ON(12)) for (int rep_ = 0; rep_ < NREP(3); ++rep_) sbattn_phase(C, ctl + CW_QSB + 64 * rep_, QB, KBB, VBB, cache_k_b, cache_v_b, OB); \
            SEAM(12); \
        } \
        if (IN(pb) && PH_ON(pb)) { \
            { pg8::Gemm g{OB, l == 0 ? WOUTA : WOUTB, MP, DM, DM, DM}; pg8::StaticOrder S; S.init(MP, DM, C.G, C.bx); pg8::EpiResid E{l == 0 ? x_prompt : Y0, RES}; \
              GEMM2X((pg8::gemm_phase<pg8::EpiResid, pg8::StaticOrder, true, true>(C.lds, g, S, E))); } \
            { int ksl = 256; asm volatile("" : "+s"(ksl)); pg8::Gemm g{OB, l == 0 ? WOUTA : WOUTB, MT, DM, ksl, DM}; pg8::SplitOrder S{C.G, C.bx}; pg8::EpiPart E{PART}; \
              GEMM2X((pg8::gemm_phase<pg8::EpiPart, pg8::SplitOrder, true, true>(C.lds, g, S, E))); } } \
        SEAM(pb); \
        if (IN(pb + 1) && PH_ON(pb + 1)) ln_phase(C, RES, X1B, ln1_g + l * DM, ln1_b + l * DM, l == 0 ? x_sample - (size_t)MP * DM : Y0, PART); \
        SEAM(pb + 1); \
        if (IN(pb + 2) && PH_ON(pb + 2)) { pg8::Gemm g{X1B, WUP + (size_t)l * DFF * DM, MT, DFF, DM, DM}; pg8::StaticOrder S; S.init(MT, DFF, C.G, C.bx); \
            pg8::EpiSqRelu E{HB}; \
            GEMM2X((pg8::gemm_phase<pg8::EpiSqRelu, pg8::StaticOrder, true, true>(C.lds, g, S, E))); } \
        SEAM(pb + 2); \
        if (IN(pb + 3) && PH_ON(pb + 3)) { \
            { pg8::Gemm g{HB, WDOWN + (size_t)l * DM * DFF, MP, DM, DFF, DFF}; pg8::StaticOrder S; S.init(MP, DM, C.G, C.bx); pg8::EpiResid E{RES, RES}; \
              if (NREP(0) > 1) { pg8::EpiResid E2{RES, PW}; pg8::gemm_phase<pg8::EpiResid, pg8::StaticOrder, true, true>(C.lds, g, S, E2); } \
              pg8::gemm_phase<pg8::EpiResid, pg8::StaticOrder, true, true>(C.lds, g, S, E); } \
            { int ksl = 1024; asm volatile("" : "+s"(ksl)); pg8::Gemm g{HB, WDOWN + (size_t)l * DM * DFF, MT, DM, ksl, DFF}; pg8::SplitOrder S{C.G, C.bx}; pg8::EpiPart E{PART}; \
              GEMM2X((pg8::gemm_phase<pg8::EpiPart, pg8::SplitOrder, true, true>(C.lds, g, S, E))); } } \
        SEAM(pb + 3); \
        if (IN(pb + 4) && PH_ON(pb + 4)) ln_phase(C, RES, X2B, ln2_g + l * DM, ln2_b + l * DM, RES, PART); \
        SEAM(pb + 4); \
        if (IN(pb + 5) && PH_ON(pb + 5)) { \
            if (MK_GATE_PART & 1) { int kple = PLE; asm volatile("" : "+s"(kple)); pg8::Gemm g{PB + (size_t)l * MT * PLE, WP + (size_t)l * DM * PLE, MT, DM, kple, PLE}; pg8::StaticOrder S; S.init(MT, DM, C.G, C.bx); \
              pg8::EpiStoreF32 E{PW}; \
              pg8::gemm_phase<pg8::EpiStoreF32, pg8::StaticOrder, true, true>(C.lds, g, S, E); if (NREP(0) > 1) { pg8::gemm_phase<pg8::EpiStoreF32, pg8::StaticOrder, true, true>(C.lds, g, S, E); } } \
            VM_WAIT(); __syncthreads(); \
            if (MK_GATE_PART & 2) { pg8::Gemm g{X2B, WG + (size_t)l * DM * DM, MT, DM, DM, DM}; pg8::StaticOrder S; S.init(MT, DM, C.G, C.bx); \
              pg8::EpiGate E{RES, PW, l == 0 ? Y0 : out + O_Y, l == 0 ? XB : (bf16*)nullptr}; \
              pg8::gemm_phase<pg8::EpiGate, pg8::StaticOrder, true, true>(C.lds, g, S, E); if (NREP(0) > 1) { pg8::gemm_phase<pg8::EpiGate, pg8::StaticOrder, true, true>(C.lds, g, S, E); } } \
        } \
        SEAM(pb + 5); \
    } while (0)
    LAYER_BODY(0);
    LAYER_BODY(1);
#undef LAYER_BODY
#undef IN
#undef SEAM
}

extern "C" void kernel_launch(void* const* d_in, const int* in_sizes, int n_in, void* d_out, int out_size, void* d_ws, size_t ws_size, hipStream_t stream) {
    static int grid = 0;
    if (grid == 0) {
        if (n_in != 22 || out_size != (int)O_END || ws_size < WS_END) { fprintf(stderr, "kernel_launch: unexpected shapes (n_in %d, out %d, ws %zu)\n", n_in, out_size, ws_size); grid = -1; return; }
        int dev = 0, cus = 0;
        if (hipGetDevice(&dev) != hipSuccess || hipDeviceGetAttribute(&cus, hipDeviceAttributeMultiprocessorCount, dev) != hipSuccess) { grid = -1; return; }
        if (hipFuncSetAttribute((const void*)mk_fwd, hipFuncAttributeMaxDynamicSharedMemorySize, LDS_BYTES) != hipSuccess) { fprintf(stderr, "kernel_launch: hipFuncSetAttribute failed\n"); grid = -1; return; }
        int per_cu = 0;
        if (hipOccupancyMaxActiveBlocksPerMultiprocessor(&per_cu, (const void*)mk_fwd, NTHREADS, LDS_BYTES) != hipSuccess || per_cu < 1) fprintf(stderr, "kernel_launch: occupancy query reports %d\n", per_cu);
        (void)hipGetLastError();
        grid = cus - (cus % 8);
        if (grid < 8) grid = 8;
    }
    if (grid < 0) return;
    if (hipMemsetAsync((char*)d_ws + WS_CTL, 0, CTL_ZERO_BYTES, stream) != hipSuccess) return;
    Args a{};
    for (int i = 0; i < 22; ++i) a.in[i] = (const float*)d_in[i];
    a.out = (float*)d_out; a.ws = (unsigned char*)d_ws;
#if MK_PER_PHASE
    for (int p = 0; p < NPH; ++p) { a.ph_lo = p; a.ph_hi = p + 1; hipLaunchKernelGGL(mk_fwd, dim3(grid), dim3(NTHREADS), LDS_BYTES, stream, a); }
#else
    a.ph_lo = 0; a.ph_hi = NPH;
    hipLaunchKernelGGL(mk_fwd, dim3(grid), dim3(NTHREADS), LDS_BYTES, stream, a);
#endif
}
```

```cpp
#include <hip/hip_runtime.h>
#include <cstdio>
#include <cstdint>
#ifndef MK_PER_PHASE
#define MK_PER_PHASE 0
#endif
#ifndef MK_PH_MASK
#define MK_PH_MASK 0xffffffffu
#endif
constexpr int NWAVES = 8, NTHREADS = 512;
constexpr int DM = 2048, SEQ = 8192, MP = 16384, DECB = 16, DECS = 64, MS = 1024, MT = 17408, PAST = 4096, SALL = 4160;
constexpr int NINA = 5264, NINA_PAD = 5376, NINB = 6144, DFF = 8192, PLE = 256, HD = 128, KVW = 512, TOPK = 256;
constexpr float LN_EPS = 1e-5f, ALPHA = 1.41421356237309515f;
constexpr float QK_SCALE = 0.08838834764831845f;
constexpr float WI_SCALE = 0.25f * 0.08838834764831845f;
constexpr int NPH = 19;

constexpr size_t O_Y = 0;
constexpr size_t O_KAP = (size_t)MT * DM, O_VAP = O_KAP + (size_t)MP * KVW, O_KIP = O_VAP + (size_t)MP * KVW;
constexpr size_t O_KBP = O_KIP + (size_t)MP * HD, O_VBP = O_KBP + (size_t)MP * DM;
constexpr size_t O_KAS = O_VBP + (size_t)MP * DM, O_VAS = O_KAS + (size_t)MS * KVW, O_KIS = O_VAS + (size_t)MS * KVW;
constexpr size_t O_KBS = O_KIS + (size_t)MS * HD, O_VBS = O_KBS + (size_t)MS * DM, O_END = O_VBS + (size_t)MS * DM;
static_assert(O_END == 127008768, "d_out layout");

constexpr size_t MiB = 1u << 20;
constexpr size_t WS_CTL = 0, CTL_ZERO_BYTES = 1 * MiB;
constexpr size_t WS_WINA = 2 * MiB, WS_WOUTA = 23 * MiB, WS_WINB = 31 * MiB, WS_WOUTB = 55 * MiB, WS_WUP = 63 * MiB, WS_WDOWN = 127 * MiB, WS_WG = 191 * MiB, WS_WP = 207 * MiB;
constexpr size_t WS_PB = 210 * MiB, WS_XB = 228 * MiB, WS_X1B = 296 * MiB, WS_X2B = 364 * MiB, WS_QB = 432 * MiB, WS_OB = 500 * MiB, WS_QIB = 568 * MiB;
constexpr size_t WS_KAP = 636 * MiB, WS_VAP = 652 * MiB, WS_KAS = 668 * MiB, WS_VAS = 733 * MiB, WS_KIP = 798 * MiB, WS_KIS = 802 * MiB, WS_WI = 819 * MiB;
constexpr size_t WS_IDX = 821 * MiB, WS_CNT = 838 * MiB, WS_RES = 840 * MiB, WS_Y0 = 976 * MiB, WS_PW = 1112 * MiB, WS_H = 1248 * MiB;
constexpr size_t WS_SCP = 1248 * MiB  , WS_SCS = 1760 * MiB, WS_PART = 1778 * MiB  , WS_END = 1842 * MiB;
static_assert(WS_WINA + (size_t)NINA_PAD * DM * 2 <= WS_WOUTA && WS_PB + (size_t)2 * MT * PLE * 2 <= WS_XB && WS_XB + (size_t)MT * DM * 2 <= WS_X1B && WS_KAS + (size_t)DECB * SALL * KVW * 2 <= WS_VAS
              && WS_KIS + (size_t)DECB * SALL * HD * 2 <= WS_WI && WS_WI + (size_t)MT * 16 * 4 <= WS_IDX && WS_IDX + (size_t)MT * TOPK * 4 <= WS_CNT && WS_RES + (size_t)MT * DM * 4 <= WS_Y0
              && WS_H + (size_t)MT * DFF * 2 <= WS_SCS && WS_SCP + (size_t)MP * SEQ * 4 <= WS_SCS && WS_SCS + (size_t)MS * SALL * 4 <= WS_PART && WS_PART + (size_t)8 * MS * DM * 4 <= WS_END, "d_ws map");
constexpr size_t WS_KBB = WS_QIB, WS_VBB = WS_KAP;
static_assert(WS_VBB + (size_t)MT * DM * 2 <= WS_KIP, "VBB overlay");
constexpr size_t D_VBB = (WS_VBB - WS_KBB) / 2;
constexpr size_t D_VAP = (WS_VAP - WS_KAP) / 2, D_KAS = (WS_KAS - WS_KAP) / 2, D_VAS = (WS_VAS - WS_KAP) / 2, D_KIS = (WS_KIS - WS_KIP) / 2;
constexpr int CW_BAR = 4096;
constexpr int CW_QSB = 8448;
constexpr int CW_QSC = 8192;

constexpr int RING_BYTES = 135168;
constexpr int LDSCTL_OFF = RING_BYTES, MISC_OFF = LDSCTL_OFF + 320;
constexpr int LDS_BYTES = 147456;
static_assert(MISC_OFF + 128 <= LDS_BYTES, "LDS map");

#define GAS __attribute__((address_space(1)))
#define LAS __attribute__((address_space(3)))
typedef unsigned short bf16;
typedef unsigned v4u __attribute__((ext_vector_type(4)));
typedef unsigned v2u __attribute__((ext_vector_type(2)));
typedef float f32x4 __attribute__((ext_vector_type(4)));
typedef float f32x2 __attribute__((ext_vector_type(2)));
typedef float f32x16 __attribute__((ext_vector_type(16)));
typedef short bf16x8 __attribute__((ext_vector_type(8)));
typedef __bf16 bf16x2_t __attribute__((ext_vector_type(2)));
#define LDS_WAIT() asm volatile("s_waitcnt lgkmcnt(0)" ::: "memory")
#define VM_WAIT() asm volatile("s_waitcnt vmcnt(0)" ::: "memory")
__device__ __forceinline__ unsigned pk2(float lo, float hi) { f32x2 v = {lo, hi}; bf16x2_t b = __builtin_convertvector(v, bf16x2_t); return __builtin_bit_cast(unsigned, b); }
__device__ __forceinline__ float bf_lo(unsigned w) { return __uint_as_float(w << 16); }
__device__ __forceinline__ float bf_hi(unsigned w) { return __uint_as_float(w & 0xffff0000u); }
__device__ __forceinline__ float dot2bf(unsigned a, unsigned b, float c) { return __builtin_amdgcn_fdot2_f32_bf16(__builtin_bit_cast(bf16x2_t, a), __builtin_bit_cast(bf16x2_t, b), c, false); }
namespace pg8 {
#define PG8_LAS __attribute__((address_space(3)))
typedef unsigned short bf16_t;
typedef short bf16x8 __attribute__((ext_vector_type(8)));
typedef float f32x4 __attribute__((ext_vector_type(4)));
typedef unsigned u32x4 __attribute__((ext_vector_type(4)));
constexpr int BM = 256, BK = 64, HALF = 128, HTB = HALF * BK * 2  , STAGE_BYTES = 8 * HTB, NXCD = 8, WGM = 8;

__host__ __device__ __forceinline__ int lds_byte(int r, int c) { const int st = (r >> 4) * 2 + (c >> 5), rr = r & 15, cc = c & 31, ob = rr * 64 + cc * 2; return st * 1024 + (ob ^ (((ob >> 9) & 1) << 5)); }
__host__ __device__ __forceinline__ void stage_rc(int b, int& R, int& C) { const int st = b / 1024, sb = b % 1024, swz = sb ^ (((sb >> 9) & 1) << 5); R = (st >> 1) * 16 + swz / 64; C = (st & 1) * 32 + (swz % 64) / 2; }
__host__ __device__ __forceinline__ int perm32(int rho) { const int n = rho >> 4, i = rho & 15; return 8 * (i >> 2) + 4 * n + (i & 3); }

struct Unit { int pm, pn, ks; };
struct Gemm { const bf16_t* A; const bf16_t* Bt; int M, N, K, ld; };

struct StaticOrder {
    int nM, nN, nwg, G, c;
    __host__ __device__ void init(int M, int N, int G_, int c_) { nM = M / BM; nN = N / BM; nwg = nM * nN; G = G_; c = c_; }
    __host__ __device__ bool next(int i, Unit& u) const {
        const long L = (long)i * G + c; if (L >= nwg) return false;
        int wgid = (int)L; { const int q = nwg / NXCD, r = nwg % NXCD, xcd = wgid % NXCD, off = wgid / NXCD; wgid = (xcd < r ? xcd * (q + 1) : r * (q + 1) + (xcd - r) * q) + off; }
        const int nig = WGM * nN, gid = wgid / nig, fm = gid * WGM, gsz = (nM - fm) < WGM ? (nM - fm) : WGM;
        u.pm = fm + ((wgid % nig) % gsz); u.pn = (wgid % nig) / gsz; u.ks = 0; return true;
    }
    __device__ __forceinline__ void a_ready(const Unit&) const {}
    __device__ __forceinline__ void done(const Unit&) const {}
};

__device__ __forceinline__ unsigned cvt_pk_bf16(float lo, float hi) { unsigned r; asm volatile("v_cvt_pk_bf16_f32 %0, %1, %2" : "=v"(r) : "v"(lo), "v"(hi)); return r; }
typedef float f32x2 __attribute__((ext_vector_type(2)));
__device__ __forceinline__ void st_bf16x8(bf16_t* p, const f32x4& a, const f32x4& b) { u32x4 w; w.x = ::pk2(a[0], a[1]); w.y = ::pk2(a[2], a[3]); w.z = ::pk2(b[0], b[1]); w.w = ::pk2(b[2], b[3]); *(u32x4*)p = w; }
__device__ __forceinline__ void st_f32x8(float* p, const f32x4& a, const f32x4& b) { *(f32x4*)p = a; *(f32x4*)(p + 4) = b; }
#define PG8_EPI_LOOP(...) \
    _Pragma("unroll") for (int ai = 0; ai < 2; ++ai) _Pragma("unroll") for (int m = 0; m < 4; ++m) { const int row = u.pm * BM + ai * HALF + wr * 64 + m * 16 + fr; \
        _Pragma("unroll") for (int bj = 0; bj < 2; ++bj) { const int cl = bj * HALF + wc * 32 + 8 * fq; const f32x4 v0 = acc[ai][bj][m][0], v1 = acc[ai][bj][m][1]; __VA_ARGS__ } }
#define PG8_EPI_LOOP_F(...) \
    _Pragma("unroll") for (int ai = 0; ai < 2; ++ai) _Pragma("unroll") for (int m = 0; m < 4; ++m) { const int row = u.pm * BM + ai * HALF + wr * 64 + m * 16 + fr; \
        _Pragma("unroll") for (int bj = 0; bj < 2; ++bj) { const int cl = bj * HALF + wc * 32 + 8 * fq; const f32x4 v0 = acc[ai][bj][m][0], v1 = acc[ai][bj][m][1]; __VA_ARGS__ } asm volatile("" ::: "memory"); }

struct EpiInA {
    static constexpr bool PERM = true, AFTER_DRAIN = false;
    bf16_t *Q, *QI, *KAP, *KIP; float* WI; float* out;
    __device__ __forceinline__ void operator()(const f32x4 (&acc)[2][2][4][2], const Unit& u, int wr, int wc, int fr, int fq) const {
        const int pn = u.pn; const bool samp = u.pm >= 64;
        float* fb = nullptr; bf16_t* bb; int ld; bool remap = false;
        if (pn < 8) { bb = Q + pn * BM; ld = ::DM; }
        else if (pn < 12) { const bool isv = pn >= 10; const int c0 = (pn & 1) * BM; ld = ::KVW; remap = samp;
            fb = out + (samp ? (isv ? ::O_VAS : ::O_KAS) - (size_t)::MP * ::KVW : (isv ? ::O_VAP : ::O_KAP)) + c0;
            bb = KAP + (samp ? (isv ? ::D_VAS : ::D_KAS) : (isv ? ::D_VAP : (size_t)0)) + c0; }
        else if (pn < 20) { bb = QI + (pn - 12) * BM; ld = ::DM; }
        else { ld = ::HD; remap = samp; fb = out + (samp ? ::O_KIS - (size_t)::MP * ::HD : ::O_KIP); bb = KIP + (samp ? ::D_KIS : (size_t)0); }
        PG8_EPI_LOOP(
            const int rs = row - ::MP; const size_t brow = remap ? ((size_t)(rs >> 6) * ::SALL + ::PAST + (rs & 63)) : (size_t)row;
            if (pn == 20 && cl >= 128) { if (cl < 144) st_f32x8(WI + (size_t)row * 16 + (cl - 128), v0 * ::WI_SCALE, v1 * ::WI_SCALE); }
            else { if (fb) st_f32x8(fb + (size_t)row * ld + cl, v0, v1); st_bf16x8(bb + brow * ld + cl, v0, v1); }
        )
    }
};
struct EpiInB {
    static constexpr bool PERM = true, AFTER_DRAIN = false;
    bf16_t* Q; bf16_t* KBB; float* out;
    __device__ __forceinline__ void operator()(const f32x4 (&acc)[2][2][4][2], const Unit& u, int wr, int wc, int fr, int fq) const {
        const int pn = u.pn; const bool samp = u.pm >= 64; const bool isv = pn >= 16;
        float* fb = nullptr; bf16_t* bb;
        if (pn < 8) bb = Q + pn * BM;
        else { const int c0 = (pn & 7) * BM; bb = KBB + (isv ? ::D_VBB : (size_t)0) + c0; fb = out + (samp ? (isv ? ::O_VBS : ::O_KBS) - (size_t)::MP * ::DM : (isv ? ::O_VBP : ::O_KBP)) + c0; }
        PG8_EPI_LOOP(
            if (fb) st_f32x8(fb + (size_t)row * ::DM + cl, v0, v1);
            st_bf16x8(bb + (size_t)row * ::DM + cl, v0, v1);
        )
    }
};
struct EpiResid {
    static constexpr bool PERM = true, AFTER_DRAIN = false;
    const float* x; float* RES;
    __device__ __forceinline__ void operator()(const f32x4 (&acc)[2][2][4][2], const Unit& u, int wr, int wc, int fr, int fq) const {
        const int pn = u.pn;
        PG8_EPI_LOOP_F(
            const size_t off = (size_t)row * ::DM + pn * BM + cl; const f32x4 x0 = *(const f32x4*)(x + off), x1 = *(const f32x4*)(x + off + 4);
            st_f32x8(RES + off, x0 * ::ALPHA + v0, x1 * ::ALPHA + v1);
        )
    }
};
struct EpiPart {
    static constexpr bool PERM = true, AFTER_DRAIN = false;
    float* PART;
    __device__ __forceinline__ void operator()(const f32x4 (&acc)[2][2][4][2], const Unit& u, int wr, int wc, int fr, int fq) const {
        const int pn = u.pn; float* base = PART + (size_t)u.ks * ::MS * ::DM;
        PG8_EPI_LOOP( st_f32x8(base + (size_t)(row - ::MP) * ::DM + pn * BM + cl, v0, v1); )
    }
};
struct SplitOrder {
    int G, c;
    __device__ __forceinline__ bool next(int i, Unit& u) const { const int L = i * G + c; if (L >= 256) return false; u.pm = 64 + (L & 3); u.pn = (L >> 2) & 7; u.ks = L >> 5; return true; }
    __device__ __forceinline__ void a_ready(const Unit&) const {}
    __device__ __forceinline__ void done(const Unit&) const {}
};
struct EpiSqRelu {
    static constexpr bool PERM = true, AFTER_DRAIN = false;
    bf16_t* H;
    __device__ __forceinline__ void operator()(const f32x4 (&acc)[2][2][4][2], const Unit& u, int wr, int wc, int fr, int fq) const {
        const int pn = u.pn;
        PG8_EPI_LOOP(
            f32x4 a = __builtin_elementwise_max(v0, (f32x4){0.f, 0.f, 0.f, 0.f}), b = __builtin_elementwise_max(v1, (f32x4){0.f, 0.f, 0.f, 0.f});
            st_bf16x8(H + (size_t)row * ::DFF + pn * BM + cl, a * a, b * b);
        )
    }
};
struct EpiStoreF32 {
    static constexpr bool PERM = true, AFTER_DRAIN = false;
    float* C;
    __device__ __forceinline__ void operator()(const f32x4 (&acc)[2][2][4][2], const Unit& u, int wr, int wc, int fr, int fq) const {
        const int pn = u.pn;
        PG8_EPI_LOOP( st_f32x8(C + (size_t)row * ::DM + pn * BM + cl, v0, v1); )
    }
};
struct EpiGate {
    static constexpr bool PERM = true, AFTER_DRAIN = false;
    const float* X2; const float* PW; float* Y; bf16_t* YB;
    __device__ __forceinline__ f32x4 sig(const f32x4& v) const { f32x4 r;
#pragma unroll
        for (int i = 0; i < 4; ++i) r[i] = __builtin_amdgcn_rcpf(1.0f + __expf(-v[i])); return r; }
    __device__ __forceinline__ void operator()(const f32x4 (&acc)[2][2][4][2], const Unit& u, int wr, int wc, int fr, int fq) const {
        const int pn = u.pn;
        PG8_EPI_LOOP_F(
            const size_t off = (size_t)row * ::DM + pn * BM + cl;
            const f32x4 y0 = *(const f32x4*)(X2 + off) + sig(v0) * *(const f32x4*)(PW + off), y1 = *(const f32x4*)(X2 + off + 4) + sig(v1) * *(const f32x4*)(PW + off + 4);
            st_f32x8(Y + off, y0, y1); if (YB) st_bf16x8(YB + off, y0, y1);
        )
    }
};
template <class Epi, class Sched, bool ALIGN_EPI = false, bool SP2 = false>
__device__ __forceinline__ void gemm_phase(PG8_LAS unsigned char* lds, const Gemm g, const Sched& S, const Epi& E) {
    const int tid = threadIdx.x, wid = __builtin_amdgcn_readfirstlane(tid >> 6), lane = tid & 63, wr = wid >> 2, wc = wid & 3, fr = lane & 15, fq = lane >> 4;
    const int K = g.ld, nt = g.K / BK;
    const size_t kslice = (size_t)g.K * 2;
    unsigned voffA[2], voffB[2];
#pragma unroll
    for (int i = 0; i < 2; ++i) { int R, C; stage_rc(tid * 16 + i * 8192, R, C); const int Rb = Epi::PERM ? ((R & ~31) + perm32(R & 31)) : R;
        voffA[i] = (unsigned)(R * K + C) * 2u; voffB[i] = (unsigned)(Rb * K + C) * 2u; }
    const size_t kstep = (size_t)(BK * 2);
    const size_t hstep = (size_t)HALF * K * 2;
    const size_t tstep = 2 * hstep;
    const unsigned ldsw = (unsigned)wid * 1024u;
    const int aoff = lds_byte(wr * 64 + fr, fq * 8), boff = lds_byte(wc * 32 + fr, fq * 8);
#define PG8_SA(b, h) (((b) * 2 + (h)) * HTB)
#define PG8_SB(b, h) ((4 + (b) * 2 + (h)) * HTB)
#define PG8_STAGE(bufoff, gbase, voff) do { _Pragma("unroll") for (int _i = 0; _i < 2; ++_i) \
        __builtin_amdgcn_global_load_lds((const unsigned*)((const char*)(gbase) + (voff)[_i]), (PG8_LAS unsigned*)(lds + (bufoff) + ldsw + _i * 8192), 16, 0, 0); } while (0)
#define PG8_LDA(dst, b, h) do { _Pragma("unroll") for (int m = 0; m < 4; ++m) _Pragma("unroll") for (int k = 0; k < 2; ++k) dst[m][k] = *(const PG8_LAS bf16x8*)(lds + PG8_SA(b, h) + aoff + m * 2048 + k * 1024); } while (0)
#define PG8_LDB(dst, b, h) do { _Pragma("unroll") for (int n = 0; n < 2; ++n) _Pragma("unroll") for (int k = 0; k < 2; ++k) dst[n][k] = *(const PG8_LAS bf16x8*)(lds + PG8_SB(b, h) + boff + n * 2048 + k * 1024); } while (0)
#define PG8_MMA(ai, bj, At, Bt) do { __builtin_amdgcn_s_setprio(1); _Pragma("unroll") for (int m = 0; m < 4; ++m) _Pragma("unroll") for (int n = 0; n < 2; ++n) _Pragma("unroll") for (int k = 0; k < 2; ++k) \
        acc[ai][bj][m][n] = __builtin_amdgcn_mfma_f32_16x16x32_bf16(Bt[n][k], At[m][k], acc[ai][bj][m][n], 0, 0, 0); __builtin_amdgcn_s_setprio(0); } while (0)
#define PG8_WAIT_V(n) asm volatile("s_waitcnt vmcnt(" #n ")" ::: "memory")
#define PG8_WAIT_L(n) asm volatile("s_waitcnt lgkmcnt(" #n ")" ::: "memory")
#define PG8_BAR __builtin_amdgcn_s_barrier()
#define PG8_SCHED __builtin_amdgcn_sched_barrier(0)
    Unit cur, nxt; int ui = 0;
    if (!S.next(0, cur)) return;
    f32x4 acc[2][2][4][2];
#pragma unroll
    for (int a = 0; a < 2; ++a)
#pragma unroll
        for (int b = 0; b < 2; ++b)
#pragma unroll
            for (int m = 0; m < 4; ++m)
#pragma unroll
                for (int n = 0; n < 2; ++n) acc[a][b][m][n] = (f32x4){0.f, 0.f, 0.f, 0.f};
    bf16x8 At[4][2], B0[2][2], B1[2][2];
    const char* cA = (const char*)g.A + (size_t)cur.pm * tstep + cur.ks * kslice; const char* cB = (const char*)g.Bt + (size_t)cur.pn * tstep + cur.ks * kslice;
    S.a_ready(cur);
    if constexpr (SP2) {
        PG8_STAGE(PG8_SB(0, 0), cB, voffB); PG8_STAGE(PG8_SB(0, 1), cB + hstep, voffB); PG8_STAGE(PG8_SA(0, 0), cA, voffA); PG8_STAGE(PG8_SA(0, 1), cA + hstep, voffA);
        if (wr == 1) PG8_BAR;
        PG8_WAIT_V(2); PG8_BAR;
        PG8_STAGE(PG8_SB(1, 0), cB + kstep, voffB); PG8_STAGE(PG8_SA(1, 0), cA + kstep, voffA); PG8_STAGE(PG8_SB(1, 1), cB + hstep + kstep, voffB);
        PG8_WAIT_V(6); PG8_BAR;
    } else {
        PG8_STAGE(PG8_SB(0, 0), cB, voffB); PG8_STAGE(PG8_SA(0, 0), cA, voffA); PG8_STAGE(PG8_SB(0, 1), cB + hstep, voffB); PG8_STAGE(PG8_SA(0, 1), cA + hstep, voffA);
        if (wr == 1) PG8_BAR;
        PG8_WAIT_V(4); PG8_BAR;
        PG8_STAGE(PG8_SB(1, 0), cB + kstep, voffB); PG8_STAGE(PG8_SA(1, 0), cA + kstep, voffA); PG8_STAGE(PG8_SB(1, 1), cB + hstep + kstep, voffB);
        PG8_WAIT_V(6); PG8_BAR;
    }
    for (;;) {
        const bool has_next = S.next(ui + 1, nxt);
        const char* nA = has_next ? (const char*)g.A + (size_t)nxt.pm * tstep + nxt.ks * kslice : cA; const char* nB = has_next ? (const char*)g.Bt + (size_t)nxt.pn * tstep + nxt.ks * kslice : cB;
        for (int t = 0; t < nt; t += 2) {
            const bool last = (t == nt - 2);
            const char* a1 = cA + (size_t)(t + 1) * kstep;
            const char* a2 = last ? nA : cA + (size_t)(t + 2) * kstep; const char* b2 = last ? nB : cB + (size_t)(t + 2) * kstep;
            const char* a3 = a2 + kstep; const char* b3 = b2 + kstep;
            if (last && has_next) S.a_ready(nxt);
            if constexpr (SP2) {
            PG8_LDB(B0, 0, 0); PG8_LDB(B1, 0, 1); PG8_SCHED; PG8_LDA(At, 0, 0); PG8_STAGE(PG8_SA(1, 1), a1 + hstep, voffA);
            PG8_WAIT_V(8); PG8_WAIT_L(0); PG8_BAR; PG8_MMA(0, 0, At, B0); PG8_MMA(0, 1, At, B1); PG8_BAR; PG8_SCHED;
            PG8_LDA(At, 0, 1); PG8_STAGE(PG8_SB(0, 0), b2, voffB); PG8_STAGE(PG8_SB(0, 1), b2 + hstep, voffB); PG8_STAGE(PG8_SA(0, 0), a2, voffA);
            PG8_WAIT_V(8); PG8_WAIT_L(0); PG8_BAR; PG8_MMA(1, 0, At, B0); PG8_MMA(1, 1, At, B1); PG8_BAR; PG8_SCHED;
            PG8_LDB(B0, 1, 0); PG8_LDB(B1, 1, 1); PG8_SCHED; PG8_LDA(At, 1, 0); PG8_STAGE(PG8_SA(0, 1), a2 + hstep, voffA);
            PG8_WAIT_V(8); PG8_WAIT_L(0); PG8_BAR; PG8_MMA(0, 0, At, B0); PG8_MMA(0, 1, At, B1); PG8_BAR; PG8_SCHED;
            PG8_LDA(At, 1, 1); PG8_STAGE(PG8_SB(1, 0), b3, voffB); PG8_STAGE(PG8_SB(1, 1), b3 + hstep, voffB); PG8_STAGE(PG8_SA(1, 0), a3, voffA);
            PG8_WAIT_V(8); PG8_WAIT_L(0); PG8_BAR; PG8_MMA(1, 0, At, B0); PG8_MMA(1, 1, At, B1); PG8_BAR; PG8_SCHED;
            } else {
            PG8_LDB(B0, 0, 0); PG8_SCHED; PG8_LDA(At, 0, 0); PG8_STAGE(PG8_SA(1, 1), a1 + hstep, voffA);
            PG8_WAIT_L(8); PG8_BAR; PG8_WAIT_L(0); PG8_MMA(0, 0, At, B0); PG8_BAR; PG8_SCHED;
            PG8_LDB(B1, 0, 1); PG8_STAGE(PG8_SB(0, 0), b2, voffB);
            PG8_BAR; PG8_WAIT_L(0); PG8_MMA(0, 1, At, B1); PG8_BAR;
            PG8_LDA(At, 0, 1); PG8_STAGE(PG8_SA(0, 0), a2, voffA);
            PG8_BAR; PG8_WAIT_L(0); PG8_MMA(1, 0, At, B0); PG8_BAR; PG8_SCHED;
            PG8_STAGE(PG8_SB(0, 1), b2 + hstep, voffB);
            PG8_WAIT_V(6); PG8_BAR; PG8_MMA(1, 1, At, B1); PG8_BAR;
            PG8_LDB(B0, 1, 0); PG8_SCHED; PG8_LDA(At, 1, 0); PG8_STAGE(PG8_SA(0, 1), a2 + hstep, voffA);
            PG8_WAIT_L(8); PG8_BAR; PG8_WAIT_L(0); PG8_MMA(0, 0, At, B0); PG8_BAR; PG8_SCHED;
            PG8_LDB(B1, 1, 1); PG8_STAGE(PG8_SB(1, 0), b3, voffB);
            PG8_BAR; PG8_WAIT_L(0); PG8_MMA(0, 1, At, B1); PG8_BAR;
            PG8_LDA(At, 1, 1); PG8_STAGE(PG8_SA(1, 0), a3, voffA);
            PG8_BAR; PG8_WAIT_L(0); PG8_MMA(1, 0, At, B0); PG8_BAR; PG8_SCHED;
            PG8_STAGE(PG8_SB(1, 1), b3 + hstep, voffB);
            PG8_WAIT_V(6); PG8_BAR; PG8_MMA(1, 1, At, B1); PG8_BAR;
            }
        }
        if constexpr (ALIGN_EPI) { if (wr == 0) PG8_BAR; }
        if constexpr (!Epi::AFTER_DRAIN) { E(acc, cur, wr, wc, fr, fq); S.done(cur); }
        if (!has_next) break;
#pragma unroll
        for (int a = 0; a < 2; ++a)
#pragma unroll
            for (int b = 0; b < 2; ++b)
#pragma unroll
                for (int m = 0; m < 4; ++m)
#pragma unroll
                    for (int n = 0; n < 2; ++n) acc[a][b][m][n] = (f32x4){0.f, 0.f, 0.f, 0.f};
        cur = nxt; cA = nA; cB = nB; ++ui;
        if constexpr (ALIGN_EPI) { if (wr == 1) PG8_BAR; }
    }
    PG8_WAIT_V(0);
    if constexpr (!ALIGN_EPI) { if (wr == 0) PG8_BAR; }
    PG8_BAR;
    if constexpr (Epi::AFTER_DRAIN) { E.fused(acc, cur, wr, wc, fr, fq, lds, wid, lane); S.done(cur); }
#undef PG8_SA
#undef PG8_SB
#undef PG8_STAGE
#undef PG8_LDA
#undef PG8_LDB
#undef PG8_MMA
#undef PG8_WAIT_V
#undef PG8_WAIT_L
#undef PG8_BAR
#undef PG8_SCHED
}
}
#define XB_TMO      128
#define XB_XCNT(j)  (256  + 64 * (j))
#define XB_XSUB(j)  (1280 + 64 * (j))
#define XB_XGEN(j)  (2304 + 64 * (j))
#define XB_TOP      3328
#define XB_TOPGEN   3392
#define XCD_BAR_WORDS 3456
#define XB_SPIN_CAP (1u << 18)

__device__ __forceinline__ unsigned xb_ld(unsigned* p)              { return __hip_atomic_load(p, __ATOMIC_RELAXED, __HIP_MEMORY_SCOPE_AGENT); }
__device__ __forceinline__ unsigned xb_add(unsigned* p, unsigned v) { return __hip_atomic_fetch_add(p, v, __ATOMIC_RELAXED, __HIP_MEMORY_SCOPE_AGENT); }
__device__ __forceinline__ unsigned xb_xcc_id() { return (unsigned)__builtin_amdgcn_s_getreg((3 << 11) | 20) & 0xFu; }
#define XB_SPIN(cond, bar) do { unsigned _sp = 0; while (cond) { __builtin_amdgcn_s_sleep(1); \
    if ((++_sp & 255u) == 0u) { if (xb_ld(&(bar)[XB_TMO])) break; if (_sp > XB_SPIN_CAP) { atomicAdd(&(bar)[XB_TMO], 1u); break; } } } } while (0)

struct XcdBarrier {
    unsigned* bar; unsigned x;
    volatile LAS unsigned* st;
};

__device__ __forceinline__ XcdBarrier xcd_barrier_post(unsigned* bar, volatile LAS unsigned* st) {
    XcdBarrier b; b.bar = bar; b.x = xb_xcc_id(); b.st = st;
    if (threadIdx.x == 0) (void)xb_add(&bar[XB_XCNT(b.x)], 1u);
    return b;
}
__device__ __forceinline__ void xcd_barrier_complete(unsigned* bar, unsigned x, unsigned& nloc, unsigned& nx) {
    const unsigned G = gridDim.x * gridDim.y * gridDim.z;
    unsigned sum, cnt, mine, sp = 0u;
    for (;;) {
        sum = 0u; cnt = 0u; mine = 0u;
#pragma unroll
        for (unsigned j = 0; j < 16; ++j) { const unsigned c = xb_ld(&bar[XB_XCNT(j)]); sum += c; cnt += (c > 0u) ? 1u : 0u; mine = (j == x) ? c : mine; }
        if (sum == G) break;
        __builtin_amdgcn_s_sleep(1);
        if ((++sp & 255u) == 0u) { if (xb_ld(&bar[XB_TMO])) break; if (sp > XB_SPIN_CAP) { atomicAdd(&bar[XB_TMO], 1u); break; } }
    }
    nloc = mine > 0u ? mine : 1u; nx = cnt > 0u ? cnt : 1u;
}

__device__ __forceinline__ void xcd_barrier(const XcdBarrier& b) {
    asm volatile("s_waitcnt vmcnt(0)" ::: "memory");
    __syncthreads();
    if (threadIdx.x == 0) {
        unsigned* bar = b.bar;
        __builtin_amdgcn_s_waitcnt(0);
        unsigned nloc = b.st[0], nx = b.st[1];
        if (nloc == 0u) { xcd_barrier_complete(bar, b.x, nloc, nx); b.st[0] = nloc; b.st[1] = nx; }
        const unsigned old = xb_add(&bar[XB_XSUB(b.x)], 1u);
        const unsigned gen = old / nloc;
        if (old + 1u == (gen + 1u) * nloc) {
            __builtin_amdgcn_fence(__ATOMIC_RELEASE, "agent");
            asm volatile("s_waitcnt vmcnt(0)" ::: "memory");
            const unsigned og = xb_add(&bar[XB_TOP], 1u);
            const unsigned tg = og / nx;
            if (og + 1u == (tg + 1u) * nx) xb_add(&bar[XB_TOPGEN], 1u);
            else XB_SPIN(xb_ld(&bar[XB_TOPGEN]) == tg, bar);
            __builtin_amdgcn_fence(__ATOMIC_ACQUIRE, "agent");
            xb_add(&bar[XB_XGEN(b.x)], 1u);
            asm volatile("s_waitcnt vmcnt(0)" ::: "memory");
        } else {
            XB_SPIN(xb_ld(&bar[XB_XGEN(b.x)]) == gen, bar);
            __builtin_amdgcn_fence(__ATOMIC_ACQUIRE, "agent");
            asm volatile("s_waitcnt vmcnt(0)" ::: "memory");
        }
    }
    __syncthreads();
}
#ifndef MK_PROBE
#define MK_PROBE 0
#endif
#define NREP(bit) (((MK_PROBE >> (bit)) & 1) ? 2 : 1)
#define GEMM2X(call) do { call; if (NREP(0) > 1) { call; } } while (0)
#define NREP2(b1, b2) ((((MK_PROBE >> (b1)) | (MK_PROBE >> (b2))) & 1) ? 2 : 1)
#ifndef MK_GATE_PART
#define MK_GATE_PART 3
#endif
typedef GAS unsigned gu32;
#define RLX_AGENT __ATOMIC_RELAXED, __HIP_MEMORY_SCOPE_AGENT
#define MFMA32(a, b, c) __builtin_amdgcn_mfma_f32_32x32x16_bf16((a), (b), (c), 0, 0, 0)

struct Ctx { LAS unsigned char* lds; volatile LAS unsigned* MISC; int tid, lane, wave, G, bx, gw, NGW; };
__device__ __forceinline__ int crow(int r, int hi) { return (r & 3) + 8 * (r >> 2) + 4 * hi; }

constexpr int TR_PITCH = 132;
__device__ __forceinline__ void p0_transpose_item(const float* W, int K, int N, int NP, bf16* WT, LAS unsigned char* scr, int item, int lane) {
    const int nblk = NP / 64, kb = item / nblk, nb = item % nblk, k0 = 64 * kb, n0 = 64 * nb;
    const int kp = lane >> 4, n4 = lane & 15; const bool inn = n0 + 4 * n4 < N;
    f32x4 va[8], vb[8];
    const float* src = W + (size_t)(k0 + 2 * kp) * N + n0 + 4 * n4;
#pragma unroll
    for (int i = 0; i < 8; ++i) { va[i] = inn ? *(const f32x4*)(src + (size_t)(8 * i) * N) : (f32x4){0.f, 0.f, 0.f, 0.f}; vb[i] = inn ? *(const f32x4*)(src + (size_t)(8 * i + 1) * N) : (f32x4){0.f, 0.f, 0.f, 0.f}; }
#pragma unroll
    for (int i = 0; i < 8; ++i)
#pragma unroll
        for (int e = 0; e < 4; ++e) *(LAS unsigned*)(scr + (4 * n4 + e) * TR_PITCH + (8 * i + 2 * kp) * 2) = pk2(va[i][e], vb[i][e]);
    LDS_WAIT();
    const int nr = lane >> 3, c = lane & 7;
#pragma unroll
    for (int j = 0; j < 8; ++j) { const int n = 8 * j + nr; const LAS unsigned* s = (const LAS unsigned*)(scr + n * TR_PITCH + 16 * c);
        v4u o; o.x = s[0]; o.y = s[1]; o.z = s[2]; o.w = s[3];
        *(v4u*)(WT + (size_t)(n0 + n) * K + k0 + 8 * c) = o; }
    LDS_WAIT();
}
__device__ __forceinline__ void transpose_job(const Ctx& C, const float* W, int K, int N, int NP, bf16* WT) {
    LAS unsigned char* scr = C.lds + C.wave * 16384;
    const int nitems = (K / 64) * (NP / 64);
    for (int it = C.gw; it < nitems; it += C.NGW) p0_transpose_item(W, K, N, NP, WT, scr, it, C.lane);
}
__device__ __forceinline__ void cvt_job(const Ctx& C, const float* src, bf16* dst, int nseg, int seglen, size_t sstride, size_t dstride) {
    const int vps = seglen / 8; const long total = (long)nseg * vps; const long NGT = (long)C.G * NTHREADS;
    for (long i0 = (long)C.bx * NTHREADS + C.tid; i0 < total; i0 += 4 * NGT) {
        f32x4 a[4], b[4]; size_t doff[4]; bool ok[4];
#pragma unroll
        for (int u = 0; u < 4; ++u) { const long i = i0 + u * NGT; ok[u] = i < total; const long ii = ok[u] ? i : i0; const int seg = (int)(ii / vps), off = (int)(ii % vps) * 8;
            a[u] = *(const f32x4*)(src + seg * sstride + off); b[u] = *(const f32x4*)(src + seg * sstride + off + 4); doff[u] = seg * dstride + off; }
#pragma unroll
        for (int u = 0; u < 4; ++u) if (ok[u]) { v4u o; o.x = pk2(a[u].x, a[u].y); o.y = pk2(a[u].z, a[u].w); o.z = pk2(b[u].x, b[u].y); o.w = pk2(b[u].z, b[u].w); *(v4u*)(dst + doff[u]) = o; }
    }
}

__device__ __forceinline__ float wave_sum(float v) {
#pragma unroll
    for (int o = 1; o < 64; o <<= 1) v += __shfl_xor(v, o);
    return v;
}
__device__ __forceinline__ void ln_phase(const Ctx& C, float* RES, bf16* XO, const float* g, const float* b, const float* xs, const float* PART) {
    for (int row = C.gw; row < MT; row += C.NGW) {
        f32x4* xr = (f32x4*)(RES + (size_t)row * DM) + C.lane;
        f32x4 v[8]; float s = 0.f;
        if (row < MP) {
#pragma unroll
            for (int j = 0; j < 8; ++j) v[j] = xr[64 * j];
        } else {
            const f32x4* xp = (const f32x4*)(xs + (size_t)row * DM) + C.lane;
#pragma unroll
            for (int j = 0; j < 8; ++j) v[j] = xp[64 * j] * ALPHA;
#pragma unroll 2
            for (int ks = 0; ks < 8; ++ks) { const f32x4* pp = (const f32x4*)(PART + ((size_t)ks * MS + (row - MP)) * DM) + C.lane;
#pragma unroll
                for (int j = 0; j < 8; ++j) v[j] += pp[64 * j]; }
        }
#pragma unroll
        for (int j = 0; j < 8; ++j) s += (v[j].x + v[j].y) + (v[j].z + v[j].w);
        const float mean = wave_sum(s) * (1.f / DM); float s2 = 0.f;
#pragma unroll
        for (int j = 0; j < 8; ++j) { v[j] = v[j] - mean; s2 += (v[j].x * v[j].x + v[j].y * v[j].y) + (v[j].z * v[j].z + v[j].w * v[j].w); }
        const float rstd = 1.f / sqrtf(wave_sum(s2) * (1.f / DM) + LN_EPS);
        v2u* o8 = (v2u*)(XO + (size_t)row * DM) + C.lane;
#pragma unroll
        for (int j = 0; j < 8; ++j) { const f32x4 gg = ((const f32x4*)g)[C.lane + 64 * j], bb = ((const f32x4*)b)[C.lane + 64 * j]; const f32x4 y = v[j] * rstd * gg + bb;
            xr[64 * j] = y; v2u w; w.x = pk2(y.x, y.y); w.y = pk2(y.z, y.w); o8[64 * j] = w; }
    }
}

constexpr int SC_QPITCH = 4112, SC_NITEMS = 160 + 2304;
__device__ __forceinline__ void scores_phase(const Ctx& C, unsigned* qhead, const bf16* QIB, const bf16* KIP, const bf16* KIS, const float* WI, float* SCP, float* SCS) {
    const int q = C.lane & 31, hh = C.lane >> 5;
    for (;;) {
        if (C.tid == 0) C.MISC[0] = __hip_atomic_fetch_add(qhead, 1u, RLX_AGENT);
        __syncthreads();
        int id = (int)C.MISC[0];
        __syncthreads();
        if (id >= SC_NITEMS) break;
        int row0, nk, ch, stride; const bf16* KI; float* SC;
        if (id < 160) { const int qt = id / 5; ch = id % 5; const int rs0 = qt * 32, b = rs0 >> 6; row0 = MP + rs0; KI = KIS + (size_t)b * SALL * HD; nk = SALL; SC = SCS + (size_t)rs0 * SALL; stride = SALL; }
        else { id -= 160; int k = 7; while (id >= 64 * (k + 1)) { id -= 64 * (k + 1); --k; }
            const int per = 4 * (k + 1), ci = id / per, rem = id % per, c = 16 * k + 15 - ci, tile4 = rem / (k + 1); ch = rem % (k + 1);
            const int b = tile4 >> 1, t0 = c * 64 + (tile4 & 1) * 32; row0 = b * SEQ + t0; KI = KIP + (size_t)b * SEQ * HD; nk = 64 * (c + 1); SC = SCP + (size_t)row0 * SEQ; stride = SEQ; }
        const int s_begin = ch * 1024, nkc = (nk - s_begin) < 1024 ? (nk - s_begin) : 1024, ntiles = nkc >> 5;
#pragma unroll 4
        for (int i = 0; i < 16; ++i) { const int p = C.tid + NTHREADS * i, qq = p >> 8, off = (p & 255) * 16;
            const v4u v = *(const v4u*)((const char*)QIB + (size_t)(row0 + qq) * (DM * 2) + off); *(LAS v4u*)(C.lds + qq * SC_QPITCH + off) = v; }
        LAS float* wl = (LAS float*)(C.lds + 32 * SC_QPITCH);
        { const int qq = C.tid >> 4, h2 = C.tid & 15; wl[qq * 17 + h2] = WI[(size_t)(row0 + qq) * 16 + h2]; }
        __syncthreads();
        const LAS unsigned char* qb = C.lds + q * SC_QPITCH + hh * 16;
        for (int ti = C.wave; ti < ntiles; ti += NWAVES) {
            const int s0 = s_begin + ti * 32;
            const bf16* kp = KI + (size_t)(s0 + q) * HD + 8 * hh;
            bf16x8 kf[8];
#pragma unroll
            for (int kk = 0; kk < 8; ++kk) kf[kk] = *(const bf16x8*)(kp + 16 * kk);
            f32x16 acc;
#pragma unroll
            for (int r = 0; r < 16; ++r) acc[r] = 0.f;
#pragma unroll 2
            for (int h = 0; h < 16; ++h) {
                f32x16 c; const float wh = wl[q * 17 + h];
#pragma unroll
                for (int r = 0; r < 16; ++r) c[r] = 0.f;
#pragma unroll
                for (int kk = 0; kk < 8; ++kk) { const bf16x8 bq = *(const LAS bf16x8*)(qb + h * 256 + kk * 32); c = MFMA32(kf[kk], bq, c); }
#pragma unroll
                for (int r = 0; r < 16; ++r) acc[r] += wh * __builtin_fmaxf(c[r], 0.f);
            }
            float* sp = SC + (size_t)q * stride + s0 + 4 * hh;
#pragma unroll
            for (int g = 0; g < 4; ++g) *(f32x4*)(sp + 8 * g) = (f32x4){acc[4 * g], acc[4 * g + 1], acc[4 * g + 2], acc[4 * g + 3]};
        }
        __syncthreads();
    }
}

__device__ __forceinline__ unsigned tokey(float f) { const unsigned u = __float_as_uint(f); return (u & 0x80000000u) ? ~u : (u | 0x80000000u); }
__device__ __forceinline__ void select_phase(const Ctx& C, const float* SCP, const float* SCS, int* IDX, int* CNT) {
    LAS unsigned* hist = (LAS unsigned*)(C.lds + C.wave * 1024);
    const int lane = C.lane; const unsigned long long ltm = (1ull << lane) - 1ull;
    for (int row = C.gw; row < MT; row += C.NGW) {
        int n; const float* sc;
        if (row < MP) { const int t = row & (SEQ - 1); n = 64 * ((t >> 6) + 1); sc = SCP + (size_t)row * SEQ; } else { n = SALL; sc = SCS + (size_t)(row - MP) * SALL; }
        int* ip = IDX + (size_t)row * TOPK;
        if (n <= TOPK) {
#pragma unroll
            for (int k = 0; k < 4; ++k) { const int i = lane + 64 * k; ip[i] = (i < n) ? i : 0; }
            if (lane == 0) CNT[row] = n;
            continue;
        }
        v4u kreg[32];
#pragma unroll
        for (int it = 0; it < 32; ++it) { kreg[it] = (v4u){0u, 0u, 0u, 0u};
            if ((it >> 2) * 1024 < n) { if (it * 256 + lane * 4 < n) { const f32x4 v = *(const f32x4*)(sc + it * 256 + lane * 4); kreg[it] = (v4u){tokey(v.x), tokey(v.y), tokey(v.z), tokey(v.w)}; } } }
        unsigned prefix = 0u, mask = 0u, krem = TOPK;
        for (int pass = 0; pass < 4; ++pass) {
            const int shift = 24 - 8 * pass;
            *(LAS v4u*)(hist + 4 * lane) = (v4u){0u, 0u, 0u, 0u};
            LDS_WAIT();
#pragma unroll
            for (int it = 0; it < 32; ++it) if ((it >> 2) * 1024 < n) {
#pragma unroll
                for (int e = 0; e < 4; ++e) { const unsigned key = kreg[it][e]; if ((key & mask) == prefix) __hip_atomic_fetch_add(hist + ((key >> shift) & 255u), 1u, __ATOMIC_RELAXED, __HIP_MEMORY_SCOPE_WORKGROUP); } }
            LDS_WAIT();
            const v4u hc = *(const LAS v4u*)(hist + 4 * lane);
            const unsigned tot = hc.x + hc.y + hc.z + hc.w; unsigned x = tot;
#pragma unroll
            for (int o = 1; o < 64; o <<= 1) { const unsigned y = __shfl_down(x, o); if (lane + o < 64) x += y; }
            const unsigned a3 = x - tot, a2 = a3 + hc.w, a1 = a2 + hc.z, a0 = a1 + hc.y;
            int fe = -1; unsigned fa = 0u;
            if (a3 < krem && krem <= a3 + hc.w) { fe = 3; fa = a3; } else if (a2 < krem && krem <= a2 + hc.z) { fe = 2; fa = a2; }
            else if (a1 < krem && krem <= a1 + hc.y) { fe = 1; fa = a1; } else if (a0 < krem && krem <= a0 + hc.x) { fe = 0; fa = a0; }
            const unsigned long long bal = __ballot(fe >= 0); const int src = bal ? (__ffsll((long long)bal) - 1) : 0;
            const unsigned d = (unsigned)__shfl(4 * lane + fe, src), above = (unsigned)__shfl((int)fa, src);
            krem -= above; prefix |= d << shift; mask |= 0xffu << shift;
        }
        int outc = 0, eqs = 0;
#pragma unroll
        for (int it = 0; it < 32; ++it) if ((it >> 2) * 1024 < n) {
            bool eq[4], sel[4];
#pragma unroll
            for (int e = 0; e < 4; ++e) { eq[e] = kreg[it][e] == prefix; sel[e] = kreg[it][e] > prefix; }
            const unsigned long long anyeq = __ballot(eq[0] || eq[1] || eq[2] || eq[3]);
            if (anyeq) {
                const int mine = (int)eq[0] + (int)eq[1] + (int)eq[2] + (int)eq[3];
                int below = 0, total = 0;
#pragma unroll
                for (int e = 0; e < 4; ++e) { const unsigned long long bb = __ballot(eq[e]); below += __popcll(bb & ltm); total += __popcll(bb); }
                int r = eqs + below;
#pragma unroll
                for (int e = 0; e < 4; ++e) { if (eq[e]) { if ((unsigned)r < krem) sel[e] = true; ++r; } }
                eqs += total; (void)mine;
            }
#pragma unroll
            for (int e = 0; e < 4; ++e) { const unsigned long long sb = __ballot(sel[e]); const int pos = outc + __popcll(sb & ltm); if (sel[e] && pos < TOPK) ip[pos] = it * 256 + lane * 4 + e; outc += __popcll(sb); }
        }
        if (lane == 0) CNT[row] = outc < TOPK ? outc : TOPK;
    }
}

__device__ __forceinline__ int t5_bucket(int n  ) {
    const int ret = (n < 0) ? 16 : 0; n = n < 0 ? -n : n;
    if (n < 8) return ret + n;
    const int lg = 31 - __builtin_clz((unsigned)(n * n));
    const int large = 2 + lg; return ret + (large < 15 ? large : 15);
}
__device__ __forceinline__ float dpp_quad_sum(float t) {
    t += __builtin_bit_cast(float, __builtin_amdgcn_mov_dpp(__builtin_bit_cast(int, t), 0xB1, 0xF, 0xF, true));
    t += __builtin_bit_cast(float, __builtin_amdgcn_mov_dpp(__builtin_bit_cast(int, t), 0x4E, 0xF, 0xF, true));
    return t;
}
__device__ __forceinline__ void sattn_task(int row, int g, int qpos, const bf16* Kb, const bf16* Vb, int cnt, const int* ip, const bf16* QB, bf16* OB,
                                           LAS int* idxl, LAS float* lg, const LAS float* biasl, int lane) {
#pragma unroll
    for (int k = 0; k < 4; ++k) { const int j = lane + 64 * k; const int v = ip[j]; idxl[j] = (j < cnt) ? v : 0; }
    const int kq = lane >> 2, c4 = lane & 3;
    unsigned qreg[4][16];
    { const bf16* qp = QB + (size_t)row * DM + (4 * g) * HD + 32 * c4;
#pragma unroll
      for (int hq = 0; hq < 4; ++hq)
#pragma unroll
          for (int i = 0; i < 4; ++i) { const v4u a = *(const v4u*)(qp + hq * HD + 8 * i); qreg[hq][4 * i] = a.x; qreg[hq][4 * i + 1] = a.y; qreg[hq][4 * i + 2] = a.z; qreg[hq][4 * i + 3] = a.w; } }
    LDS_WAIT();
#define SA_QK_LOAD(KD, B) do { _Pragma("unroll") for (int rr = 0; rr < 4; ++rr) { const int key = idxl[16 * (4 * (B) + rr) + kq]; const bf16* kp = Kb + (size_t)key * KVW + 32 * c4; \
        _Pragma("unroll") for (int i = 0; i < 4; ++i) KD[rr][i] = *(const v4u*)(kp + 8 * i); } } while (0)
#define SA_QK_COMP(KD, B) do { _Pragma("unroll") for (int rr = 0; rr < 4; ++rr) { float s[4]; \
        _Pragma("unroll") for (int hq = 0; hq < 4; ++hq) { float t = 0.f; \
            _Pragma("unroll") for (int i = 0; i < 4; ++i) { t = dot2bf(KD[rr][i].x, qreg[hq][4 * i], t); t = dot2bf(KD[rr][i].y, qreg[hq][4 * i + 1], t); t = dot2bf(KD[rr][i].z, qreg[hq][4 * i + 2], t); t = dot2bf(KD[rr][i].w, qreg[hq][4 * i + 3], t); } \
            s[hq] = dpp_quad_sum(t); } \
        const float sv = c4 == 0 ? s[0] : c4 == 1 ? s[1] : c4 == 2 ? s[2] : s[3]; \
        lg[(16 * (4 * (B) + rr) + kq) * 4 + c4] = sv; } } while (0)
    { v4u kdA[4][4], kdB[4][4];
      SA_QK_LOAD(kdA, 0); SA_QK_LOAD(kdB, 1); SA_QK_COMP(kdA, 0); SA_QK_LOAD(kdA, 2); SA_QK_COMP(kdB, 1); SA_QK_LOAD(kdB, 3); SA_QK_COMP(kdA, 2); SA_QK_COMP(kdB, 3); }
#undef SA_QK_LOAD
#undef SA_QK_COMP
    LDS_WAIT();
    float l[4][4];
#pragma unroll
    for (int k = 0; k < 4; ++k) { const int j = lane + 64 * k; const f32x4 l4 = *(const LAS f32x4*)(lg + 4 * j); const int key = idxl[j]; const int bk = t5_bucket(qpos - key);
        const f32x4 b4 = *(const LAS f32x4*)(biasl + bk * 16 + 4 * g); const bool valid = j < cnt;
#pragma unroll
        for (int hq = 0; hq < 4; ++hq) l[k][hq] = valid ? l4[hq] * QK_SCALE + b4[hq] : -INFINITY; }
    LDS_WAIT();
#pragma unroll
    for (int hq = 0; hq < 4; ++hq) { float m = __builtin_fmaxf(__builtin_fmaxf(l[0][hq], l[1][hq]), __builtin_fmaxf(l[2][hq], l[3][hq]));
#pragma unroll
        for (int o = 1; o < 64; o <<= 1) m = __builtin_fmaxf(m, __shfl_xor(m, o));
        float sum = 0.f;
#pragma unroll
        for (int k = 0; k < 4; ++k) { l[k][hq] = __expf(l[k][hq] - m); sum += l[k][hq]; }
        sum = wave_sum(sum); const float inv = 1.0f / sum;
#pragma unroll
        for (int k = 0; k < 4; ++k) l[k][hq] *= inv; }
#pragma unroll
    for (int k = 0; k < 4; ++k) { const int j = lane + 64 * k; *(LAS f32x4*)(lg + 4 * j) = (f32x4){l[k][0], l[k][1], l[k][2], l[k][3]}; }
    LDS_WAIT();
    const int ks = lane >> 4, dc = lane & 15;
    f32x2 o[4][4];
#pragma unroll
    for (int hq = 0; hq < 4; ++hq)
#pragma unroll
        for (int i = 0; i < 4; ++i) o[hq][i] = (f32x2){0.f, 0.f};
    const bf16* vp = Vb + 8 * dc;
#define SA_PV_LOAD(W, B) do { _Pragma("unroll") for (int u = 0; u < 16; ++u) { const int key = idxl[64 * (B) + 4 * u + ks]; W[u] = *(const v4u*)(vp + (size_t)key * KVW); } } while (0)
#define SA_PV_COMP(W, B) do { _Pragma("unroll") for (int u = 0; u < 16; ++u) { const f32x4 p4 = *(const LAS f32x4*)(lg + 4 * (64 * (B) + 4 * u + ks)); \
        const f32x2 v0 = (f32x2){bf_lo(W[u].x), bf_hi(W[u].x)}, v1 = (f32x2){bf_lo(W[u].y), bf_hi(W[u].y)}, v2 = (f32x2){bf_lo(W[u].z), bf_hi(W[u].z)}, v3 = (f32x2){bf_lo(W[u].w), bf_hi(W[u].w)}; \
        _Pragma("unroll") for (int hq = 0; hq < 4; ++hq) { const float ph = p4[hq]; o[hq][0] += ph * v0; o[hq][1] += ph * v1; o[hq][2] += ph * v2; o[hq][3] += ph * v3; } } } while (0)
    { v4u wA[16], wB[16];
      SA_PV_LOAD(wA, 0); SA_PV_LOAD(wB, 1); SA_PV_COMP(wA, 0); SA_PV_LOAD(wA, 2); SA_PV_COMP(wB, 1); SA_PV_LOAD(wB, 3); SA_PV_COMP(wA, 2); SA_PV_COMP(wB, 3); }
#undef SA_PV_LOAD
#undef SA_PV_COMP
    v4u st = (v4u){0u, 0u, 0u, 0u};
#pragma unroll
    for (int hq = 0; hq < 4; ++hq) { unsigned pk[4];
#pragma unroll
        for (int i = 0; i < 4; ++i) { float x = o[hq][i].x, y = o[hq][i].y; x += __shfl_xor(x, 16); x += __shfl_xor(x, 32); y += __shfl_xor(y, 16); y += __shfl_xor(y, 32); pk[i] = pk2(x, y); }
        if (ks == hq) st = (v4u){pk[0], pk[1], pk[2], pk[3]}; }
    *(v4u*)(OB + (size_t)row * DM + (4 * g + ks) * HD + 8 * dc) = st;
    LDS_WAIT();
}
__device__ __forceinline__ void sattn_phase(const Ctx& C, const float* rel_bias, const bf16* QB, const bf16* KAP, const bf16* VAP, const bf16* KAS, const bf16* VAS, const int* IDX, const int* CNT, bf16* OB) {
    LAS float* biasl = (LAS float*)C.lds;
    LAS int* idxl = (LAS int*)(C.lds + 2048 + C.wave * 5120); LAS float* lg = (LAS float*)(C.lds + 2048 + C.wave * 5120 + 1024);
    if (C.tid < 512) biasl[C.tid] = rel_bias[C.tid];
    __syncthreads();
    const int x8 = C.bx & 7, g = x8 & 3, par = x8 >> 2, wi = (C.bx >> 3) * NWAVES + C.wave, nw = (C.G >> 3) * NWAVES;
    for (int k = wi; k < SEQ + 512; k += nw) {
        if (k < SEQ) { const int row = par * SEQ + k;
            sattn_task(row, g, k, KAP + (size_t)par * SEQ * KVW + g * HD, VAP + (size_t)par * SEQ * KVW + g * HD, CNT[row], IDX + (size_t)row * TOPK, QB, OB, idxl, lg, biasl, C.lane); }
        else { const int j = k - SEQ, b = 2 * (j >> 6) + par, i = j & 63, row = MP + b * DECS + i;
            sattn_task(row, g, PAST + i, KAS + (size_t)b * SALL * KVW + g * HD, VAS + (size_t)b * SALL * KVW + g * HD, CNT[row], IDX + (size_t)row * TOPK, QB, OB, idxl, lg, biasl, C.lane); }
    }
}

constexpr int VT_PITCH = 320, SB_NTASK = 8192 + 512;
typedef short v4i16_t __attribute__((ext_vector_type(4)));
__device__ __forceinline__ bf16x8 pack8(const f32x4& a, const f32x4& b) { v4u w; w.x = pk2(a.x, a.y); w.y = pk2(a.z, a.w); w.z = pk2(b.x, b.y); w.w = pk2(b.z, b.w); return __builtin_bit_cast(bf16x8, w); }
__device__ __forceinline__ void sb_task(bool samp, int b, int h, int qpos0, int r0, const bf16* QB, const bf16* KBB, const bf16* VBB, const float* kcache, const float* vcache, bf16* OB, LAS unsigned char* vt, int lane) {
    const int q = lane & 31, hh = lane >> 5;
    bf16x8 qf[8];
    { const bf16* qp = QB + (size_t)(r0 + q) * DM + h * HD + 8 * hh;
#pragma unroll
      for (int kk = 0; kk < 8; ++kk) qf[kk] = *(const bf16x8*)(qp + 16 * kk); }
    f32x16 O[4];
#pragma unroll
    for (int db = 0; db < 4; ++db)
#pragma unroll
        for (int r = 0; r < 16; ++r) O[db][r] = 0.f;
    float R = 1.f; const int t = qpos0 + q;
    const int vkey = lane >> 1, vch0 = (lane & 1) * 8;
    const int rowbase = samp ? (MP + b * DECS - PAST) : b * SEQ;
    bf16x8 kf[8]; v4u vr[8]; bool have = false;
    for (int kt = qpos0 >> 5; kt >= 0; --kt) {
        const bool f32t = samp && (32 * kt < PAST);
        if (f32t) {
            const float* kl = kcache + ((size_t)(b * PAST + 32 * kt + q) * 16 + h) * HD + 8 * hh;
#pragma unroll
            for (int kk = 0; kk < 8; ++kk) { const f32x4 a = *(const f32x4*)(kl + 16 * kk), bq = *(const f32x4*)(kl + 16 * kk + 4); kf[kk] = pack8(a, bq); }
#pragma unroll
            for (int i = 0; i < 8; ++i) { const float* vl = vcache + ((size_t)(b * PAST + 32 * kt + vkey) * 16 + h) * HD + 8 * (vch0 + i); const f32x4 a = *(const f32x4*)vl, bq = *(const f32x4*)(vl + 4); vr[i] = __builtin_bit_cast(v4u, pack8(a, bq)); }
        } else if (!have) {
            const bf16* kl = KBB + (size_t)(rowbase + 32 * kt + q) * DM + h * HD + 8 * hh;
#pragma unroll
            for (int kk = 0; kk < 8; ++kk) kf[kk] = *(const bf16x8*)(kl + 16 * kk);
#pragma unroll
            for (int i = 0; i < 8; ++i) vr[i] = *(const v4u*)(VBB + (size_t)(rowbase + 32 * kt + vkey) * DM + h * HD + 8 * (vch0 + i));
        }
#pragma unroll
        for (int i = 0; i < 8; ++i) *(LAS v4u*)(vt + vkey * VT_PITCH + 16 * (vch0 + i)) = vr[i];
        f32x16 c;
#pragma unroll
        for (int r = 0; r < 16; ++r) c[r] = 0.f;
#pragma unroll
        for (int kk = 0; kk < 8; ++kk) c = MFMA32(kf[kk], qf[kk], c);
        have = false;
        if (kt > 0 && !(samp && (32 * (kt - 1) < PAST))) { have = true;
            const bf16* kl = KBB + (size_t)(rowbase + 32 * (kt - 1) + q) * DM + h * HD + 8 * hh;
#pragma unroll
            for (int kk = 0; kk < 8; ++kk) kf[kk] = *(const bf16x8*)(kl + 16 * kk);
#pragma unroll
            for (int i = 0; i < 8; ++i) vr[i] = *(const v4u*)(VBB + (size_t)(rowbase + 32 * (kt - 1) + vkey) * DM + h * HD + 8 * (vch0 + i));
        }
        float om[16], be[16];
#pragma unroll
        for (int r = 0; r < 16; ++r) { const int s = 32 * kt + crow(r, hh); const float z = c[r] * QK_SCALE; const float a = __expf(-__builtin_fabsf(z)); const float rr = __builtin_amdgcn_rcpf(1.0f + a), ar = a * rr;
            const bool m = s < t; const float beta = z > 0.f ? rr : ar, omb = z > 0.f ? ar : rr; om[r] = m ? omb : 1.f; be[r] = m ? beta : 0.f; }
        float pg[4], pp[4], tt[4];
#pragma unroll
        for (int gi = 0; gi < 4; ++gi) { pg[gi] = (om[4 * gi] * om[4 * gi + 1]) * (om[4 * gi + 2] * om[4 * gi + 3]); pp[gi] = __shfl_xor(pg[gi], 32); tt[gi] = pg[gi] * pp[gi]; }
        float SB[4]; SB[3] = 1.f; SB[2] = tt[3]; SB[1] = tt[3] * tt[2]; SB[0] = SB[1] * tt[1];
        float A[16];
#pragma unroll
        for (int gi = 0; gi < 4; ++gi) { const float s3 = R * SB[gi] * (hh == 0 ? pp[gi] : 1.f), s2 = s3 * om[4 * gi + 3], s1 = s2 * om[4 * gi + 2], s0 = s1 * om[4 * gi + 1];
            A[4 * gi + 3] = be[4 * gi + 3] * s3; A[4 * gi + 2] = be[4 * gi + 2] * s2; A[4 * gi + 1] = be[4 * gi + 1] * s1; A[4 * gi] = be[4 * gi] * s0; }
        R = R * (SB[0] * tt[0]);
        bf16x8 pf[2];
#pragma unroll
        for (int s = 0; s < 2; ++s) { v4u w; w.x = pk2(A[8 * s], A[8 * s + 1]); w.y = pk2(A[8 * s + 2], A[8 * s + 3]); w.z = pk2(A[8 * s + 4], A[8 * s + 5]); w.w = pk2(A[8 * s + 6], A[8 * s + 7]); pf[s] = __builtin_bit_cast(bf16x8, w); }
        { const int i16 = lane & 15, qq = i16 >> 2, pq = i16 & 3, blk = (lane >> 4) & 1;
          LAS unsigned char* vb0 = vt + (4 * hh + qq) * VT_PITCH + (16 * blk + 4 * pq) * 2;
#pragma unroll
          for (int db = 0; db < 4; ++db)
#pragma unroll
              for (int s = 0; s < 2; ++s) { LAS unsigned char* ap = vb0 + (16 * s) * VT_PITCH + 64 * db;
                  const v4i16_t lo = __builtin_amdgcn_ds_read_tr16_b64_v4i16((LAS v4i16_t*)ap), hi2 = __builtin_amdgcn_ds_read_tr16_b64_v4i16((LAS v4i16_t*)(ap + 8 * VT_PITCH));
                  const bf16x8 af = __builtin_shufflevector(lo, hi2, 0, 1, 2, 3, 4, 5, 6, 7); O[db] = MFMA32(af, pf[s], O[db]); } }
        LDS_WAIT();
        if (__all(R == 0.f)) break;
    }
#pragma unroll
    for (int db = 0; db < 4; ++db)
#pragma unroll
        for (int rg = 0; rg < 4; ++rg) { v2u w; w.x = pk2(O[db][4 * rg], O[db][4 * rg + 1]); w.y = pk2(O[db][4 * rg + 2], O[db][4 * rg + 3]);
            *(v2u*)(OB + (size_t)(r0 + q) * DM + h * HD + 32 * db + 8 * rg + 4 * hh) = w; }
}
__device__ __forceinline__ void sbattn_phase(const Ctx& C, unsigned* qhead, const bf16* QB, const bf16* KBB, const bf16* VBB, const float* kcache, const float* vcache, bf16* OB) {
    LAS unsigned char* vt = C.lds + C.wave * (32 * VT_PITCH);
    int id = 0; if (C.lane == 0) id = (int)__hip_atomic_fetch_add(qhead, 1u, RLX_AGENT); id = __builtin_amdgcn_readfirstlane(id);
    while (id < SB_NTASK) {
        int nid = 0; if (C.lane == 0) nid = (int)__hip_atomic_fetch_add(qhead, 1u, RLX_AGENT);
        if (id < 512) { const int b = id >> 5, h = (id >> 1) & 15, hf = id & 1; sb_task(true, b, h, PAST + 32 * hf, MP + b * DECS + 32 * hf, QB, KBB, VBB, kcache, vcache, OB, vt, C.lane); }
        else { const int j = id - 512, b = j >> 12, h = (j >> 8) & 15, qt = j & 255; sb_task(false, b, h, qt * 32, b * SEQ + qt * 32, QB, KBB, VBB, kcache, vcache, OB, vt, C.lane); }
        id = __builtin_amdgcn_readfirstlane(nid);
    }
}

struct Args { const float* in[22]; float* out; unsigned char* ws; int ph_lo, ph_hi; };
__global__ void __launch_bounds__(NTHREADS, 2) mk_fwd(Args args) {
    extern __shared__ __attribute__((aligned(16))) unsigned char lds_raw[];
    Ctx C;
    C.lds = (LAS unsigned char*)lds_raw; C.MISC = (volatile LAS unsigned*)(C.lds + MISC_OFF);
    C.tid = threadIdx.x; C.lane = C.tid & 63; C.wave = __builtin_amdgcn_readfirstlane(C.tid >> 6);
    C.G = gridDim.x; C.bx = blockIdx.x; C.gw = C.bx * NWAVES + C.wave; C.NGW = C.G * NWAVES;
    unsigned char* ws = args.ws; unsigned* ctl = (unsigned*)(ws + WS_CTL); float* out = args.out;
    for (int u = C.tid; u < (LDS_BYTES - LDSCTL_OFF) / 4; u += NTHREADS) ((LAS unsigned*)(C.lds + LDSCTL_OFF))[u] = 0u;
    __syncthreads();
    XcdBarrier bar; bar.bar = ctl + CW_BAR; bar.x = 0; bar.st = nullptr;
    if (!MK_PER_PHASE) bar = xcd_barrier_post(ctl + CW_BAR, C.MISC + 8);
    const int lo = args.ph_lo, hi = args.ph_hi;
#define IN(k) (lo <= (k) && (k) < hi)
#define PH_ON(k) ((MK_PH_MASK >> (k)) & 1u)
#define SEAM(k) do { if (!MK_PER_PHASE && IN(k) && IN((k) + 1)) xcd_barrier(bar); } while (0)
    const float *x_prompt = args.in[0], *x_sample = args.in[1], *cache_k_a = args.in[2], *cache_v_a = args.in[3], *cache_kidx_a = args.in[4], *cache_k_b = args.in[5], *cache_v_b = args.in[6];
    const float *p_prompt = args.in[7], *p_sample = args.in[8], *rel_bias = args.in[9], *w_in_a = args.in[10], *w_out_a = args.in[11], *w_in_b = args.in[12], *w_out_b = args.in[13];
    const float *ln1_g = args.in[14], *ln1_b = args.in[15], *ln2_g = args.in[16], *ln2_b = args.in[17], *w_up = args.in[18], *w_down = args.in[19], *w_ple = args.in[20], *w_ple_gate = args.in[21];
    bf16 *WINA = (bf16*)(ws + WS_WINA), *WOUTA = (bf16*)(ws + WS_WOUTA), *WINB = (bf16*)(ws + WS_WINB), *WOUTB = (bf16*)(ws + WS_WOUTB), *WUP = (bf16*)(ws + WS_WUP), *WDOWN = (bf16*)(ws + WS_WDOWN), *WG = (bf16*)(ws + WS_WG), *WP = (bf16*)(ws + WS_WP);
    bf16 *PB = (bf16*)(ws + WS_PB), *XB = (bf16*)(ws + WS_XB), *X1B = (bf16*)(ws + WS_X1B), *X2B = (bf16*)(ws + WS_X2B), *QB = (bf16*)(ws + WS_QB), *OB = (bf16*)(ws + WS_OB), *QIB = (bf16*)(ws + WS_QIB);
    bf16 *KAP = (bf16*)(ws + WS_KAP), *VAP = (bf16*)(ws + WS_VAP), *KAS = (bf16*)(ws + WS_KAS), *VAS = (bf16*)(ws + WS_VAS), *KIP = (bf16*)(ws + WS_KIP), *KIS = (bf16*)(ws + WS_KIS), *HB = (bf16*)(ws + WS_H), *KBB = (bf16*)(ws + WS_KBB), *VBB = (bf16*)(ws + WS_VBB);
    float *WI = (float*)(ws + WS_WI), *RES = (float*)(ws + WS_RES), *Y0 = (float*)(ws + WS_Y0), *PW = (float*)(ws + WS_PW), *SCP = (float*)(ws + WS_SCP), *SCS = (float*)(ws + WS_SCS), *PART = (float*)(ws + WS_PART);
    int *IDX = (int*)(ws + WS_IDX), *CNT = (int*)(ws + WS_CNT);

    if (IN(0)) for (int rep_ = 0; rep_ < NREP(2); ++rep_) {
        transpose_job(C, w_in_a, DM, NINA, NINA_PAD, WINA); transpose_job(C, w_out_a, DM, DM, DM, WOUTA); transpose_job(C, w_in_b, DM, NINB, NINB, WINB); transpose_job(C, w_out_b, DM, DM, DM, WOUTB);
        for (int l = 0; l < 2; ++l) { transpose_job(C, w_up + (size_t)l * DM * DFF, DM, DFF, DFF, WUP + (size_t)l * DFF * DM); transpose_job(C, w_down + (size_t)l * DFF * DM, DFF, DM, DM, WDOWN + (size_t)l * DM * DFF);
            transpose_job(C, w_ple_gate + (size_t)l * DM * DM, DM, DM, DM, WG + (size_t)l * DM * DM); transpose_job(C, w_ple + (size_t)l * PLE * DM, PLE, DM, DM, WP + (size_t)l * DM * PLE); }
        cvt_job(C, x_prompt, XB, 1, MP * DM, 0, 0); cvt_job(C, x_sample, XB + (size_t)MP * DM, 1, MS * DM, 0, 0);
        for (int l = 0; l < 2; ++l) { cvt_job(C, p_prompt + (size_t)l * MP * PLE, PB + (size_t)l * MT * PLE, 1, MP * PLE, 0, 0); cvt_job(C, p_sample + (size_t)l * MS * PLE, PB + (size_t)l * MT * PLE + (size_t)MP * PLE, 1, MS * PLE, 0, 0); }
        cvt_job(C, cache_k_a, KAS, DECB, PAST * KVW, (size_t)PAST * KVW, (size_t)SALL * KVW); cvt_job(C, cache_v_a, VAS, DECB, PAST * KVW, (size_t)PAST * KVW, (size_t)SALL * KVW);
        cvt_job(C, cache_kidx_a, KIS, DECB, PAST * HD, (size_t)PAST * HD, (size_t)SALL * HD);
    }
    SEAM(0);
#define LAYER_BODY(l) do { \
        const int pb = (l == 0) ? 5 : 13; \
        if (l == 0) { \
            if (IN(1) && PH_ON(1)) { pg8::Gemm g{XB, WINA, MT, NINA_PAD, DM, DM}; pg8::StaticOrder S; S.init(MT, NINA_PAD, C.G, C.bx); \
                pg8::EpiInA E{QB, QIB, KAP, KIP, WI, out}; \
                pg8::gemm_phase<pg8::EpiInA, pg8::StaticOrder, true, true>(C.lds, g, S, E); if (NREP(0) > 1) { pg8::gemm_phase<pg8::EpiInA, pg8::StaticOrder, true, true>(C.lds, g, S, E); } } \
            SEAM(1); \
            if (IN(2) && PH_ON(2)) for (int rep_ = 0; rep_ < NREP2(1, 4); ++rep_) scores_phase(C, ctl + CW_QSC + 64 * rep_, QIB, KIP, KIS, WI, SCP, SCS); \
            SEAM(2); \
            if (IN(3) && PH_ON(3)) for (int rep_ = 0; rep_ < NREP2(1, 5); ++rep_) select_phase(C, SCP, SCS, IDX, CNT); \
            SEAM(3); \
            if (IN(4) && PH_ON(4)) for (int rep_ = 0; rep_ < NREP2(1, 6); ++rep_) sattn_phase(C, rel_bias, QB, KAP, VAP, KAS, VAS, IDX, CNT, OB); \
            SEAM(4); \
        } else { \
            if (IN(11) && PH_ON(11)) { pg8::Gemm g{XB, WINB, MT, NINB, DM, DM}; pg8::StaticOrder S; S.init(MT, NINB, C.G, C.bx); \
                pg8::EpiInB E{QB, KBB, out}; \
                pg8::gemm_phase<pg8::EpiInB, pg8::StaticOrder, true, true>(C.lds, g, S, E); if (NREP(0) > 1) { pg8::gemm_phase<pg8::EpiInB, pg8::StaticOrder, true, true>(C.lds, g, S, E); } } \
            SEAM(11); \
            if (IN(12) && PH_ON(12)) for (int rep_ = 0; rep_ < NREP(3); ++rep_) sbattn_phase(C, ctl + CW_QSB + 64 * rep_, QB, KBB, VBB, cache_k_b, cache_v_b, OB); \
            SEAM(12); \
        } \
        if (IN(pb) && PH_ON(pb)) { \
            { pg8::Gemm g{OB, l == 0 ? WOUTA : WOUTB, MP, DM, DM, DM}; pg8::StaticOrder S; S.init(MP, DM, C.G, C.bx); pg8::EpiResid E{l == 0 ? x_prompt : Y0, RES}; \
              GEMM2X((pg8::gemm_phase<pg8::EpiResid, pg8::StaticOrder, true, true>(C.lds, g, S, E))); } \
            { int ksl = 256; asm volatile("" : "+s"(ksl)); pg8::Gemm g{OB, l == 0 ? WOUTA : WOUTB, MT, DM, ksl, DM}; pg8::SplitOrder S{C.G, C.bx}; pg8::EpiPart E{PART}; \
              GEMM2X((pg8::gemm_phase<pg8::EpiPart, pg8::SplitOrder, true, true>(C.lds, g, S, E))); } } \
        SEAM(pb); \
        if (IN(pb + 1) && PH_ON(pb + 1)) ln_phase(C, RES, X1B, ln1_g + l * DM, ln1_b + l * DM, l == 0 ? x_sample - (size_t)MP * DM : Y0, PART); \
        SEAM(pb + 1); \
        if (IN(pb + 2) && PH_ON(pb + 2)) { pg8::Gemm g{X1B, WUP + (size_t)l * DFF * DM, MT, DFF, DM, DM}; pg8::StaticOrder S; S.init(MT, DFF, C.G, C.bx); \
            pg8::EpiSqRelu E{HB}; \
            GEMM2X((pg8::gemm_phase<pg8::EpiSqRelu, pg8::StaticOrder, true, true>(C.lds, g, S, E))); } \
        SEAM(pb + 2); \
        if (IN(pb + 3) && PH_ON(pb + 3)) { \
            { pg8::Gemm g{HB, WDOWN + (size_t)l * DM * DFF, MP, DM, DFF, DFF}; pg8::StaticOrder S; S.init(MP, DM, C.G, C.bx); pg8::EpiResid E{RES, RES}; \
              if (NREP(0) > 1) { pg8::EpiResid E2{RES, PW}; pg8::gemm_phase<pg8::EpiResid, pg8::StaticOrder, true, true>(C.lds, g, S, E2); } \
              pg8::gemm_phase<pg8::EpiResid, pg8::StaticOrder, true, true>(C.lds, g, S, E); } \
            { int ksl = 1024; asm volatile("" : "+s"(ksl)); pg8::Gemm g{HB, WDOWN + (size_t)l * DM * DFF, MT, DM, ksl, DFF}; pg8::SplitOrder S{C.G, C.bx}; pg8::EpiPart E{PART}; \
              GEMM2X((pg8::gemm_phase<pg8::EpiPart, pg8::SplitOrder, true, true>(C.lds, g, S, E))); } } \
        SEAM(pb + 3); \
        if (IN(pb + 4) && PH_ON(pb + 4)) ln_phase(C, RES, X2B, ln2_g + l * DM, ln2_b + l * DM, RES, PART); \
        SEAM(pb + 4); \
        if (IN(pb + 5) && PH_ON(pb + 5)) { \
            if (MK_GATE_PART & 1) { int kple = PLE; asm volatile("" : "+s"(kple)); pg8::Gemm g{PB + (size_t)l * MT * PLE, WP + (size_t)l * DM * PLE, MT, DM, kple, PLE}; pg8::StaticOrder S; S.init(MT, DM, C.G, C.bx); \
              pg8::EpiStoreF32 E{PW}; \
              pg8::gemm_phase<pg8::EpiStoreF32, pg8::StaticOrder, true, true>(C.lds, g, S, E); if (NREP(0) > 1) { pg8::gemm_phase<pg8::EpiStoreF32, pg8::StaticOrder, true, true>(C.lds, g, S, E); } } \
            VM_WAIT(); __syncthreads(); \
            if (MK_GATE_PART & 2) { pg8::Gemm g{X2B, WG + (size_t)l * DM * DM, MT, DM, DM, DM}; pg8::StaticOrder S; S.init(MT, DM, C.G, C.bx); \
              pg8::EpiGate E{RES, PW, l == 0 ? Y0 : out + O_Y, l == 0 ? XB : (bf16*)nullptr}; \
              pg8::gemm_phase<pg8::EpiGate, pg8::StaticOrder, true, true>(C.lds, g, S, E); if (NREP(0) > 1) { pg8::gemm_phase<pg8::EpiGate, pg8::StaticOrder, true, true>(C.lds, g, S, E); } } \
        } \
        SEAM(pb + 5); \
    } while (0)
    LAYER_BODY(0);
    LAYER_BODY(1);
#undef LAYER_BODY
#undef IN
#undef SEAM
}

extern "C" void kernel_launch(void* const* d_in, const int* in_sizes, int n_in, void* d_out, int out_size, void* d_ws, size_t ws_size, hipStream_t stream) {
    static int grid = 0;
    if (grid == 0) {
        if (n_in != 22 || out_size != (int)O_END || ws_size < WS_END) { fprintf(stderr, "kernel_launch: unexpected shapes (n_in %d, out %d, ws %zu)\n", n_in, out_size, ws_size); grid = -1; return; }
        int dev = 0, cus = 0;
        if (hipGetDevice(&dev) != hipSuccess || hipDeviceGetAttribute(&cus, hipDeviceAttributeMultiprocessorCount, dev) != hipSuccess) { grid = -1; return; }
        if (hipFuncSetAttribute((const void*)mk_fwd, hipFuncAttributeMaxDynamicSharedMemorySize, LDS_BYTES) != hipSuccess) { fprintf(stderr, "kernel_launch: hipFuncSetAttribute failed\n"); grid = -1; return; }
        int per_cu = 0;
        if (hipOccupancyMaxActiveBlocksPerMultiprocessor(&per_cu, (const void*)mk_fwd, NTHREADS, LDS_BYTES) != hipSuccess || per_cu < 1) fprintf(stderr, "kernel_launch: occupancy query reports %d\n", per_cu);
        (void)hipGetLastError();
        grid = cus - (cus % 8);
        if (grid < 8) grid = 8;
    }
    if (grid < 0) return;
    if (hipMemsetAsync((char*)d_ws + WS_CTL, 0, CTL_ZERO_BYTES, stream) != hipSuccess) return;
    Args a{};
    for (int i = 0; i < 22; ++i) a.in[i] = (const float*)d_in[i];
    a.out = (float*)d_out; a.ws = (unsigned char*)d_ws;
#if MK_PER_PHASE
    for (int p = 0; p < NPH; ++p) { a.ph_lo = p; a.ph_hi = p + 1; hipLaunchKernelGGL(mk_fwd, dim3(grid), dim3(NTHREADS), LDS_BYTES, stream, a); }
#else
    a.ph_lo = 0; a.ph_hi = NPH;
    hipLaunchKernelGGL(mk_fwd, dim3(grid), dim3(NTHREADS), LDS_BYTES, stream, a);
#endif
}
```

```cpp
#include <hip/hip_runtime.h>
#include <cstdio>
#include <cstdint>
#ifndef MK_PER_PHASE
#define MK_PER_PHASE 0
#endif
#ifndef MK_PH_MASK
#define MK_PH_MASK 0xffffffffu
#endif
constexpr int NWAVES = 8, NTHREADS = 512;
constexpr int DM = 2048, SEQ = 8192, MP = 16384, DECB = 16, DECS = 64, MS = 1024, MT = 17408, PAST = 4096, SALL = 4160;
constexpr int NINA = 5264, NINA_PAD = 5376, NINB = 6144, DFF = 8192, PLE = 256, HD = 128, KVW = 512, TOPK = 256;
constexpr float LN_EPS = 1e-5f, ALPHA = 1.41421356237309515f;
constexpr float QK_SCALE = 0.08838834764831845f;
constexpr float WI_SCALE = 0.25f * 0.08838834764831845f;
constexpr int NPH = 19;

constexpr size_t O_Y = 0;
constexpr size_t O_KAP = (size_t)MT * DM, O_VAP = O_KAP + (size_t)MP * KVW, O_KIP = O_VAP + (size_t)MP * KVW;
constexpr size_t O_KBP = O_KIP + (size_t)MP * HD, O_VBP = O_KBP + (size_t)MP * DM;
constexpr size_t O_KAS = O_VBP + (size_t)MP * DM, O_VAS = O_KAS + (size_t)MS * KVW, O_KIS = O_VAS + (size_t)MS * KVW;
constexpr size_t O_KBS = O_KIS + (size_t)MS * HD, O_VBS = O_KBS + (size_t)MS * DM, O_END = O_VBS + (size_t)MS * DM;
static_assert(O_END == 127008768, "d_out layout");

constexpr size_t MiB = 1u << 20;
constexpr size_t WS_CTL = 0, CTL_ZERO_BYTES = 1 * MiB;
constexpr size_t WS_WINA = 2 * MiB, WS_WOUTA = 23 * MiB, WS_WINB = 31 * MiB, WS_WOUTB = 55 * MiB, WS_WUP = 63 * MiB, WS_WDOWN = 127 * MiB, WS_WG = 191 * MiB, WS_WP = 207 * MiB;
constexpr size_t WS_PB = 210 * MiB, WS_XB = 228 * MiB, WS_X1B = 296 * MiB, WS_X2B = 364 * MiB, WS_QB = 432 * MiB, WS_OB = 500 * MiB, WS_QIB = 568 * MiB;
constexpr size_t WS_KAP = 636 * MiB, WS_VAP = 652 * MiB, WS_KAS = 668 * MiB, WS_VAS = 733 * MiB, WS_KIP = 798 * MiB, WS_KIS = 802 * MiB, WS_WI = 819 * MiB;
constexpr size_t WS_IDX = 821 * MiB, WS_CNT = 838 * MiB, WS_RES = 840 * MiB, WS_Y0 = 976 * MiB, WS_PW = 1112 * MiB, WS_H = 1248 * MiB;
constexpr size_t WS_SCP = 1248 * MiB  , WS_SCS = 1760 * MiB, WS_PART = 1778 * MiB  , WS_PBUF = 1842 * MiB  , WS_END = 1978 * MiB;
static_assert(WS_WINA + (size_t)NINA_PAD * DM * 2 <= WS_WOUTA && WS_PB + (size_t)2 * MT * PLE * 2 <= WS_XB && WS_XB + (size_t)MT * DM * 2 <= WS_X1B && WS_KAS + (size_t)DECB * SALL * KVW * 2 <= WS_VAS
              && WS_KIS + (size_t)DECB * SALL * HD * 2 <= WS_WI && WS_WI + (size_t)MT * 16 * 4 <= WS_IDX && WS_IDX + (size_t)MT * TOPK * 4 <= WS_CNT && WS_RES + (size_t)MT * DM * 4 <= WS_Y0
              && WS_H + (size_t)MT * DFF * 2 <= WS_SCS && WS_SCP + (size_t)MP * SEQ * 4 <= WS_SCS && WS_SCS + (size_t)MS * SALL * 4 <= WS_PART && WS_PART + (size_t)8 * MS * DM * 4 <= WS_PBUF && WS_PBUF + (size_t)8 * 8704 * 1024 * 2 <= WS_END && WS_END <= 2048 * MiB, "d_ws map");
constexpr size_t WS_KBB = WS_QIB, WS_VBB = WS_KAP;
static_assert(WS_VBB + (size_t)MT * DM * 2 <= WS_KIP, "VBB overlay");
constexpr size_t D_VBB = (WS_VBB - WS_KBB) / 2;
constexpr size_t D_VAP = WS_VAP - WS_KAP, D_KAS = WS_KAS - WS_KAP, D_VAS = WS_VAS - WS_KAP;
constexpr size_t D_KIS = (WS_KIS - WS_KIP) / 2;
constexpr int CW_BAR = 4096;
constexpr int CW_QSA = 12288;
constexpr int CW_QSB = 8448;
constexpr int CW_QSC = 8192;

constexpr int RING_BYTES = 135168;
constexpr int LDSCTL_OFF = RING_BYTES, MISC_OFF = LDSCTL_OFF + 320;
constexpr int LDS_BYTES = 147456;
static_assert(MISC_OFF + 128 <= LDS_BYTES, "LDS map");

#define GAS __attribute__((address_space(1)))
#define LAS __attribute__((address_space(3)))
typedef unsigned short bf16;
typedef unsigned v4u __attribute__((ext_vector_type(4)));
typedef unsigned v2u __attribute__((ext_vector_type(2)));
typedef float f32x4 __attribute__((ext_vector_type(4)));
typedef float f32x2 __attribute__((ext_vector_type(2)));
typedef float f32x16 __attribute__((ext_vector_type(16)));
typedef short bf16x8 __attribute__((ext_vector_type(8)));
typedef __bf16 bf16x2_t __attribute__((ext_vector_type(2)));
#define LDS_WAIT() asm volatile("s_waitcnt lgkmcnt(0)" ::: "memory")
#define VM_WAIT() asm volatile("s_waitcnt vmcnt(0)" ::: "memory")
__device__ __forceinline__ unsigned pk2(float lo, float hi) { f32x2 v = {lo, hi}; bf16x2_t b = __builtin_convertvector(v, bf16x2_t); return __builtin_bit_cast(unsigned, b); }
__device__ __forceinline__ float bf_lo(unsigned w) { return __uint_as_float(w << 16); }
__device__ __forceinline__ float bf_hi(unsigned w) { return __uint_as_float(w & 0xffff0000u); }
__device__ __forceinline__ float dot2bf(unsigned a, unsigned b, float c) { return __builtin_amdgcn_fdot2_f32_bf16(__builtin_bit_cast(bf16x2_t, a), __builtin_bit_cast(bf16x2_t, b), c, false); }
namespace pg8 {
#define PG8_LAS __attribute__((address_space(3)))
typedef unsigned short bf16_t;
typedef short bf16x8 __attribute__((ext_vector_type(8)));
typedef float f32x4 __attribute__((ext_vector_type(4)));
typedef unsigned u32x4 __attribute__((ext_vector_type(4)));
constexpr int BM = 256, BK = 64, HALF = 128, HTB = HALF * BK * 2  , STAGE_BYTES = 8 * HTB, NXCD = 8, WGM = 8;

__host__ __device__ __forceinline__ int lds_byte(int r, int c) { const int st = (r >> 4) * 2 + (c >> 5), rr = r & 15, cc = c & 31, ob = rr * 64 + cc * 2; return st * 1024 + (ob ^ (((ob >> 9) & 1) << 5)); }
__host__ __device__ __forceinline__ void stage_rc(int b, int& R, int& C) { const int st = b / 1024, sb = b % 1024, swz = sb ^ (((sb >> 9) & 1) << 5); R = (st >> 1) * 16 + swz / 64; C = (st & 1) * 32 + (swz % 64) / 2; }
__host__ __device__ __forceinline__ int perm32(int rho) { const int n = rho >> 4, i = rho & 15; return 8 * (i >> 2) + 4 * n + (i & 3); }

struct Unit { int pm, pn, ks; };
struct Gemm { const bf16_t* A; const bf16_t* Bt; int M, N, K, ld; };

struct StaticOrder {
    int nM, nN, nwg, G, c;
    __host__ __device__ void init(int M, int N, int G_, int c_) { nM = M / BM; nN = N / BM; nwg = nM * nN; G = G_; c = c_; }
    __host__ __device__ bool next(int i, Unit& u) const {
        const long L = (long)i * G + c; if (L >= nwg) return false;
        int wgid = (int)L; { const int q = nwg / NXCD, r = nwg % NXCD, xcd = wgid % NXCD, off = wgid / NXCD; wgid = (xcd < r ? xcd * (q + 1) : r * (q + 1) + (xcd - r) * q) + off; }
        const int nig = WGM * nN, gid = wgid / nig, fm = gid * WGM, gsz = (nM - fm) < WGM ? (nM - fm) : WGM;
        u.pm = fm + ((wgid % nig) % gsz); u.pn = (wgid % nig) / gsz; u.ks = 0; return true;
    }
    __device__ __forceinline__ void a_ready(const Unit&) const {}
    __device__ __forceinline__ void done(const Unit&) const {}
};

__device__ __forceinline__ unsigned cvt_pk_bf16(float lo, float hi) { unsigned r; asm volatile("v_cvt_pk_bf16_f32 %0, %1, %2" : "=v"(r) : "v"(lo), "v"(hi)); return r; }
typedef float f32x2 __attribute__((ext_vector_type(2)));
__device__ __forceinline__ void st_bf16x8(bf16_t* p, const f32x4& a, const f32x4& b) { u32x4 w; w.x = ::pk2(a[0], a[1]); w.y = ::pk2(a[2], a[3]); w.z = ::pk2(b[0], b[1]); w.w = ::pk2(b[2], b[3]); *(u32x4*)p = w; }
__device__ __forceinline__ void st_f32x8(float* p, const f32x4& a, const f32x4& b) { *(f32x4*)p = a; *(f32x4*)(p + 4) = b; }
#define PG8_EPI_LOOP(...) \
    _Pragma("unroll") for (int ai = 0; ai < 2; ++ai) _Pragma("unroll") for (int m = 0; m < 4; ++m) { const int row = u.pm * BM + ai * HALF + wr * 64 + m * 16 + fr; \
        _Pragma("unroll") for (int bj = 0; bj < 2; ++bj) { const int cl = bj * HALF + wc * 32 + 8 * fq; const f32x4 v0 = acc[ai][bj][m][0], v1 = acc[ai][bj][m][1]; __VA_ARGS__ } }
#ifndef PG8_EPI_FENCE
#define PG8_EPI_FENCE(m) (((m) & 3) == 3)
#endif
#define PG8_EPI_LOOP_F(...) \
    _Pragma("unroll") for (int ai = 0; ai < 2; ++ai) _Pragma("unroll") for (int m = 0; m < 4; ++m) { const int row = u.pm * BM + ai * HALF + wr * 64 + m * 16 + fr; \
        _Pragma("unroll") for (int bj = 0; bj < 2; ++bj) { const int cl = bj * HALF + wc * 32 + 8 * fq; const f32x4 v0 = acc[ai][bj][m][0], v1 = acc[ai][bj][m][1]; __VA_ARGS__ } if (PG8_EPI_FENCE(m)) asm volatile("" ::: "memory"); }

__device__ __forceinline__ void st_fp8x8(unsigned char* p, const f32x4& a, const f32x4& b) { int lo = 0, hi = 0;
    lo = __builtin_amdgcn_cvt_pk_fp8_f32(a[0], a[1], lo, false); lo = __builtin_amdgcn_cvt_pk_fp8_f32(a[2], a[3], lo, true);
    hi = __builtin_amdgcn_cvt_pk_fp8_f32(b[0], b[1], hi, false); hi = __builtin_amdgcn_cvt_pk_fp8_f32(b[2], b[3], hi, true);
    typedef unsigned u32x2 __attribute__((ext_vector_type(2))); *(u32x2*)p = (u32x2){(unsigned)lo, (unsigned)hi}; }
struct EpiInA {
    static constexpr bool PERM = true, AFTER_DRAIN = false;
    bf16_t *Q, *QI, *KIP; unsigned char* KA8; float* WI; float* out;
    __device__ __forceinline__ void operator()(const f32x4 (&acc)[2][2][4][2], const Unit& u, int wr, int wc, int fr, int fq) const {
        const int pn = u.pn; const bool samp = u.pm >= 64;
        float* fb = nullptr; bf16_t* bb = nullptr; unsigned char* b8 = nullptr; int ld; bool remap = false;
        if (pn < 8) { bb = Q + pn * BM; ld = ::DM; }
        else if (pn < 12) { const bool isv = pn >= 10; const int c0 = (pn & 1) * BM; ld = ::KVW; remap = samp;
            fb = out + (samp ? (isv ? ::O_VAS : ::O_KAS) - (size_t)::MP * ::KVW : (isv ? ::O_VAP : ::O_KAP)) + c0;
            b8 = KA8 + (samp ? (isv ? ::D_VAS : ::D_KAS) : (isv ? ::D_VAP : (size_t)0)) + c0; }
        else if (pn < 20) { bb = QI + (pn - 12) * BM; ld = ::DM; }
        else { ld = ::HD; remap = samp; fb = out + (samp ? ::O_KIS - (size_t)::MP * ::HD : ::O_KIP); bb = KIP + (samp ? ::D_KIS : (size_t)0); }
        PG8_EPI_LOOP(
            const int rs = row - ::MP; const size_t brow = remap ? ((size_t)(rs >> 6) * ::SALL + ::PAST + (rs & 63)) : (size_t)row;
            if (pn == 20 && cl >= 128) { if (cl < 144) st_f32x8(WI + (size_t)row * 16 + (cl - 128), v0 * ::WI_SCALE, v1 * ::WI_SCALE); }
            else { if (fb) st_f32x8(fb + (size_t)row * ld + cl, v0, v1); if (b8) st_fp8x8(b8 + brow * ld + cl, v0, v1); else st_bf16x8(bb + brow * ld + cl, v0, v1); }
        )
    }
};
struct EpiInB {
    static constexpr bool PERM = true, AFTER_DRAIN = false;
    bf16_t* Q; bf16_t* KBB; float* out;
    __device__ __forceinline__ void operator()(const f32x4 (&acc)[2][2][4][2], const Unit& u, int wr, int wc, int fr, int fq) const {
        const int pn = u.pn; const bool samp = u.pm >= 64; const bool isv = pn >= 16;
        float* fb = nullptr; bf16_t* bb;
        if (pn < 8) bb = Q + pn * BM;
        else { const int c0 = (pn & 7) * BM; bb = KBB + (isv ? ::D_VBB : (size_t)0) + c0; fb = out + (samp ? (isv ? ::O_VBS : ::O_KBS) - (size_t)::MP * ::DM : (isv ? ::O_VBP : ::O_KBP)) + c0; }
        PG8_EPI_LOOP(
            if (fb) st_f32x8(fb + (size_t)row * ::DM + cl, v0, v1);
            st_bf16x8(bb + (size_t)row * ::DM + cl, v0, v1);
        )
    }
};
struct EpiResid {
    static constexpr bool PERM = true, AFTER_DRAIN = false;
    const float* x; float* RES;
    __device__ __forceinline__ void operator()(const f32x4 (&acc)[2][2][4][2], const Unit& u, int wr, int wc, int fr, int fq) const {
        const int pn = u.pn;
        PG8_EPI_LOOP_F(
            const size_t off = (size_t)row * ::DM + pn * BM + cl; const f32x4 x0 = *(const f32x4*)(x + off), x1 = *(const f32x4*)(x + off + 4);
            st_f32x8(RES + off, x0 * ::ALPHA + v0, x1 * ::ALPHA + v1);
        )
    }
};
struct EpiPart {
    static constexpr bool PERM = true, AFTER_DRAIN = false;
    float* PART;
    __device__ __forceinline__ void operator()(const f32x4 (&acc)[2][2][4][2], const Unit& u, int wr, int wc, int fr, int fq) const {
        const int pn = u.pn; float* base = PART + (size_t)u.ks * ::MS * ::DM;
        PG8_EPI_LOOP( st_f32x8(base + (size_t)(row - ::MP) * ::DM + pn * BM + cl, v0, v1); )
    }
};
struct SplitOrder {
    int G, c;
    __device__ __forceinline__ bool next(int i, Unit& u) const { const int L = i * G + c; if (L >= 256) return false; u.pm = 64 + (L & 3); u.pn = (L >> 2) & 7; u.ks = L >> 5; return true; }
    __device__ __forceinline__ void a_ready(const Unit&) const {}
    __device__ __forceinline__ void done(const Unit&) const {}
};
struct EpiSqRelu {
    static constexpr bool PERM = true, AFTER_DRAIN = false;
    bf16_t* H;
    __device__ __forceinline__ void operator()(const f32x4 (&acc)[2][2][4][2], const Unit& u, int wr, int wc, int fr, int fq) const {
        const int pn = u.pn;
        PG8_EPI_LOOP(
            f32x4 a = __builtin_elementwise_max(v0, (f32x4){0.f, 0.f, 0.f, 0.f}), b = __builtin_elementwise_max(v1, (f32x4){0.f, 0.f, 0.f, 0.f});
            st_bf16x8(H + (size_t)row * ::DFF + pn * BM + cl, a * a, b * b);
        )
    }
};
struct EpiStoreF32 {
    static constexpr bool PERM = true, AFTER_DRAIN = false;
    float* C;
    __device__ __forceinline__ void operator()(const f32x4 (&acc)[2][2][4][2], const Unit& u, int wr, int wc, int fr, int fq) const {
        const int pn = u.pn;
        PG8_EPI_LOOP( st_f32x8(C + (size_t)row * ::DM + pn * BM + cl, v0, v1); )
    }
};
struct EpiGate {
    static constexpr bool PERM = true, AFTER_DRAIN = false;
    const float* X2; const float* PW; float* Y; bf16_t* YB;
    __device__ __forceinline__ f32x4 sig(const f32x4& v) const { f32x4 r;
#pragma unroll
        for (int i = 0; i < 4; ++i) r[i] = __builtin_amdgcn_rcpf(1.0f + __expf(-v[i])); return r; }
    __device__ __forceinline__ void operator()(const f32x4 (&acc)[2][2][4][2], const Unit& u, int wr, int wc, int fr, int fq) const {
        const int pn = u.pn;
        PG8_EPI_LOOP_F(
            const size_t off = (size_t)row * ::DM + pn * BM + cl;
            const f32x4 y0 = *(const f32x4*)(X2 + off) + sig(v0) * *(const f32x4*)(PW + off), y1 = *(const f32x4*)(X2 + off + 4) + sig(v1) * *(const f32x4*)(PW + off + 4);
            st_f32x8(Y + off, y0, y1); if (YB) st_bf16x8(YB + off, y0, y1);
        )
    }
};
struct EpiNull {
    static constexpr bool PERM = true, AFTER_DRAIN = false;
    bf16_t* H;
    __device__ __forceinline__ void operator()(const f32x4 (&acc)[2][2][4][2], const Unit& u, int wr, int wc, int fr, int fq) const {
        const int pn = u.pn;
        PG8_EPI_LOOP( if (v0[0] == 1.2345e38f && v1[3] == -7.7e37f) st_bf16x8(H + (size_t)row * ::DFF + pn * BM + cl, v0, v1); )
    }
};
template <class Epi, class Sched, bool ALIGN_EPI = false, bool SP2 = false>
__device__ __forceinline__ void gemm_phase(PG8_LAS unsigned char* lds, const Gemm g, const Sched& S, const Epi& E) {
    const int tid = threadIdx.x, wid = __builtin_amdgcn_readfirstlane(tid >> 6), lane = tid & 63, wr = wid >> 2, wc = wid & 3, fr = lane & 15, fq = lane >> 4;
    const int K = g.ld, nt = g.K / BK;
    const size_t kslice = (size_t)g.K * 2;
    unsigned voffA[2], voffB[2];
#pragma unroll
    for (int i = 0; i < 2; ++i) { int R, C; stage_rc(tid * 16 + i * 8192, R, C); const int Rb = Epi::PERM ? ((R & ~31) + perm32(R & 31)) : R;
        voffA[i] = (unsigned)(R * K + C) * 2u; voffB[i] = (unsigned)(Rb * K + C) * 2u; }
    const size_t kstep = (size_t)(BK * 2);
    const size_t hstep = (size_t)HALF * K * 2;
    const size_t tstep = 2 * hstep;
    const unsigned ldsw = (unsigned)wid * 1024u;
    const int aoff = lds_byte(wr * 64 + fr, fq * 8), boff = lds_byte(wc * 32 + fr, fq * 8);
#define PG8_SA(b, h) (((b) * 2 + (h)) * HTB)
#define PG8_SB(b, h) ((4 + (b) * 2 + (h)) * HTB)
#define PG8_STAGE(bufoff, gbase, voff) do { _Pragma("unroll") for (int _i = 0; _i < 2; ++_i) \
        __builtin_amdgcn_global_load_lds((const unsigned*)((const char*)(gbase) + (voff)[_i]), (PG8_LAS unsigned*)(lds + (bufoff) + ldsw + _i * 8192), 16, 0, 0); } while (0)
#define PG8_LDA(dst, b, h) do { _Pragma("unroll") for (int m = 0; m < 4; ++m) _Pragma("unroll") for (int k = 0; k < 2; ++k) dst[m][k] = *(const PG8_LAS bf16x8*)(lds + PG8_SA(b, h) + aoff + m * 2048 + k * 1024); } while (0)
#define PG8_LDB(dst, b, h) do { _Pragma("unroll") for (int n = 0; n < 2; ++n) _Pragma("unroll") for (int k = 0; k < 2; ++k) dst[n][k] = *(const PG8_LAS bf16x8*)(lds + PG8_SB(b, h) + boff + n * 2048 + k * 1024); } while (0)
#define PG8_MMA(ai, bj, At, Bt) do { __builtin_amdgcn_s_setprio(1); _Pragma("unroll") for (int m = 0; m < 4; ++m) _Pragma("unroll") for (int n = 0; n < 2; ++n) _Pragma("unroll") for (int k = 0; k < 2; ++k) \
        acc[ai][bj][m][n] = __builtin_amdgcn_mfma_f32_16x16x32_bf16(Bt[n][k], At[m][k], acc[ai][bj][m][n], 0, 0, 0); __builtin_amdgcn_s_setprio(0); } while (0)
#define PG8_WAIT_V(n) asm volatile("s_waitcnt vmcnt(" #n ")" ::: "memory")
#define PG8_WAIT_L(n) asm volatile("s_waitcnt lgkmcnt(" #n ")" ::: "memory")
#define PG8_BAR __builtin_amdgcn_s_barrier()
#define PG8_SCHED __builtin_amdgcn_sched_barrier(0)
    Unit cur, nxt; int ui = 0;
    if (!S.next(0, cur)) return;
    f32x4 acc[2][2][4][2];
#pragma unroll
    for (int a = 0; a < 2; ++a)
#pragma unroll
        for (int b = 0; b < 2; ++b)
#pragma unroll
            for (int m = 0; m < 4; ++m)
#pragma unroll
                for (int n = 0; n < 2; ++n) acc[a][b][m][n] = (f32x4){0.f, 0.f, 0.f, 0.f};
    bf16x8 At[4][2], B0[2][2], B1[2][2];
    const char* cA = (const char*)g.A + (size_t)cur.pm * tstep + cur.ks * kslice; const char* cB = (const char*)g.Bt + (size_t)cur.pn * tstep + cur.ks * kslice;
    S.a_ready(cur);
    if constexpr (SP2) {
        PG8_STAGE(PG8_SB(0, 0), cB, voffB); PG8_STAGE(PG8_SB(0, 1), cB + hstep, voffB); PG8_STAGE(PG8_SA(0, 0), cA, voffA); PG8_STAGE(PG8_SA(0, 1), cA + hstep, voffA);
        if (wr == 1) PG8_BAR;
        PG8_WAIT_V(2); PG8_BAR;
        PG8_STAGE(PG8_SB(1, 0), cB + kstep, voffB); PG8_STAGE(PG8_SA(1, 0), cA + kstep, voffA); PG8_STAGE(PG8_SB(1, 1), cB + hstep + kstep, voffB);
        PG8_WAIT_V(6); PG8_BAR;
    } else {
        PG8_STAGE(PG8_SB(0, 0), cB, voffB); PG8_STAGE(PG8_SA(0, 0), cA, voffA); PG8_STAGE(PG8_SB(0, 1), cB + hstep, voffB); PG8_STAGE(PG8_SA(0, 1), cA + hstep, voffA);
        if (wr == 1) PG8_BAR;
        PG8_WAIT_V(4); PG8_BAR;
        PG8_STAGE(PG8_SB(1, 0), cB + kstep, voffB); PG8_STAGE(PG8_SA(1, 0), cA + kstep, voffA); PG8_STAGE(PG8_SB(1, 1), cB + hstep + kstep, voffB);
        PG8_WAIT_V(6); PG8_BAR;
    }
    for (;;) {
        const bool has_next = S.next(ui + 1, nxt);
        const char* nA = has_next ? (const char*)g.A + (size_t)nxt.pm * tstep + nxt.ks * kslice : cA; const char* nB = has_next ? (const char*)g.Bt + (size_t)nxt.pn * tstep + nxt.ks * kslice : cB;
        for (int t = 0; t < nt; t += 2) {
            const bool last = (t == nt - 2);
            const char* a1 = cA + (size_t)(t + 1) * kstep;
            const char* a2 = last ? nA : cA + (size_t)(t + 2) * kstep; const char* b2 = last ? nB : cB + (size_t)(t + 2) * kstep;
            const char* a3 = a2 + kstep; const char* b3 = b2 + kstep;
            if (last && has_next) S.a_ready(nxt);
            if constexpr (SP2) {
            PG8_LDB(B0, 0, 0); PG8_LDB(B1, 0, 1); PG8_SCHED; PG8_LDA(At, 0, 0); PG8_STAGE(PG8_SA(1, 1), a1 + hstep, voffA);
            PG8_WAIT_V(8); PG8_WAIT_L(0); PG8_BAR; PG8_MMA(0, 0, At, B0); PG8_MMA(0, 1, At, B1); PG8_BAR; PG8_SCHED;
            PG8_LDA(At, 0, 1); PG8_STAGE(PG8_SB(0, 0), b2, voffB); PG8_STAGE(PG8_SB(0, 1), b2 + hstep, voffB); PG8_STAGE(PG8_SA(0, 0), a2, voffA);
            PG8_WAIT_V(8); PG8_WAIT_L(0); PG8_BAR; PG8_MMA(1, 0, At, B0); PG8_MMA(1, 1, At, B1); PG8_BAR; PG8_SCHED;
            PG8_LDB(B0, 1, 0); PG8_LDB(B1, 1, 1); PG8_SCHED; PG8_LDA(At, 1, 0); PG8_STAGE(PG8_SA(0, 1), a2 + hstep, voffA);
            PG8_WAIT_V(8); PG8_WAIT_L(0); PG8_BAR; PG8_MMA(0, 0, At, B0); PG8_MMA(0, 1, At, B1); PG8_BAR; PG8_SCHED;
            PG8_LDA(At, 1, 1); PG8_STAGE(PG8_SB(1, 0), b3, voffB); PG8_STAGE(PG8_SB(1, 1), b3 + hstep, voffB); PG8_STAGE(PG8_SA(1, 0), a3, voffA);
            PG8_WAIT_V(8); PG8_WAIT_L(0); PG8_BAR; PG8_MMA(1, 0, At, B0); PG8_MMA(1, 1, At, B1); PG8_BAR; PG8_SCHED;
            } else {
            PG8_LDB(B0, 0, 0); PG8_SCHED; PG8_LDA(At, 0, 0); PG8_STAGE(PG8_SA(1, 1), a1 + hstep, voffA);
            PG8_WAIT_L(8); PG8_BAR; PG8_WAIT_L(0); PG8_MMA(0, 0, At, B0); PG8_BAR; PG8_SCHED;
            PG8_LDB(B1, 0, 1); PG8_STAGE(PG8_SB(0, 0), b2, voffB);
            PG8_BAR; PG8_WAIT_L(0); PG8_MMA(0, 1, At, B1); PG8_BAR;
            PG8_LDA(At, 0, 1); PG8_STAGE(PG8_SA(0, 0), a2, voffA);
            PG8_BAR; PG8_WAIT_L(0); PG8_MMA(1, 0, At, B0); PG8_BAR; PG8_SCHED;
            PG8_STAGE(PG8_SB(0, 1), b2 + hstep, voffB);
            PG8_WAIT_V(6); PG8_BAR; PG8_MMA(1, 1, At, B1); PG8_BAR;
            PG8_LDB(B0, 1, 0); PG8_SCHED; PG8_LDA(At, 1, 0); PG8_STAGE(PG8_SA(0, 1), a2 + hstep, voffA);
            PG8_WAIT_L(8); PG8_BAR; PG8_WAIT_L(0); PG8_MMA(0, 0, At, B0); PG8_BAR; PG8_SCHED;
            PG8_LDB(B1, 1, 1); PG8_STAGE(PG8_SB(1, 0), b3, voffB);
            PG8_BAR; PG8_WAIT_L(0); PG8_MMA(0, 1, At, B1); PG8_BAR;
            PG8_LDA(At, 1, 1); PG8_STAGE(PG8_SA(1, 0), a3, voffA);
            PG8_BAR; PG8_WAIT_L(0); PG8_MMA(1, 0, At, B0); PG8_BAR; PG8_SCHED;
            PG8_STAGE(PG8_SB(1, 1), b3 + hstep, voffB);
            PG8_WAIT_V(6); PG8_BAR; PG8_MMA(1, 1, At, B1); PG8_BAR;
            }
        }
        if constexpr (ALIGN_EPI) { if (wr == 0) PG8_BAR; }
        if constexpr (!Epi::AFTER_DRAIN) { E(acc, cur, wr, wc, fr, fq); S.done(cur); }
        if (!has_next) break;
#pragma unroll
        for (int a = 0; a < 2; ++a)
#pragma unroll
            for (int b = 0; b < 2; ++b)
#pragma unroll
                for (int m = 0; m < 4; ++m)
#pragma unroll
                    for (int n = 0; n < 2; ++n) acc[a][b][m][n] = (f32x4){0.f, 0.f, 0.f, 0.f};
        cur = nxt; cA = nA; cB = nB; ++ui;
        if constexpr (ALIGN_EPI) { if (wr == 1) PG8_BAR; }
    }
    PG8_WAIT_V(0);
    if constexpr (!ALIGN_EPI) { if (wr == 0) PG8_BAR; }
    PG8_BAR;
    if constexpr (Epi::AFTER_DRAIN) { E.fused(acc, cur, wr, wc, fr, fq, lds, wid, lane); S.done(cur); }
#undef PG8_SA
#undef PG8_SB
#undef PG8_STAGE
#undef PG8_LDA
#undef PG8_LDB
#undef PG8_MMA
#undef PG8_WAIT_V
#undef PG8_WAIT_L
#undef PG8_BAR
#undef PG8_SCHED
}
}
#define XB_TMO      128
#define XB_XCNT(j)  (256  + 64 * (j))
#define XB_XSUB(j)  (1280 + 64 * (j))
#define XB_XGEN(j)  (2304 + 64 * (j))
#define XB_TOP      3328
#define XB_TOPGEN   3392
#define XCD_BAR_WORDS 3456
#define XB_SPIN_CAP (1u << 18)

__device__ __forceinline__ unsigned xb_ld(unsigned* p)              { return __hip_atomic_load(p, __ATOMIC_RELAXED, __HIP_MEMORY_SCOPE_AGENT); }
__device__ __forceinline__ unsigned xb_add(unsigned* p, unsigned v) { return __hip_atomic_fetch_add(p, v, __ATOMIC_RELAXED, __HIP_MEMORY_SCOPE_AGENT); }
__device__ __forceinline__ unsigned xb_xcc_id() { return (unsigned)__builtin_amdgcn_s_getreg((3 << 11) | 20) & 0xFu; }
#define XB_SPIN(cond, bar) do { unsigned _sp = 0; while (cond) { __builtin_amdgcn_s_sleep(1); \
    if ((++_sp & 255u) == 0u) { if (xb_ld(&(bar)[XB_TMO])) break; if (_sp > XB_SPIN_CAP) { atomicAdd(&(bar)[XB_TMO], 1u); break; } } } } while (0)

struct XcdBarrier {
    unsigned* bar; unsigned x;
    volatile LAS unsigned* st;
};

__device__ __forceinline__ XcdBarrier xcd_barrier_post(unsigned* bar, volatile LAS unsigned* st) {
    XcdBarrier b; b.bar = bar; b.x = xb_xcc_id(); b.st = st;
    if (threadIdx.x == 0) (void)xb_add(&bar[XB_XCNT(b.x)], 1u);
    return b;
}
__device__ __forceinline__ void xcd_barrier_complete(unsigned* bar, unsigned x, unsigned& nloc, unsigned& nx) {
    const unsigned G = gridDim.x * gridDim.y * gridDim.z;
    unsigned sum, cnt, mine, sp = 0u;
    for (;;) {
        sum = 0u; cnt = 0u; mine = 0u;
#pragma unroll
        for (unsigned j = 0; j < 16; ++j) { const unsigned c = xb_ld(&bar[XB_XCNT(j)]); sum += c; cnt += (c > 0u) ? 1u : 0u; mine = (j == x) ? c : mine; }
        if (sum == G) break;
        __builtin_amdgcn_s_sleep(1);
        if ((++sp & 255u) == 0u) { if (xb_ld(&bar[XB_TMO])) break; if (sp > XB_SPIN_CAP) { atomicAdd(&bar[XB_TMO], 1u); break; } }
    }
    nloc = mine > 0u ? mine : 1u; nx = cnt > 0u ? cnt : 1u;
}

__device__ __forceinline__ void xcd_barrier(const XcdBarrier& b) {
    asm volatile("s_waitcnt vmcnt(0)" ::: "memory");
    __syncthreads();
    if (threadIdx.x == 0) {
        unsigned* bar = b.bar;
        __builtin_amdgcn_s_waitcnt(0);
        unsigned nloc = b.st[0], nx = b.st[1];
        if (nloc == 0u) { xcd_barrier_complete(bar, b.x, nloc, nx); b.st[0] = nloc; b.st[1] = nx; }
        const unsigned old = xb_add(&bar[XB_XSUB(b.x)], 1u);
        const unsigned gen = old / nloc;
        if (old + 1u == (gen + 1u) * nloc) {
            __builtin_amdgcn_fence(__ATOMIC_RELEASE, "agent");
            asm volatile("s_waitcnt vmcnt(0)" ::: "memory");
            const unsigned og = xb_add(&bar[XB_TOP], 1u);
            const unsigned tg = og / nx;
            if (og + 1u == (tg + 1u) * nx) xb_add(&bar[XB_TOPGEN], 1u);
            else XB_SPIN(xb_ld(&bar[XB_TOPGEN]) == tg, bar);
            __builtin_amdgcn_fence(__ATOMIC_ACQUIRE, "agent");
            xb_add(&bar[XB_XGEN(b.x)], 1u);
            asm volatile("s_waitcnt vmcnt(0)" ::: "memory");
        } else {
            XB_SPIN(xb_ld(&bar[XB_XGEN(b.x)]) == gen, bar);
            __builtin_amdgcn_fence(__ATOMIC_ACQUIRE, "agent");
            asm volatile("s_waitcnt vmcnt(0)" ::: "memory");
        }
    }
    __syncthreads();
}
#ifndef MK_PROBE
#define MK_PROBE 0
#endif
#define NREP(bit) (((MK_PROBE >> (bit)) & 1) ? 2 : 1)
#define GEMM2X(call) do { call; if (NREP(0) > 1) { call; } } while (0)
#define NREP2(b1, b2) ((((MK_PROBE >> (b1)) | (MK_PROBE >> (b2))) & 1) ? 2 : 1)
#ifndef MK_GATE_PART
#define MK_GATE_PART 3
#endif
typedef GAS unsigned gu32;
#define RLX_AGENT __ATOMIC_RELAXED, __HIP_MEMORY_SCOPE_AGENT
#define MFMA32(a, b, c) __builtin_amdgcn_mfma_f32_32x32x16_bf16((a), (b), (c), 0, 0, 0)

struct Ctx { LAS unsigned char* lds; volatile LAS unsigned* MISC; int tid, lane, wave, G, bx, gw, NGW; };
__device__ __forceinline__ int crow(int r, int hi) { return (r & 3) + 8 * (r >> 2) + 4 * hi; }

constexpr int TR_PITCH = 132;
__device__ __forceinline__ void p0_transpose_item(const float* W, int K, int N, int NP, bf16* WT, LAS unsigned char* scr, int item, int lane) {
    const int nblk = NP / 64, kb = item / nblk, nb = item % nblk, k0 = 64 * kb, n0 = 64 * nb;
    const int kp = lane >> 4, n4 = lane & 15; const bool inn = n0 + 4 * n4 < N;
    f32x4 va[8], vb[8];
    const float* src = W + (size_t)(k0 + 2 * kp) * N + n0 + 4 * n4;
#pragma unroll
    for (int i = 0; i < 8; ++i) { va[i] = inn ? *(const f32x4*)(src + (size_t)(8 * i) * N) : (f32x4){0.f, 0.f, 0.f, 0.f}; vb[i] = inn ? *(const f32x4*)(src + (size_t)(8 * i + 1) * N) : (f32x4){0.f, 0.f, 0.f, 0.f}; }
#pragma unroll
    for (int i = 0; i < 8; ++i)
#pragma unroll
        for (int e = 0; e < 4; ++e) *(LAS unsigned*)(scr + (4 * n4 + e) * TR_PITCH + (8 * i + 2 * kp) * 2) = pk2(va[i][e], vb[i][e]);
    LDS_WAIT();
    const int nr = lane >> 3, c = lane & 7;
#pragma unroll
    for (int j = 0; j < 8; ++j) { const int n = 8 * j + nr; const LAS unsigned* s = (const LAS unsigned*)(scr + n * TR_PITCH + 16 * c);
        v4u o; o.x = s[0]; o.y = s[1]; o.z = s[2]; o.w = s[3];
        *(v4u*)(WT + (size_t)(n0 + n) * K + k0 + 8 * c) = o; }
    LDS_WAIT();
}
__device__ __forceinline__ void transpose_job(const Ctx& C, const float* W, int K, int N, int NP, bf16* WT) {
    LAS unsigned char* scr = C.lds + C.wave * 16384;
    const int nitems = (K / 64) * (NP / 64);
    for (int it = C.gw; it < nitems; it += C.NGW) p0_transpose_item(W, K, N, NP, WT, scr, it, C.lane);
}
__device__ __forceinline__ void cvt_job(const Ctx& C, const float* src, bf16* dst, int nseg, int seglen, size_t sstride, size_t dstride) {
    const int vps = seglen / 8; const long total = (long)nseg * vps; const long NGT = (long)C.G * NTHREADS;
    for (long i0 = (long)C.bx * NTHREADS + C.tid; i0 < total; i0 += 4 * NGT) {
        f32x4 a[4], b[4]; size_t doff[4]; bool ok[4];
#pragma unroll
        for (int u = 0; u < 4; ++u) { const long i = i0 + u * NGT; ok[u] = i < total; const long ii = ok[u] ? i : i0; const int seg = (int)(ii / vps), off = (int)(ii % vps) * 8;
            a[u] = *(const f32x4*)(src + seg * sstride + off); b[u] = *(const f32x4*)(src + seg * sstride + off + 4); doff[u] = seg * dstride + off; }
#pragma unroll
        for (int u = 0; u < 4; ++u) if (ok[u]) { v4u o; o.x = pk2(a[u].x, a[u].y); o.y = pk2(a[u].z, a[u].w); o.z = pk2(b[u].x, b[u].y); o.w = pk2(b[u].z, b[u].w); *(v4u*)(dst + doff[u]) = o; }
    }
}

__device__ __forceinline__ void cvt8_job(const Ctx& C, const float* src, unsigned char* dst, int nseg, int seglen, size_t sstride, size_t dstride) {
    const int vps = seglen / 8; const long total = (long)nseg * vps; const long NGT = (long)C.G * NTHREADS;
    for (long i0 = (long)C.bx * NTHREADS + C.tid; i0 < total; i0 += 4 * NGT) {
        f32x4 a[4], b[4]; size_t doff[4]; bool ok[4];
#pragma unroll
        for (int u = 0; u < 4; ++u) { const long i = i0 + u * NGT; ok[u] = i < total; const long ii = ok[u] ? i : i0; const int seg = (int)(ii / vps), off = (int)(ii % vps) * 8;
            a[u] = *(const f32x4*)(src + seg * sstride + off); b[u] = *(const f32x4*)(src + seg * sstride + off + 4); doff[u] = seg * dstride + off; }
#pragma unroll
        for (int u = 0; u < 4; ++u) if (ok[u]) { int lo = 0, hi = 0;
            lo = __builtin_amdgcn_cvt_pk_fp8_f32(a[u].x, a[u].y, lo, false); lo = __builtin_amdgcn_cvt_pk_fp8_f32(a[u].z, a[u].w, lo, true);
            hi = __builtin_amdgcn_cvt_pk_fp8_f32(b[u].x, b[u].y, hi, false); hi = __builtin_amdgcn_cvt_pk_fp8_f32(b[u].z, b[u].w, hi, true);
            *(v2u*)(dst + doff[u]) = (v2u){(unsigned)lo, (unsigned)hi}; }
    }
}

__device__ __forceinline__ float wave_sum(float v) {
#pragma unroll
    for (int o = 1; o < 64; o <<= 1) v += __shfl_xor(v, o);
    return v;
}
__device__ __forceinline__ void ln_load_row(int row, int lane, const float* RES, const float* xs, const float* PART, f32x4 (&v)[8]) {
    if (row < MP) { const f32x4* xr = (const f32x4*)(RES + (size_t)row * DM) + lane;
#pragma unroll
        for (int j = 0; j < 8; ++j) v[j] = xr[64 * j];
    } else { const f32x4* xp = (const f32x4*)(xs + (size_t)row * DM) + lane;
#pragma unroll
        for (int j = 0; j < 8; ++j) v[j] = xp[64 * j] * ALPHA;
#pragma unroll 2
        for (int ks = 0; ks < 8; ++ks) { const f32x4* pp = (const f32x4*)(PART + ((size_t)ks * MS + (row - MP)) * DM) + lane;
#pragma unroll
            for (int j = 0; j < 8; ++j) v[j] += pp[64 * j]; } }
}
__device__ __forceinline__ void ln_finish_row(int row, int lane, f32x4 (&v)[8], const float* g, const float* b, float* ROUT, bf16* XO) {
    float s = 0.f;
#pragma unroll
    for (int j = 0; j < 8; ++j) s += (v[j].x + v[j].y) + (v[j].z + v[j].w);
    const float mean = wave_sum(s) * (1.f / DM); float s2 = 0.f;
#pragma unroll
    for (int j = 0; j < 8; ++j) { v[j] = v[j] - mean; s2 += (v[j].x * v[j].x + v[j].y * v[j].y) + (v[j].z * v[j].z + v[j].w * v[j].w); }
    const float rstd = 1.f / sqrtf(wave_sum(s2) * (1.f / DM) + LN_EPS);
    f32x4* xo = (f32x4*)(ROUT + (size_t)row * DM) + lane; v2u* o8 = (v2u*)(XO + (size_t)row * DM) + lane;
#pragma unroll
    for (int j = 0; j < 8; ++j) { const f32x4 gg = ((const f32x4*)g)[lane + 64 * j], bb = ((const f32x4*)b)[lane + 64 * j]; const f32x4 y = v[j] * rstd * gg + bb;
        xo[64 * j] = y; v2u w; w.x = pk2(y.x, y.y); w.y = pk2(y.z, y.w); o8[64 * j] = w; }
}
__device__ __forceinline__ void ln_phase(const Ctx& C, float* RES, bf16* XO, const float* g, const float* b, const float* xs, const float* PART, float* ROUT) {
    for (int row = C.gw; row < MT; row += 2 * C.NGW) {
        const int row2 = row + C.NGW; const bool two = row2 < MT;
        f32x4 va[8], vb[8];
        ln_load_row(row, C.lane, RES, xs, PART, va);
        if (two) ln_load_row(row2, C.lane, RES, xs, PART, vb);
        ln_finish_row(row, C.lane, va, g, b, ROUT, XO);
        if (two) ln_finish_row(row2, C.lane, vb, g, b, ROUT, XO);
    }
}

constexpr int SC_QPITCH = 4112, SC_NITEMS = 160 + 2304;
__device__ __forceinline__ void scores_phase(const Ctx& C, unsigned* qhead, const bf16* QIB, const bf16* KIP, const bf16* KIS, const float* WI, float* SCP, float* SCS) {
    const int q = C.lane & 31, hh = C.lane >> 5;
    for (;;) {
        if (C.tid == 0) C.MISC[0] = __hip_atomic_fetch_add(qhead, 1u, RLX_AGENT);
        __syncthreads();
        int id = (int)C.MISC[0];
        __syncthreads();
        if (id >= SC_NITEMS) break;
        int row0, nk, ch, stride; const bf16* KI; float* SC;
        if (id < 160) { const int qt = id / 5; ch = id % 5; const int rs0 = qt * 32, b = rs0 >> 6; row0 = MP + rs0; KI = KIS + (size_t)b * SALL * HD; nk = SALL; SC = SCS + (size_t)rs0 * SALL; stride = SALL; }
        else { id -= 160; int k = 7; while (id >= 64 * (k + 1)) { id -= 64 * (k + 1); --k; }
            const int per = 4 * (k + 1), ci = id / per, rem = id % per, c = 16 * k + 15 - ci, tile4 = rem / (k + 1); ch = rem % (k + 1);
            const int b = tile4 >> 1, t0 = c * 64 + (tile4 & 1) * 32; row0 = b * SEQ + t0; KI = KIP + (size_t)b * SEQ * HD; nk = 64 * (c + 1); SC = SCP + (size_t)row0 * SEQ; stride = SEQ; }
        const int s_begin = ch * 1024, nkc = (nk - s_begin) < 1024 ? (nk - s_begin) : 1024, ntiles = nkc >> 5;
#pragma unroll 4
        for (int i = 0; i < 16; ++i) { const int p = C.tid + NTHREADS * i, qq = p >> 8, off = (p & 255) * 16;
            const v4u v = *(const v4u*)((const char*)QIB + (size_t)(row0 + qq) * (DM * 2) + off); *(LAS v4u*)(C.lds + qq * SC_QPITCH + off) = v; }
        LAS float* wl = (LAS float*)(C.lds + 32 * SC_QPITCH);
        { const int qq = C.tid >> 4, h2 = C.tid & 15; wl[qq * 17 + h2] = WI[(size_t)(row0 + qq) * 16 + h2]; }
        __syncthreads();
        const LAS unsigned char* qb = C.lds + q * SC_QPITCH + hh * 16;
        bf16x8 kf[8];
        if (C.wave < ntiles) { const bf16* kp = KI + (size_t)(s_begin + C.wave * 32 + q) * HD + 8 * hh;
#pragma unroll
            for (int kk = 0; kk < 8; ++kk) kf[kk] = *(const bf16x8*)(kp + 16 * kk); }
        for (int ti = C.wave; ti < ntiles; ti += NWAVES) {
            const int s0 = s_begin + ti * 32;
            bf16x8 kn[8];
            { const int tn = (ti + NWAVES < ntiles) ? ti + NWAVES : ti; const bf16* kp = KI + (size_t)(s_begin + tn * 32 + q) * HD + 8 * hh;
#pragma unroll
              for (int kk = 0; kk < 8; ++kk) kn[kk] = *(const bf16x8*)(kp + 16 * kk); }
            f32x16 acc;
#pragma unroll
            for (int r = 0; r < 16; ++r) acc[r] = 0.f;
#pragma unroll 2
            for (int h = 0; h < 16; ++h) {
                f32x16 c; const float wh = wl[q * 17 + h];
#pragma unroll
                for (int r = 0; r < 16; ++r) c[r] = 0.f;
#pragma unroll
                for (int kk = 0; kk < 8; ++kk) { const bf16x8 bq = *(const LAS bf16x8*)(qb + h * 256 + kk * 32); c = MFMA32(kf[kk], bq, c); }
#pragma unroll
                for (int r = 0; r < 16; ++r) acc[r] += wh * __builtin_fmaxf(c[r], 0.f);
            }
            float* sp = SC + (size_t)q * stride + s0 + 4 * hh;
#pragma unroll
            for (int g = 0; g < 4; ++g) *(f32x4*)(sp + 8 * g) = (f32x4){acc[4 * g], acc[4 * g + 1], acc[4 * g + 2], acc[4 * g + 3]};
#pragma unroll
            for (int kk = 0; kk < 8; ++kk) kf[kk] = kn[kk];
        }
        __syncthreads();
    }
}

__device__ __forceinline__ unsigned tokey(float f) { const unsigned u = __float_as_uint(f); return (u & 0x80000000u) ? ~u : (u | 0x80000000u); }
__device__ __forceinline__ void select_phase(const Ctx& C, const float* SCP, const float* SCS, int* IDX, int* CNT) {
    LAS unsigned* hist = (LAS unsigned*)(C.lds + C.wave * 1024);
    const int lane = C.lane; const unsigned long long ltm = (1ull << lane) - 1ull;
    for (int row = C.gw; row < MT; row += C.NGW) {
        int n; const float* sc;
        if (row < MP) { const int t = row & (SEQ - 1); n = 64 * ((t >> 6) + 1); sc = SCP + (size_t)row * SEQ; } else { n = SALL; sc = SCS + (size_t)(row - MP) * SALL; }
        int* ip = IDX + (size_t)row * TOPK;
        if (n <= TOPK) {
#pragma unroll
            for (int k = 0; k < 4; ++k) { const int i = lane + 64 * k; ip[i] = (i < n) ? i : 0; }
            if (lane == 0) CNT[row] = n;
            continue;
        }
        v4u kreg[32];
#pragma unroll
        for (int it = 0; it < 32; ++it) { kreg[it] = (v4u){0u, 0u, 0u, 0u};
            if ((it >> 2) * 1024 < n) { if (it * 256 + lane * 4 < n) { const f32x4 v = *(const f32x4*)(sc + it * 256 + lane * 4); kreg[it] = (v4u){tokey(v.x), tokey(v.y), tokey(v.z), tokey(v.w)}; } } }
        unsigned prefix = 0u, mask = 0u, krem = TOPK;
        for (int pass = 0; pass < 4; ++pass) {
            const int shift = 24 - 8 * pass;
            *(LAS v4u*)(hist + 4 * lane) = (v4u){0u, 0u, 0u, 0u};
            LDS_WAIT();
#pragma unroll
            for (int it = 0; it < 32; ++it) if ((it >> 2) * 1024 < n) {
#pragma unroll
                for (int e = 0; e < 4; ++e) { const unsigned key = kreg[it][e]; if ((key & mask) == prefix) __hip_atomic_fetch_add(hist + ((key >> shift) & 255u), 1u, __ATOMIC_RELAXED, __HIP_MEMORY_SCOPE_WORKGROUP); } }
            LDS_WAIT();
            const v4u hc = *(const LAS v4u*)(hist + 4 * lane);
            const unsigned tot = hc.x + hc.y + hc.z + hc.w; unsigned x = tot;
#pragma unroll
            for (int o = 1; o < 64; o <<= 1) { const unsigned y = __shfl_down(x, o); if (lane + o < 64) x += y; }
            const unsigned a3 = x - tot, a2 = a3 + hc.w, a1 = a2 + hc.z, a0 = a1 + hc.y;
            int fe = -1; unsigned fa = 0u;
            if (a3 < krem && krem <= a3 + hc.w) { fe = 3; fa = a3; } else if (a2 < krem && krem <= a2 + hc.z) { fe = 2; fa = a2; }
            else if (a1 < krem && krem <= a1 + hc.y) { fe = 1; fa = a1; } else if (a0 < krem && krem <= a0 + hc.x) { fe = 0; fa = a0; }
            const unsigned long long bal = __ballot(fe >= 0); const int src = bal ? (__ffsll((long long)bal) - 1) : 0;
            const unsigned d = (unsigned)__shfl(4 * lane + fe, src), above = (unsigned)__shfl((int)fa, src);
            krem -= above; prefix |= d << shift; mask |= 0xffu << shift;
        }
        int outc = 0, eqs = 0;
#pragma unroll
        for (int it = 0; it < 32; ++it) if ((it >> 2) * 1024 < n) {
            bool eq[4], sel[4];
#pragma unroll
            for (int e = 0; e < 4; ++e) { eq[e] = kreg[it][e] == prefix; sel[e] = kreg[it][e] > prefix; }
            const unsigned long long anyeq = __ballot(eq[0] || eq[1] || eq[2] || eq[3]);
            if (anyeq) {
                const int mine = (int)eq[0] + (int)eq[1] + (int)eq[2] + (int)eq[3];
                int below = 0, total = 0;
#pragma unroll
                for (int e = 0; e < 4; ++e) { const unsigned long long bb = __ballot(eq[e]); below += __popcll(bb & ltm); total += __popcll(bb); }
                int r = eqs + below;
#pragma unroll
                for (int e = 0; e < 4; ++e) { if (eq[e]) { if ((unsigned)r < krem) sel[e] = true; ++r; } }
                eqs += total; (void)mine;
            }
#pragma unroll
            for (int e = 0; e < 4; ++e) { const unsigned long long sb = __ballot(sel[e]); const int pos = outc + __popcll(sb & ltm); if (sel[e] && pos < TOPK) ip[pos] = it * 256 + lane * 4 + e; outc += __popcll(sb); }
        }
        if (lane == 0) CNT[row] = outc < TOPK ? outc : TOPK;
    }
}

__device__ __forceinline__ int t5_bucket(int n  ) {
    const int ret = (n < 0) ? 16 : 0; n = n < 0 ? -n : n;
    if (n < 8) return ret + n;
    const int lg = 31 - __builtin_clz((unsigned)(n * n));
    const int large = 2 + lg; return ret + (large < 15 ? large : 15);
}
#define DPPF(v, ctrl) __builtin_bit_cast(float, __builtin_amdgcn_mov_dpp(__builtin_bit_cast(int, (v)), (ctrl), 0xF, 0xF, true))
__device__ __forceinline__ float wave_sum_dpp(float v) { v += DPPF(v, 0xB1); v += DPPF(v, 0x4E); v += DPPF(v, 0x141); v += DPPF(v, 0x140);
    const int b = __builtin_bit_cast(int, v);
    return (__builtin_bit_cast(float, __builtin_amdgcn_readlane(b, 0)) + __builtin_bit_cast(float, __builtin_amdgcn_readlane(b, 16))) + (__builtin_bit_cast(float, __builtin_amdgcn_readlane(b, 32)) + __builtin_bit_cast(float, __builtin_amdgcn_readlane(b, 48))); }
__device__ __forceinline__ float wave_max_dpp(float v) { v = __builtin_fmaxf(v, DPPF(v, 0xB1)); v = __builtin_fmaxf(v, DPPF(v, 0x4E)); v = __builtin_fmaxf(v, DPPF(v, 0x141)); v = __builtin_fmaxf(v, DPPF(v, 0x140));
    const int b = __builtin_bit_cast(int, v);
    return __builtin_fmaxf(__builtin_fmaxf(__builtin_bit_cast(float, __builtin_amdgcn_readlane(b, 0)), __builtin_bit_cast(float, __builtin_amdgcn_readlane(b, 16))), __builtin_fmaxf(__builtin_bit_cast(float, __builtin_amdgcn_readlane(b, 32)), __builtin_bit_cast(float, __builtin_amdgcn_readlane(b, 48)))); }
__device__ __forceinline__ float sum_x16_x32(float x) {
    { const auto r = __builtin_amdgcn_permlane16_swap(__float_as_uint(x), __float_as_uint(x), false, false); x = __uint_as_float(r[0]) + __uint_as_float(r[1]); }
    { const auto r = __builtin_amdgcn_permlane32_swap(__float_as_uint(x), __float_as_uint(x), false, false); x = __uint_as_float(r[0]) + __uint_as_float(r[1]); }
    return x; }
__device__ __forceinline__ float dpp_quad_sum(float t) {
    t += __builtin_bit_cast(float, __builtin_amdgcn_mov_dpp(__builtin_bit_cast(int, t), 0xB1, 0xF, 0xF, true));
    t += __builtin_bit_cast(float, __builtin_amdgcn_mov_dpp(__builtin_bit_cast(int, t), 0x4E, 0xF, 0xF, true));
    return t;
}
__device__ __forceinline__ float dot2bf8(unsigned w8, bool hi, unsigned q, float c) {
    const bf16x2_t kb = hi ? __builtin_amdgcn_cvt_scalef32_pk_bf16_fp8(w8, 1.0f, true) : __builtin_amdgcn_cvt_scalef32_pk_bf16_fp8(w8, 1.0f, false);
    return __builtin_amdgcn_fdot2_f32_bf16(kb, __builtin_bit_cast(bf16x2_t, q), c, false);
}
__device__ __forceinline__ void sattn_task(int row, int g, int qpos, const unsigned char* Kb, const unsigned char* Vb, int cnt, const int* ip, const bf16* QB, bf16* OB,
                                           LAS int* idxl, LAS float* lg, const LAS float* biasl, int lane) {
#pragma unroll
    for (int k = 0; k < 4; ++k) { const int j = lane + 64 * k; const int v = ip[j]; idxl[j] = (j < cnt) ? v : 0; }
    const int kq = lane >> 2, c4 = lane & 3;
    unsigned qreg[4][16];
    { const bf16* qp = QB + (size_t)row * DM + (4 * g) * HD + 32 * c4;
#pragma unroll
      for (int hq = 0; hq < 4; ++hq)
#pragma unroll
          for (int i = 0; i < 4; ++i) { const v4u a = *(const v4u*)(qp + hq * HD + 8 * i); qreg[hq][4 * i] = a.x; qreg[hq][4 * i + 1] = a.y; qreg[hq][4 * i + 2] = a.z; qreg[hq][4 * i + 3] = a.w; } }
    LDS_WAIT();
#define SA_QK_LOAD(KD, B) do { _Pragma("unroll") for (int rr = 0; rr < 8; ++rr) { const int key = idxl[16 * (8 * (B) + rr) + kq]; const unsigned char* kp = Kb + (unsigned)(key * KVW + 32 * c4); \
        KD[rr][0] = *(const v4u*)kp; KD[rr][1] = *(const v4u*)(kp + 16); } } while (0)
#define SA_QK_COMP(KD, B) do { _Pragma("unroll") for (int rr = 0; rr < 8; ++rr) { float s[4]; \
        _Pragma("unroll") for (int hq = 0; hq < 4; ++hq) { float t = 0.f; \
            _Pragma("unroll") for (int i = 0; i < 2; ++i) { \
                t = dot2bf8(KD[rr][i].x, false, qreg[hq][8 * i], t);     t = dot2bf8(KD[rr][i].x, true, qreg[hq][8 * i + 1], t); \
                t = dot2bf8(KD[rr][i].y, false, qreg[hq][8 * i + 2], t); t = dot2bf8(KD[rr][i].y, true, qreg[hq][8 * i + 3], t); \
                t = dot2bf8(KD[rr][i].z, false, qreg[hq][8 * i + 4], t); t = dot2bf8(KD[rr][i].z, true, qreg[hq][8 * i + 5], t); \
                t = dot2bf8(KD[rr][i].w, false, qreg[hq][8 * i + 6], t); t = dot2bf8(KD[rr][i].w, true, qreg[hq][8 * i + 7], t); } \
            s[hq] = dpp_quad_sum(t); } \
        const float sv = c4 == 0 ? s[0] : c4 == 1 ? s[1] : c4 == 2 ? s[2] : s[3]; \
        lg[(16 * (8 * (B) + rr) + kq) * 4 + c4] = sv; } } while (0)
    { v4u kdA[8][2], kdB[8][2];
      SA_QK_LOAD(kdA, 0); SA_QK_LOAD(kdB, 1); SA_QK_COMP(kdA, 0); SA_QK_COMP(kdB, 1); }
#undef SA_QK_LOAD
#undef SA_QK_COMP
    LDS_WAIT();
    float l[4][4];
#pragma unroll
    for (int k = 0; k < 4; ++k) { const int j = lane + 64 * k; const f32x4 l4 = *(const LAS f32x4*)(lg + 4 * j); const int key = idxl[j]; const int bk = t5_bucket(qpos - key);
        const f32x4 b4 = *(const LAS f32x4*)(biasl + bk * 16 + 4 * g); const bool valid = j < cnt;
#pragma unroll
        for (int hq = 0; hq < 4; ++hq) l[k][hq] = valid ? l4[hq] * QK_SCALE + b4[hq] : -INFINITY; }
    LDS_WAIT();
#pragma unroll
    for (int hq = 0; hq < 4; ++hq) { const float m = wave_max_dpp(__builtin_fmaxf(__builtin_fmaxf(l[0][hq], l[1][hq]), __builtin_fmaxf(l[2][hq], l[3][hq])));
        float sum = 0.f;
#pragma unroll
        for (int k = 0; k < 4; ++k) { l[k][hq] = __expf(l[k][hq] - m); sum += l[k][hq]; }
        sum = wave_sum_dpp(sum); const float inv = 1.0f / sum;
#pragma unroll
        for (int k = 0; k < 4; ++k) l[k][hq] *= inv; }
#pragma unroll
    for (int k = 0; k < 4; ++k) { const int j = lane + 64 * k; *(LAS f32x4*)(lg + 4 * j) = (f32x4){l[k][0], l[k][1], l[k][2], l[k][3]}; }
    LDS_WAIT();
    const int ks = lane >> 4, dc = lane & 15;
    f32x2 o[4][4];
#pragma unroll
    for (int hq = 0; hq < 4; ++hq)
#pragma unroll
        for (int i = 0; i < 4; ++i) o[hq][i] = (f32x2){0.f, 0.f};
    const unsigned char* vp = Vb + 8 * dc;
#define SA_PV_LOAD(W, B) do { _Pragma("unroll") for (int u = 0; u < 16; ++u) { const int key = idxl[64 * (B) + 4 * u + ks]; W[u] = *(const v2u*)(vp + (unsigned)(key * KVW)); } } while (0)
#define SA_PV_COMP(W, B) do { _Pragma("unroll") for (int u = 0; u < 16; ++u) { const f32x4 p4 = *(const LAS f32x4*)(lg + 4 * (64 * (B) + 4 * u + ks)); \
        const f32x2 v0 = __builtin_amdgcn_cvt_pk_f32_fp8((int)W[u].x, false), v1 = __builtin_amdgcn_cvt_pk_f32_fp8((int)W[u].x, true), v2 = __builtin_amdgcn_cvt_pk_f32_fp8((int)W[u].y, false), v3 = __builtin_amdgcn_cvt_pk_f32_fp8((int)W[u].y, true); \
        _Pragma("unroll") for (int hq = 0; hq < 4; ++hq) { const float ph = p4[hq]; o[hq][0] += ph * v0; o[hq][1] += ph * v1; o[hq][2] += ph * v2; o[hq][3] += ph * v3; } } } while (0)
    { v2u wA[16], wB[16];
      SA_PV_LOAD(wA, 0); SA_PV_LOAD(wB, 1); SA_PV_COMP(wA, 0); SA_PV_LOAD(wA, 2); SA_PV_COMP(wB, 1); SA_PV_LOAD(wB, 3); SA_PV_COMP(wA, 2); SA_PV_COMP(wB, 3); }
#undef SA_PV_LOAD
#undef SA_PV_COMP
    v4u st = (v4u){0u, 0u, 0u, 0u};
#pragma unroll
    for (int hq = 0; hq < 4; ++hq) { unsigned pk[4];
#pragma unroll
        for (int i = 0; i < 4; ++i) pk[i] = pk2(sum_x16_x32(o[hq][i].x), sum_x16_x32(o[hq][i].y));
        if (ks == hq) st = (v4u){pk[0], pk[1], pk[2], pk[3]}; }
    *(v4u*)(OB + (size_t)row * DM + (4 * g + ks) * HD + 8 * dc) = st;
    LDS_WAIT();
}
__device__ __forceinline__ void sattn_phase(const Ctx& C, const float* rel_bias, const bf16* QB, const unsigned char* KA8, const int* IDX, const int* CNT, bf16* OB) {
    LAS float* biasl = (LAS float*)C.lds;
    LAS int* idxl = (LAS int*)(C.lds + 2048 + C.wave * 5120); LAS float* lg = (LAS float*)(C.lds + 2048 + C.wave * 5120 + 1024);
    if (C.tid < 512) biasl[C.tid] = rel_bias[C.tid];
    __syncthreads();
    const int x8 = C.bx & 7, g = x8 & 3, par = x8 >> 2, wi = (C.bx >> 3) * NWAVES + C.wave, nw = (C.G >> 3) * NWAVES;
    for (int k = wi; k < SEQ + 512; k += nw) {
        if (k < SEQ) { const int row = par * SEQ + k; const unsigned char* kt = KA8 + (size_t)par * SEQ * KVW + g * HD;
            sattn_task(row, g, k, kt, kt + D_VAP, CNT[row], IDX + (size_t)row * TOPK, QB, OB, idxl, lg, biasl, C.lane); }
        else { const int j = k - SEQ, b = 2 * (j >> 6) + par, i = j & 63, row = MP + b * DECS + i; const unsigned char* kt = KA8 + (size_t)b * SALL * KVW + g * HD;
            sattn_task(row, g, PAST + i, kt + D_KAS, kt + D_VAS, CNT[row], IDX + (size_t)row * TOPK, QB, OB, idxl, lg, biasl, C.lane); }
    }
}

constexpr int VT_PITCH = 320, SB_NTASK = 8192 + 512;
typedef short v4i16_t __attribute__((ext_vector_type(4)));
__device__ __forceinline__ bf16x8 pack8(const f32x4& a, const f32x4& b) { v4u w; w.x = pk2(a.x, a.y); w.y = pk2(a.z, a.w); w.z = pk2(b.x, b.y); w.w = pk2(b.z, b.w); return __builtin_bit_cast(bf16x8, w); }
__device__ __forceinline__ void sb_task(bool samp, int b, int h, int qpos0, int r0, const bf16* QB, const bf16* KBB, const bf16* VBB, const float* kcache, const float* vcache, bf16* OB, LAS unsigned char* vt, int lane) {
    const int q = lane & 31, hh = lane >> 5;
    bf16x8 qf[8];
    { const bf16* qp = QB + (size_t)(r0 + q) * DM + h * HD + 8 * hh;
#pragma unroll
      for (int kk = 0; kk < 8; ++kk) qf[kk] = *(const bf16x8*)(qp + 16 * kk); }
    f32x16 O[4];
#pragma unroll
    for (int db = 0; db < 4; ++db)
#pragma unroll
        for (int r = 0; r < 16; ++r) O[db][r] = 0.f;
    float R = 1.f; const int t = qpos0 + q;
    const int vkey = lane >> 1, vch0 = (lane & 1) * 8;
    const int rowbase = samp ? (MP + b * DECS - PAST) : b * SEQ;
    bf16x8 kf[8]; v4u vr[8]; bool have = false;
    for (int kt = qpos0 >> 5; kt >= 0; --kt) {
        const bool f32t = samp && (32 * kt < PAST);
        if (f32t) {
            const float* kl = kcache + ((size_t)(b * PAST + 32 * kt + q) * 16 + h) * HD + 8 * hh;
#pragma unroll
            for (int kk = 0; kk < 8; ++kk) { const f32x4 a = *(const f32x4*)(kl + 16 * kk), bq = *(const f32x4*)(kl + 16 * kk + 4); kf[kk] = pack8(a, bq); }
#pragma unroll
            for (int i = 0; i < 8; ++i) { const float* vl = vcache + ((size_t)(b * PAST + 32 * kt + vkey) * 16 + h) * HD + 8 * (vch0 + i); const f32x4 a = *(const f32x4*)vl, bq = *(const f32x4*)(vl + 4); vr[i] = __builtin_bit_cast(v4u, pack8(a, bq)); }
        } else if (!have) {
            const bf16* kl = KBB + (size_t)(rowbase + 32 * kt + q) * DM + h * HD + 8 * hh;
#pragma unroll
            for (int kk = 0; kk < 8; ++kk) kf[kk] = *(const bf16x8*)(kl + 16 * kk);
#pragma unroll
            for (int i = 0; i < 8; ++i) vr[i] = *(const v4u*)(VBB + (size_t)(rowbase + 32 * kt + vkey) * DM + h * HD + 8 * (vch0 + i));
        }
#pragma unroll
        for (int i = 0; i < 8; ++i) *(LAS v4u*)(vt + vkey * VT_PITCH + 16 * (vch0 + i)) = vr[i];
        f32x16 c;
#pragma unroll
        for (int r = 0; r < 16; ++r) c[r] = 0.f;
#pragma unroll
        for (int kk = 0; kk < 8; ++kk) c = MFMA32(kf[kk], qf[kk], c);
        have = false;
        if (kt > 0 && !(samp && (32 * (kt - 1) < PAST))) { have = true;
            const bf16* kl = KBB + (size_t)(rowbase + 32 * (kt - 1) + q) * DM + h * HD + 8 * hh;
#pragma unroll
            for (int kk = 0; kk < 8; ++kk) kf[kk] = *(const bf16x8*)(kl + 16 * kk);
#pragma unroll
            for (int i = 0; i < 8; ++i) vr[i] = *(const v4u*)(VBB + (size_t)(rowbase + 32 * (kt - 1) + vkey) * DM + h * HD + 8 * (vch0 + i));
        }
        float om[16], be[16];
#pragma unroll
        for (int r = 0; r < 16; ++r) { const int s = 32 * kt + crow(r, hh); const float z = c[r] * QK_SCALE; const float a = __expf(-__builtin_fabsf(z)); const float rr = __builtin_amdgcn_rcpf(1.0f + a), ar = a * rr;
            const bool m = s < t; const float beta = z > 0.f ? rr : ar, omb = z > 0.f ? ar : rr; om[r] = m ? omb : 1.f; be[r] = m ? beta : 0.f; }
        float pg[4], pp[4], tt[4];
#pragma unroll
        for (int gi = 0; gi < 4; ++gi) { pg[gi] = (om[4 * gi] * om[4 * gi + 1]) * (om[4 * gi + 2] * om[4 * gi + 3]); pp[gi] = __shfl_xor(pg[gi], 32); tt[gi] = pg[gi] * pp[gi]; }
        float SB[4]; SB[3] = 1.f; SB[2] = tt[3]; SB[1] = tt[3] * tt[2]; SB[0] = SB[1] * tt[1];
        float A[16];
#pragma unroll
        for (int gi = 0; gi < 4; ++gi) { const float s3 = R * SB[gi] * (hh == 0 ? pp[gi] : 1.f), s2 = s3 * om[4 * gi + 3], s1 = s2 * om[4 * gi + 2], s0 = s1 * om[4 * gi + 1];
            A[4 * gi + 3] = be[4 * gi + 3] * s3; A[4 * gi + 2] = be[4 * gi + 2] * s2; A[4 * gi + 1] = be[4 * gi + 1] * s1; A[4 * gi] = be[4 * gi] * s0; }
        R = R * (SB[0] * tt[0]);
        bf16x8 pf[2];
#pragma unroll
        for (int s = 0; s < 2; ++s) { v4u w; w.x = pk2(A[8 * s], A[8 * s + 1]); w.y = pk2(A[8 * s + 2], A[8 * s + 3]); w.z = pk2(A[8 * s + 4], A[8 * s + 5]); w.w = pk2(A[8 * s + 6], A[8 * s + 7]); pf[s] = __builtin_bit_cast(bf16x8, w); }
        { const int i16 = lane & 15, qq = i16 >> 2, pq = i16 & 3, blk = (lane >> 4) & 1;
          LAS unsigned char* vb0 = vt + (4 * hh + qq) * VT_PITCH + (16 * blk + 4 * pq) * 2;
#pragma unroll
          for (int db = 0; db < 4; ++db)
#pragma unroll
              for (int s = 0; s < 2; ++s) { LAS unsigned char* ap = vb0 + (16 * s) * VT_PITCH + 64 * db;
                  const v4i16_t lo = __builtin_amdgcn_ds_read_tr16_b64_v4i16((LAS v4i16_t*)ap), hi2 = __builtin_amdgcn_ds_read_tr16_b64_v4i16((LAS v4i16_t*)(ap + 8 * VT_PITCH));
                  const bf16x8 af = __builtin_shufflevector(lo, hi2, 0, 1, 2, 3, 4, 5, 6, 7); O[db] = MFMA32(af, pf[s], O[db]); } }
        LDS_WAIT();
        if (__all(R == 0.f)) break;
    }
#pragma unroll
    for (int db = 0; db < 4; ++db)
#pragma unroll
        for (int rg = 0; rg < 4; ++rg) { v2u w; w.x = pk2(O[db][4 * rg], O[db][4 * rg + 1]); w.y = pk2(O[db][4 * rg + 2], O[db][4 * rg + 3]);
            *(v2u*)(OB + (size_t)(r0 + q) * DM + h * HD + 32 * db + 8 * rg + 4 * hh) = w; }
}
__device__ __forceinline__ void sbattn_phase(const Ctx& C, unsigned* qhead, const bf16* QB, const bf16* KBB, const bf16* VBB, const float* kcache, const float* vcache, bf16* OB) {
    LAS unsigned char* vt = C.lds + C.wave * (32 * VT_PITCH);
    int id = 0; if (C.lane == 0) id = (int)__hip_atomic_fetch_add(qhead, 1u, RLX_AGENT); id = __builtin_amdgcn_readfirstlane(id);
    while (id < SB_NTASK) {
        int nid = 0; if (C.lane == 0) nid = (int)__hip_atomic_fetch_add(qhead, 1u, RLX_AGENT);
        if (id < 512) { const int b = id >> 5, h = (id >> 1) & 15, hf = id & 1; sb_task(true, b, h, PAST + 32 * hf, MP + b * DECS + 32 * hf, QB, KBB, VBB, kcache, vcache, OB, vt, C.lane); }
        else { const int j = id - 512, b = j >> 12, h = (j >> 8) & 15, qt = j & 255; sb_task(false, b, h, qt * 32, b * SEQ + qt * 32, QB, KBB, VBB, kcache, vcache, OB, vt, C.lane); }
        id = __builtin_amdgcn_readfirstlane(nid);
    }
}

struct Args { const float* in[22]; float* out; unsigned char* ws; int ph_lo, ph_hi; };
__global__ void __launch_bounds__(NTHREADS, 2) mk_fwd(Args args) {
    extern __shared__ __attribute__((aligned(16))) unsigned char lds_raw[];
    Ctx C;
    C.lds = (LAS unsigned char*)lds_raw; C.MISC = (volatile LAS unsigned*)(C.lds + MISC_OFF);
    C.tid = threadIdx.x; C.lane = C.tid & 63; C.wave = __builtin_amdgcn_readfirstlane(C.tid >> 6);
    C.G = gridDim.x; C.bx = blockIdx.x; C.gw = C.bx * NWAVES + C.wave; C.NGW = C.G * NWAVES;
    unsigned char* ws = args.ws; unsigned* ctl = (unsigned*)(ws + WS_CTL); float* out = args.out;
    for (int u = C.tid; u < (LDS_BYTES - LDSCTL_OFF) / 4; u += NTHREADS) ((LAS unsigned*)(C.lds + LDSCTL_OFF))[u] = 0u;
    __syncthreads();
    XcdBarrier bar; bar.bar = ctl + CW_BAR; bar.x = 0; bar.st = nullptr;
    if (!MK_PER_PHASE) bar = xcd_barrier_post(ctl + CW_BAR, C.MISC + 8);
    const int lo = args.ph_lo, hi = args.ph_hi;
#define IN(k) (lo <= (k) && (k) < hi)
#define PH_ON(k) ((MK_PH_MASK >> (k)) & 1u)
#define SEAM(k) do { if (!MK_PER_PHASE && IN(k) && IN((k) + 1)) xcd_barrier(bar); } while (0)
    const float *x_prompt = args.in[0], *x_sample = args.in[1], *cache_k_a = args.in[2], *cache_v_a = args.in[3], *cache_kidx_a = args.in[4], *cache_k_b = args.in[5], *cache_v_b = args.in[6];
    const float *p_prompt = args.in[7], *p_sample = args.in[8], *rel_bias = args.in[9], *w_in_a = args.in[10], *w_out_a = args.in[11], *w_in_b = args.in[12], *w_out_b = args.in[13];
    const float *ln1_g = args.in[14], *ln1_b = args.in[15], *ln2_g = args.in[16], *ln2_b = args.in[17], *w_up = args.in[18], *w_down = args.in[19], *w_ple = args.in[20], *w_ple_gate = args.in[21];
    bf16 *WINA = (bf16*)(ws + WS_WINA), *WOUTA = (bf16*)(ws + WS_WOUTA), *WINB = (bf16*)(ws + WS_WINB), *WOUTB = (bf16*)(ws + WS_WOUTB), *WUP = (bf16*)(ws + WS_WUP), *WDOWN = (bf16*)(ws + WS_WDOWN), *WG = (bf16*)(ws + WS_WG), *WP = (bf16*)(ws + WS_WP);
    bf16 *PB = (bf16*)(ws + WS_PB), *XB = (bf16*)(ws + WS_XB), *X1B = (bf16*)(ws + WS_X1B), *X2B = (bf16*)(ws + WS_X2B), *QB = (bf16*)(ws + WS_QB), *OB = (bf16*)(ws + WS_OB), *QIB = (bf16*)(ws + WS_QIB);
    unsigned char* KA8 = ws + WS_KAP; bf16 *KIP = (bf16*)(ws + WS_KIP), *KIS = (bf16*)(ws + WS_KIS), *HB = (bf16*)(ws + WS_H), *KBB = (bf16*)(ws + WS_KBB), *VBB = (bf16*)(ws + WS_VBB);
    float *WI = (float*)(ws + WS_WI), *RES = (float*)(ws + WS_RES), *Y0 = (float*)(ws + WS_Y0), *PW = (float*)(ws + WS_PW), *SCP = (float*)(ws + WS_SCP), *SCS = (float*)(ws + WS_SCS), *PART = (float*)(ws + WS_PART); bf16* PBUF = (bf16*)(ws + WS_PBUF);
    int *IDX = (int*)(ws + WS_IDX), *CNT = (int*)(ws + WS_CNT);

    if (IN(0)) for (int rep_ = 0; rep_ < NREP(2); ++rep_) {
        transpose_job(C, w_in_a, DM, NINA, NINA_PAD, WINA); transpose_job(C, w_out_a, DM, DM, DM, WOUTA); transpose_job(C, w_in_b, DM, NINB, NINB, WINB); transpose_job(C, w_out_b, DM, DM, DM, WOUTB);
        for (int l = 0; l < 2; ++l) { transpose_job(C, w_up + (size_t)l * DM * DFF, DM, DFF, DFF, WUP + (size_t)l * DFF * DM); transpose_job(C, w_down + (size_t)l * DFF * DM, DFF, DM, DM, WDOWN + (size_t)l * DM * DFF);
            transpose_job(C, w_ple_gate + (size_t)l * DM * DM, DM, DM, DM, WG + (size_t)l * DM * DM); transpose_job(C, w_ple + (size_t)l * PLE * DM, PLE, DM, DM, WP + (size_t)l * DM * PLE); }
        cvt_job(C, x_prompt, XB, 1, MP * DM, 0, 0); cvt_job(C, x_sample, XB + (size_t)MP * DM, 1, MS * DM, 0, 0);
        for (int l = 0; l < 2; ++l) { cvt_job(C, p_prompt + (size_t)l * MP * PLE, PB + (size_t)l * MT * PLE, 1, MP * PLE, 0, 0); cvt_job(C, p_sample + (size_t)l * MS * PLE, PB + (size_t)l * MT * PLE + (size_t)MP * PLE, 1, MS * PLE, 0, 0); }
        cvt8_job(C, cache_k_a, KA8 + D_KAS, DECB, PAST * KVW, (size_t)PAST * KVW, (size_t)SALL * KVW); cvt8_job(C, cache_v_a, KA8 + D_VAS, DECB, PAST * KVW, (size_t)PAST * KVW, (size_t)SALL * KVW);
        cvt_job(C, cache_kidx_a, KIS, DECB, PAST * HD, (size_t)PAST * HD, (size_t)SALL * HD);
    }
    SEAM(0);
#define LAYER_BODY(l) do { \
        const int pb = (l == 0) ? 5 : 13; \
        if (l == 0) { \
            if (IN(1) && PH_ON(1)) { pg8::Gemm g{XB, WINA, MT, NINA_PAD, DM, DM}; pg8::StaticOrder S; S.init(MT, NINA_PAD, C.G, C.bx); \
                pg8::EpiInA E{QB, QIB, KIP, KA8, WI, out}; \
                pg8::gemm_phase<pg8::EpiInA, pg8::StaticOrder, true, true>(C.lds, g, S, E); if (NREP(0) > 1) { pg8::gemm_phase<pg8::EpiInA, pg8::StaticOrder, true, true>(C.lds, g, S, E); } } \
            SEAM(1); \
            if (IN(2) && PH_ON(2)) for (int rep_ = 0; rep_ < NREP2(1, 4); ++rep_) scores_phase(C, ctl + CW_QSC + 64 * rep_, QIB, KIP, KIS, WI, SCP, SCS); \
            SEAM(2); \
            if (IN(3) && PH_ON(3)) for (int rep_ = 0; rep_ < NREP2(1, 5); ++rep_) select_phase(C, SCP, SCS, IDX, CNT); \
            SEAM(3); \
            if (IN(4) && PH_ON(4)) for (int rep_ = 0; rep_ < NREP2(1, 6); ++rep_) sattn_phase(C, rel_bias, QB, KA8, IDX, CNT, OB); \
            SEAM(4); \
        } else { \
            if (IN(11) && PH_ON(11)) { pg8::Gemm g{XB, WINB, MT, NINB, DM, DM}; pg8::StaticOrder S; S.init(MT, NINB, C.G, C.bx); \
                pg8::EpiInB E{QB, KBB, out}; \
                pg8::gemm_phase<pg8::EpiInB, pg8::StaticOrder, true, true>(C.lds, g, S, E); if (NREP(0) > 1) { pg8::gemm_phase<pg8::EpiInB, pg8::StaticOrder, true, true>(C.lds, g, S, E); } } \
            SEAM(11); \
            if (IN(12) && PH_ON(12)) for (int rep_ = 0; rep_ < NREP(3); ++rep_) sbattn_phase(C, ctl + CW_QSB + 64 * rep_, QB, KBB, VBB, cache_k_b, cache_v_b, OB); \
            SEAM(12); \
        } \
        if (IN(pb) && PH_ON(pb)) { \
            { pg8::Gemm g{OB, l == 0 ? WOUTA : WOUTB, MP, DM, DM, DM}; pg8::StaticOrder S; S.init(MP, DM, C.G, C.bx); pg8::EpiResid E{l == 0 ? x_prompt : Y0, RES}; \
              GEMM2X((pg8::gemm_phase<pg8::EpiResid, pg8::StaticOrder, true, true>(C.lds, g, S, E))); } \
            { int ksl = 256; asm volatile("" : "+s"(ksl)); pg8::Gemm g{OB, l == 0 ? WOUTA : WOUTB, MT, DM, ksl, DM}; pg8::SplitOrder S{C.G, C.bx}; pg8::EpiPart E{PART}; \
              GEMM2X((pg8::gemm_phase<pg8::EpiPart, pg8::SplitOrder, true, true>(C.lds, g, S, E))); } } \
        SEAM(pb); \
        if (IN(pb + 1) && PH_ON(pb + 1)) { if (NREP(9) > 1) ln_phase(C, RES, X2B, ln1_g + l * DM, ln1_b + l * DM, l == 0 ? x_sample - (size_t)MP * DM : Y0, PART, PW); ln_phase(C, RES, X1B, ln1_g + l * DM, ln1_b + l * DM, l == 0 ? x_sample - (size_t)MP * DM : Y0, PART, RES); } \
        SEAM(pb + 1); \
        if (IN(pb + 2) && PH_ON(pb + 2)) { pg8::Gemm g{X1B, WUP + (size_t)l * DFF * DM, MT, DFF, DM, DM}; pg8::StaticOrder S; S.init(MT, DFF, C.G, C.bx); \
            pg8::EpiSqRelu E{HB}; \
            GEMM2X((pg8::gemm_phase<pg8::EpiSqRelu, pg8::StaticOrder, true, true>(C.lds, g, S, E))); \
            if (NREP(7) > 1) { pg8::gemm_phase<pg8::EpiSqRelu, pg8::StaticOrder, true, true>(C.lds, g, S, E); } \
            if (NREP(8) > 1) { pg8::EpiNull E0{HB}; pg8::gemm_phase<pg8::EpiNull, pg8::StaticOrder, true, true>(C.lds, g, S, E0); } } \
        SEAM(pb + 2); \
        if (IN(pb + 3) && PH_ON(pb + 3)) { \
            { pg8::Gemm g{HB, WDOWN + (size_t)l * DM * DFF, MP, DM, DFF, DFF}; pg8::StaticOrder S; S.init(MP, DM, C.G, C.bx); pg8::EpiResid E{RES, RES}; \
              if (NREP(0) > 1) { pg8::EpiResid E2{RES, PW}; pg8::gemm_phase<pg8::EpiResid, pg8::StaticOrder, true, true>(C.lds, g, S, E2); } \
              pg8::gemm_phase<pg8::EpiResid, pg8::StaticOrder, true, true>(C.lds, g, S, E); } \
            { int ksl = 1024; asm volatile("" : "+s"(ksl)); pg8::Gemm g{HB, WDOWN + (size_t)l * DM * DFF, MT, DM, ksl, DFF}; pg8::SplitOrder S{C.G, C.bx}; pg8::EpiPart E{PART}; \
              GEMM2X((pg8::gemm_phase<pg8::EpiPart, pg8::SplitOrder, true, true>(C.lds, g, S, E))); } } \
        SEAM(pb + 3); \
        if (IN(pb + 4) && PH_ON(pb + 4)) { if (NREP(9) > 1) ln_phase(C, RES, X1B, ln2_g + l * DM, ln2_b + l * DM, RES, PART, PW); ln_phase(C, RES, X2B, ln2_g + l * DM, ln2_b + l * DM, RES, PART, RES); } \
        SEAM(pb + 4); \
        if (IN(pb + 5) && PH_ON(pb + 5)) { \
            if (MK_GATE_PART & 1) { int kple = PLE; asm volatile("" : "+s"(kple)); pg8::Gemm g{PB + (size_t)l * MT * PLE, WP + (size_t)l * DM * PLE, MT, DM, kple, PLE}; pg8::StaticOrder S; S.init(MT, DM, C.G, C.bx); \
              pg8::EpiStoreF32 E{PW}; \
              pg8::gemm_phase<pg8::EpiStoreF32, pg8::StaticOrder, true, true>(C.lds, g, S, E); if (NREP(0) > 1) { pg8::gemm_phase<pg8::EpiStoreF32, pg8::StaticOrder, true, true>(C.lds, g, S, E); } } \
            VM_WAIT(); __syncthreads(); \
            if (MK_GATE_PART & 2) { pg8::Gemm g{X2B, WG + (size_t)l * DM * DM, MT, DM, DM, DM}; pg8::StaticOrder S; S.init(MT, DM, C.G, C.bx); \
              pg8::EpiGate E{RES, PW, l == 0 ? Y0 : out + O_Y, l == 0 ? XB : (bf16*)nullptr}; \
              pg8::gemm_phase<pg8::EpiGate, pg8::StaticOrder, true, true>(C.lds, g, S, E); if (NREP(0) > 1) { pg8::gemm_phase<pg8::EpiGate, pg8::StaticOrder, true, true>(C.lds, g, S, E); } } \
        } \
        SEAM(pb + 5); \
    } while (0)
    LAYER_BODY(0);
    LAYER_BODY(1);
#undef LAYER_BODY
#undef IN
#undef SEAM
}

extern "C" void kernel_launch(void* const* d_in, const int* in_sizes, int n_in, void* d_out, int out_size, void* d_ws, size_t ws_size, hipStream_t stream) {
    static int grid = 0;
    if (grid == 0) {
        if (n_in != 22 || out_size != (int)O_END || ws_size < WS_END) { fprintf(stderr, "kernel_launch: unexpected shapes (n_in %d, out %d, ws %zu)\n", n_in, out_size, ws_size); grid = -1; return; }
        int dev = 0, cus = 0;
        if (hipGetDevice(&dev) != hipSuccess || hipDeviceGetAttribute(&cus, hipDeviceAttributeMultiprocessorCount, dev) != hipSuccess) { grid = -1; return; }
        if (hipFuncSetAttribute((const void*)mk_fwd, hipFuncAttributeMaxDynamicSharedMemorySize, LDS_BYTES) != hipSuccess) { fprintf(stderr, "kernel_launch: hipFuncSetAttribute failed\n"); grid = -1; return; }
        int per_cu = 0;
        if (hipOccupancyMaxActiveBlocksPerMultiprocessor(&per_cu, (const void*)mk_fwd, NTHREADS, LDS_BYTES) != hipSuccess || per_cu < 1) fprintf(stderr, "kernel_launch: occupancy query reports %d\n", per_cu);
        (void)hipGetLastError();
        grid = cus - (cus % 8);
        if (grid < 8) grid = 8;
    }
    if (grid < 0) return;
    if (hipMemsetAsync((char*)d_ws + WS_CTL, 0, CTL_ZERO_BYTES, stream) != hipSuccess) return;
    Args a{};
    for (int i = 0; i < 22; ++i) a.in[i] = (const float*)d_in[i];
    a.out = (float*)d_out; a.ws = (unsigned char*)d_ws;
#if MK_PER_PHASE
    for (int p = 0; p < NPH; ++p) { a.ph_lo = p; a.ph_hi = p + 1; hipLaunchKernelGGL(mk_fwd, dim3(grid), dim3(NTHREADS), LDS_BYTES, stream, a); }
#else
    a.ph_lo = 0; a.ph_hi = NPH;
    hipLaunchKernelGGL(mk_fwd, dim3(grid), dim3(NTHREADS), LDS_BYTES, stream, a);
#endif
}
```
